# Optimizing an MI355X kernel written in HIP

```python
import jax, jax.numpy as jnp
from jax import lax
import numpy as np

D_MODEL = 1024
BATCH = 4
SEQ = 4096
DEPTH = 4

HEAD_DIM = 64
GLA_WIDTH = 3 * D_MODEL // 8
HGRN_WIDTH = 3 * D_MODEL // 8
MLSTM_WIDTH = D_MODEL - GLA_WIDTH - HGRN_WIDTH
GLA_HEADS = GLA_WIDTH // HEAD_DIM
GLA_DK = HEAD_DIM // 2
GLA_GATE_RANK = 16
GLA_GATE_TAU = 16.0
HGRN_HEADS = HGRN_WIDTH // HEAD_DIM
HGRN_DK = HEAD_DIM
MLSTM_HEADS = MLSTM_WIDTH // HEAD_DIM
MLSTM_CONV = 4
D_FF = 4 * D_MODEL
CHUNK = 64
EPS = 1e-6
IN_SPLITS = (GLA_HEADS * GLA_DK, GLA_HEADS * GLA_DK, GLA_WIDTH, GLA_GATE_RANK, GLA_WIDTH,
             HGRN_HEADS * HGRN_DK, HGRN_HEADS * HGRN_DK, HGRN_WIDTH, HGRN_WIDTH,
             2 * MLSTM_WIDTH, MLSTM_WIDTH, MLSTM_HEADS, MLSTM_HEADS, MLSTM_WIDTH)
D_IN = sum(IN_SPLITS)
IN_OFFSETS = tuple(int(o) for o in np.cumsum(IN_SPLITS)[:-1])

kernel_name = 'hybrid_gla_hgrn2_mlstm_adaln_trunk'


def _rms(x):
    xf = x.astype(jnp.float32)
    return xf * lax.rsqrt(jnp.mean(xf * xf, axis=-1, keepdims=True) + EPS)


def modulated_rmsnorm(x, gain, shift, scale):
    y = _rms(x) * gain.astype(jnp.float32)
    y = y * (1.0 + scale[:, None]) + shift[:, None]
    return y.astype(x.dtype)


def split_heads(t, n_heads):
    return t.reshape(t.shape[:-1] + (n_heads, -1))


def head_rmsnorm(o, gain):
    return o * lax.rsqrt(jnp.mean(o * o, axis=-1, keepdims=True) + EPS) * gain.astype(jnp.float32)


def head_layernorm(h, gain):
    mu = jnp.mean(h, axis=-1, keepdims=True)
    hc = h - mu
    var = jnp.mean(hc * hc, axis=-1, keepdims=True)
    return hc * lax.rsqrt(var + EPS) * gain.astype(jnp.float32).reshape(h.shape[-2:])


def to_chunks(t):
    b, s = t.shape[:2]
    return jnp.moveaxis(t.reshape((b, s // CHUNK, CHUNK) + t.shape[2:]), 1, 0)


def gated_linear_attention(q, k, v, log_g):
    B, S, H, K = q.shape
    V = v.shape[-1]
    causal = jnp.tril(jnp.ones((CHUNK, CHUNK), bool))[None, :, :, None, None]

    def step(state, inp):
        qc, kc, vc, gc = inp
        b = jnp.cumsum(gc, axis=1)
        decay = jnp.exp(jnp.where(causal, b[:, :, None] - b[:, None, :], -jnp.inf))
        scores = jnp.einsum('bihk,bjhk,bijhk->bhij', qc, kc, decay)
        o = (jnp.einsum('bhij,bjhv->bihv', scores, vc)
             + jnp.einsum('bihk,bhkv->bihv', qc * jnp.exp(b), state))
        b_last = b[:, -1]
        state = (jnp.exp(b_last)[..., None] * state
                 + jnp.einsum('bjhk,bjhv->bhkv', kc * jnp.exp(b_last[:, None] - b), vc))
        return state, o

    f32 = jnp.float32
    xs = (to_chunks(q.astype(f32)), to_chunks(k.astype(f32)),
          to_chunks(v.astype(f32)), to_chunks(log_g.astype(f32)))
    _, o = lax.scan(step, jnp.zeros((B, H, K, V), f32), xs)
    return jnp.moveaxis(o, 0, 1).reshape(B, S, H, V)


def mlstm_chunkwise(q, k, v, log_i, log_f):
    B, S, H, Dh = q.shape
    N = S // CHUNK

    def blk(t):
        return jnp.moveaxis(t.reshape((B, N, CHUNK) + t.shape[2:]), 3, 1)

    q, k, v, log_i, log_f = blk(q), blk(k), blk(v), blk(log_i), blk(log_f)
    b = jnp.cumsum(log_f, axis=-1)
    causal = jnp.tril(jnp.ones((CHUNK, CHUNK), bool))
    log_w = jnp.where(causal, b[..., :, None] - b[..., None, :] + log_i[..., None, :], -jnp.inf)
    m_intra = jnp.max(log_w, axis=-1)
    b_last = b[..., -1]
    w_state = b_last[..., None] - b + log_i
    m_local = jnp.max(w_state, axis=-1)
    p_state = jnp.exp(w_state - m_local[..., None])
    u = jnp.einsum('bhnc,bhncd,bhnce->bhnde', p_state, k, v)
    nu = jnp.einsum('bhnc,bhncd->bhnd', p_state, k)

    def step(carry, inp):
        c_st, n_st, m = carry
        a_n, ml_n, u_n, nu_n = inp
        m_new = jnp.maximum(a_n + m, ml_n)
        s_old = jnp.exp(a_n + m - m_new)
        s_loc = jnp.exp(ml_n - m_new)
        c_new = s_old[..., None, None] * c_st + s_loc[..., None, None] * u_n
        n_new = s_old[..., None] * n_st + s_loc[..., None] * nu_n
        return (c_new, n_new, m_new), (c_st, n_st, m)

    f32 = jnp.float32
    init = (jnp.zeros((B, H, Dh, Dh), f32), jnp.zeros((B, H, Dh), f32), jnp.zeros((B, H), f32))
    xs = (jnp.moveaxis(b_last, 2, 0), jnp.moveaxis(m_local, 2, 0),
          jnp.moveaxis(u, 2, 0), jnp.moveaxis(nu, 2, 0))
    _, (c_prev, n_prev, m_prev) = lax.scan(step, init, xs)
    c_prev = jnp.moveaxis(c_prev, 0, 2)
    n_prev = jnp.moveaxis(n_prev, 0, 2)
    m_prev = jnp.moveaxis(m_prev, 0, 2)
    m_inter = b + m_prev[..., None]
    m_t = jnp.maximum(m_inter, m_intra)
    p = jnp.exp(log_w - m_t[..., None]) * jnp.einsum('bhnid,bhnjd->bhnij', q, k)
    s_inter = jnp.exp(m_inter - m_t)
    num = (jnp.einsum('bhnij,bhnje->bhnie', p, v)
           + s_inter[..., None] * jnp.einsum('bhnid,bhnde->bhnie', q, c_prev))
    den = jnp.sum(p, axis=-1) + s_inter * jnp.einsum('bhnid,bhnd->bhni', q, n_prev)
    h = num / jnp.maximum(jnp.abs(den), jnp.exp(-m_t))[..., None]
    return h.transpose(0, 2, 3, 1, 4).reshape(B, S, H, Dh)


def causal_depthwise_conv(x, w):
    return lax.conv_general_dilated(
        x, w[:, None, :].astype(x.dtype), window_strides=(1,), padding=[(MLSTM_CONV - 1, 0)],
        dimension_numbers=('NWC', 'WIO', 'NWC'), feature_group_count=x.shape[-1])


def gla_group(q, k, v, g_low, g_out, w_gate, b_gate, norm_gain):
    f32 = jnp.float32
    B, S, _ = q.shape
    q = split_heads(q.astype(f32), GLA_HEADS) * GLA_DK ** -0.5
    k = split_heads(k.astype(f32), GLA_HEADS)
    v = split_heads(v, GLA_HEADS)
    gate_logits = (g_low @ w_gate).astype(f32) + b_gate.astype(f32)
    log_g = split_heads(jax.nn.log_sigmoid(gate_logits) / GLA_GATE_TAU, GLA_HEADS)
    o = gated_linear_attention(q, k, v, log_g)
    o = head_rmsnorm(o, norm_gain) * jax.nn.silu(split_heads(g_out.astype(f32), GLA_HEADS))
    return o.reshape(B, S, GLA_WIDTH)


def hgrn2_group(q, f, i, g_out, lower_bound, norm_gain):
    f32 = jnp.float32
    B, S, _ = q.shape
    lb = lower_bound.reshape(HGRN_HEADS, HGRN_DK)
    f = split_heads(f.astype(f32), HGRN_HEADS)
    log_f = jnp.logaddexp(jnp.log(lb), jnp.log1p(-lb) + jax.nn.log_sigmoid(f))
    k = (1.0 - lb) * jax.nn.sigmoid(-f)
    q = jax.nn.silu(split_heads(q.astype(f32), HGRN_HEADS))
    o = gated_linear_attention(q, k, split_heads(i, HGRN_HEADS), log_f)
    o = head_rmsnorm(o, norm_gain) * jax.nn.sigmoid(split_heads(g_out.astype(f32), HGRN_HEADS))
    return o.reshape(B, S, HGRN_WIDTH)


def mlstm_group(qk_pre, v, i_pre, f_pre, g_out, conv_w, gate_b, norm_gain):
    f32 = jnp.float32
    B, S, _ = v.shape
    qk = jax.nn.silu(causal_depthwise_conv(qk_pre, conv_w).astype(f32))
    q, k = jnp.split(qk, 2, axis=-1)
    q = split_heads(q, MLSTM_HEADS)
    k = split_heads(k, MLSTM_HEADS) * HEAD_DIM ** -0.5
    gate_b = gate_b.astype(f32)
    log_i = i_pre.astype(f32) + gate_b[:MLSTM_HEADS]
    log_f = jax.nn.log_sigmoid(f_pre.astype(f32) + gate_b[MLSTM_HEADS:])
    h = mlstm_chunkwise(q, k, split_heads(v.astype(f32), MLSTM_HEADS), log_i, log_f)
    h = head_layernorm(h, norm_gain) * jax.nn.sigmoid(split_heads(g_out.astype(f32), MLSTM_HEADS))
    return h.reshape(B, S, MLSTM_WIDTH)


def setup_inputs(seed: int = 0) -> dict:
    key = jax.random.key(seed)
    ks = jax.random.split(key, 22)
    f32 = jnp.float32

    def nrm(k, shape, std):
        return jax.random.normal(k, shape, f32) * std

    forget_bias = jnp.linspace(3.0, 6.0, MLSTM_HEADS, dtype=f32)[None, :] + nrm(ks[15], (DEPTH, MLSTM_HEADS), 0.1)
    return {
        'x': nrm(ks[0], (BATCH, SEQ, D_MODEL), 1.0),
        'c': nrm(ks[1], (BATCH, D_MODEL), 1.0),
        'w_ada': nrm(ks[2], (DEPTH, D_MODEL, 6 * D_MODEL), 0.5 * D_MODEL ** -0.5),
        'b_ada': nrm(ks[3], (DEPTH, 6 * D_MODEL), 0.02),
        'norm_mix': 1.0 + nrm(ks[4], (DEPTH, D_MODEL), 0.02),
        'norm_mlp': 1.0 + nrm(ks[5], (DEPTH, D_MODEL), 0.02),
        'w_in': nrm(ks[6], (DEPTH, D_MODEL, D_IN), D_MODEL ** -0.5),
        'gla_w_gate': nrm(ks[7], (DEPTH, GLA_GATE_RANK, GLA_HEADS * GLA_DK), GLA_GATE_RANK ** -0.5),
        'gla_b_gate': nrm(ks[8], (DEPTH, GLA_HEADS * GLA_DK), 0.1),
        'gla_norm': 1.0 + nrm(ks[9], (DEPTH, HEAD_DIM), 0.02),
        'hgrn_lb_logits': nrm(ks[10], (DEPTH, HGRN_HEADS * HGRN_DK), 0.1),
        'hgrn_norm': 1.0 + nrm(ks[11], (DEPTH, HEAD_DIM), 0.02),
        'mlstm_conv': nrm(ks[12], (DEPTH, MLSTM_CONV, 2 * MLSTM_WIDTH), MLSTM_CONV ** -0.5),
        'mlstm_gate_b': jnp.concatenate([nrm(ks[14], (DEPTH, MLSTM_HEADS), 0.1), forget_bias], axis=-1),
        'mlstm_norm': 1.0 + nrm(ks[16], (DEPTH, MLSTM_WIDTH), 0.02),
        'w_out': nrm(ks[17], (DEPTH, D_MODEL, D_MODEL), D_MODEL ** -0.5),
        'w_ff1': nrm(ks[18], (DEPTH, D_MODEL, D_FF), D_MODEL ** -0.5),
        'w_ff2': nrm(ks[19], (DEPTH, D_FF, D_MODEL), D_FF ** -0.5),
        'final_norm': 1.0 + nrm(ks[20], (D_MODEL,), 0.02),
    }


def reference(x, c, w_ada, b_ada, norm_mix, norm_mlp, w_in, gla_w_gate, gla_b_gate, gla_norm,
              hgrn_lb_logits, hgrn_norm, mlstm_conv, mlstm_gate_b, mlstm_norm, w_out, w_ff1, w_ff2,
              final_norm):
    f32 = jnp.float32
    cond = jax.nn.silu(c.astype(f32))
    lb_cum = jnp.cumsum(jax.nn.softmax(hgrn_lb_logits.astype(f32), axis=0), axis=0)
    lower_bounds = lb_cum - lb_cum[0]
    for l in range(DEPTH):
        mod = cond @ w_ada[l].astype(f32) + b_ada[l].astype(f32)
        shift1, scale1, gate1, shift2, scale2, gate2 = jnp.split(mod, 6, axis=-1)
        h = modulated_rmsnorm(x, norm_mix[l], shift1, scale1)
        z = h @ w_in[l]
        (gq, gk, gv, glow, gout, hq, hf, hi, hout,
         mqk, mv, mi, mf, mout) = jnp.split(z, IN_OFFSETS, axis=-1)
        mixed = jnp.concatenate([
            gla_group(gq, gk, gv, glow, gout, gla_w_gate[l], gla_b_gate[l], gla_norm[l]),
            hgrn2_group(hq, hf, hi, hout, lower_bounds[l], hgrn_norm[l]),
            mlstm_group(mqk, mv, mi, mf, mout, mlstm_conv[l], mlstm_gate_b[l], mlstm_norm[l]),
        ], axis=-1).astype(x.dtype)
        x = x + gate1[:, None].astype(x.dtype) * (mixed @ w_out[l])
        h = modulated_rmsnorm(x, norm_mlp[l], shift2, scale2)
        ff = jnp.square(jax.nn.relu(h @ w_ff1[l])) @ w_ff2[l]
        x = x + gate2[:, None].astype(x.dtype) * ff
    return (_rms(x) * final_norm.astype(f32)).astype(x.dtype)
```

```cpp
#include <hip/hip_runtime.h>
#include <cstdint>
#include <cstdio>

namespace cfg {
constexpr int D = 1024, NB = 4, S = 4096, L = 4, M = NB * S, DIN = 3736, DFF = 4096;
constexpr int GQ = 0, GK = 192, GV = 384, GLOW = 768, GOUT = 784, HQ = 1168, HF = 1552, HI = 1936, HOUT = 2320,
              MQK = 2704, MV = 3216, MI = 3472, MF = 3476, MOUT = 3480;
constexpr float EPS = 1e-6f;
}
using namespace cfg;

__device__ __forceinline__ float sigmoidf_(float x) { return 1.f / (1.f + __expf(-x)); }
__device__ __forceinline__ float siluf_(float x) { return x * sigmoidf_(x); }
__device__ __forceinline__ float logsigmoidf_(float x) { return fminf(x, 0.f) - log1pf(__expf(-fabsf(x))); }
__device__ __forceinline__ float wave_sum(float v) {
#pragma unroll
    for (int o = 1; o < 64; o <<= 1) v += __shfl_xor(v, o);
    return v;
}

__global__ void __launch_bounds__(256) r_mod(const float* c, const float* w_ada, const float* b_ada, float* mod) {
    __shared__ float cond[NB * D];
    for (int i = threadIdx.x; i < NB * D; i += 256) cond[i] = siluf_(c[i]);
    __syncthreads();
    const int gid = blockIdx.x * 256 + threadIdx.x;
    if (gid >= L * 6 * D) return;
    const int l = gid / (6 * D), n = gid % (6 * D);
    float a0 = 0, a1 = 0, a2 = 0, a3 = 0;
    const float* w = w_ada + (size_t)l * D * 6 * D + n;
    for (int k = 0; k < D; ++k) { const float wv = w[(size_t)k * 6 * D]; a0 += cond[k] * wv; a1 += cond[D + k] * wv; a2 += cond[2 * D + k] * wv; a3 += cond[3 * D + k] * wv; }
    const float bb = b_ada[l * 6 * D + n];
    mod[(l * NB + 0) * 6 * D + n] = a0 + bb; mod[(l * NB + 1) * 6 * D + n] = a1 + bb; mod[(l * NB + 2) * 6 * D + n] = a2 + bb; mod[(l * NB + 3) * 6 * D + n] = a3 + bb;
}
__global__ void r_lb(const float* logits, float* lb) {
    const int ch = blockIdx.x * blockDim.x + threadIdx.x; if (ch >= 384) return;
    float v[L], mx = -1e30f; for (int l = 0; l < L; ++l) { v[l] = logits[l * 384 + ch]; mx = fmaxf(mx, v[l]); }
    float s = 0; for (int l = 0; l < L; ++l) { v[l] = __expf(v[l] - mx); s += v[l]; }
    float cum = 0, first = 0; for (int l = 0; l < L; ++l) { cum += v[l] / s; if (l == 0) first = cum; lb[l * 384 + ch] = cum - first; }
}
__global__ void __launch_bounds__(256) r_norm(const float* x, const float* gain, const float* mod_l  , int shift_idx, int scale_idx, float* h, int plain) {
    const int row = blockIdx.x * 4 + (threadIdx.x >> 6), lane = threadIdx.x & 63;
    const float* xr = x + (size_t)row * D; float v[16]; float ss = 0;
#pragma unroll
    for (int j = 0; j < 16; ++j) { v[j] = xr[lane + 64 * j]; ss += v[j] * v[j]; }
    ss = wave_sum(ss); const float rstd = rsqrtf(ss / D + EPS); const int b = row / S;
#pragma unroll
    for (int j = 0; j < 16; ++j) { const int k = lane + 64 * j; float y = v[j] * rstd * gain[k];
        if (!plain) y = y * (1.f + mod_l[b * 6 * D + scale_idx * D + k]) + mod_l[b * 6 * D + shift_idx * D + k];
        h[(size_t)row * D + k] = y; }
}
__global__ void __launch_bounds__(256) r_gemm(const float* A, const float* Bm, float* C, int Mm, int N, int K, int mode, const float* mod_l, int gate_idx) {
    __shared__ float As[16][65], Bs[16][65];
    const int tx = threadIdx.x & 15, ty = threadIdx.x >> 4, m0 = blockIdx.y * 64, n0 = blockIdx.x * 64;
    float acc[4][4] = {};
    for (int k0 = 0; k0 < K; k0 += 16) {
        for (int i = threadIdx.x; i < 64 * 16; i += 256) { const int r = i >> 4, kk = i & 15; As[kk][r] = A[(size_t)(m0 + r) * K + k0 + kk]; }
        for (int i = threadIdx.x; i < 64 * 16; i += 256) { const int kk = i >> 6, cc = i & 63; Bs[kk][cc] = (n0 + cc < N) ? Bm[(size_t)(k0 + kk) * N + n0 + cc] : 0.f; }
        __syncthreads();
#pragma unroll
        for (int kk = 0; kk < 16; ++kk) { float a[4], b[4];
#pragma unroll
            for (int i = 0; i < 4; ++i) { a[i] = As[kk][ty * 4 + i]; b[i] = Bs[kk][tx * 4 + i]; }
#pragma unroll
            for (int i = 0; i < 4; ++i)
#pragma unroll
                for (int j = 0; j < 4; ++j) acc[i][j] += a[i] * b[j]; }
        __syncthreads();
    }
    for (int i = 0; i < 4; ++i) for (int j = 0; j < 4; ++j) { const int r = m0 + ty * 4 + i, cidx = n0 + tx * 4 + j; if (cidx >= N) continue;
        float v = acc[i][j];
        if (mode == 1) { const int b = r / S; v = C[(size_t)r * N + cidx] + mod_l[b * 6 * D + gate_idx * D + cidx] * v; }
        else if (mode == 2) { v = fmaxf(v, 0.f); v = v * v; }
        C[(size_t)r * N + cidx] = v; }
}
__global__ void __launch_bounds__(64) r_mixer(const float* z, float* mixed, const float* w_gate, const float* b_gate, const float* gla_norm, const float* lb, const float* hgrn_norm,
                                              const float* conv, const float* gate_b, const float* mlstm_norm) {
    __shared__ float sh[3][64];
    const int lane = threadIdx.x, b = blockIdx.x / 16, head = blockIdx.x % 16;
    if (head < 12) {
        const bool gla = head < 6; const int hh = gla ? head : head - 6; const int K = gla ? 32 : 64;
        float St[64]; for (int c = 0; c < 64; ++c) St[c] = 0.f;
        const float lbv = gla ? 0.f : lb[hh * 64 + lane];
        for (int t = 0; t < S; ++t) {
            const float* zr = z + (size_t)(b * S + t) * DIN;
            float q, kk, dec;
            if (gla) { if (lane < 32) { q = zr[GQ + hh * 32 + lane] * 0.17677669529663687f; kk = zr[GK + hh * 32 + lane];
                    float lg = b_gate[hh * 32 + lane]; for (int r = 0; r < 16; ++r) lg += zr[GLOW + r] * w_gate[r * 192 + hh * 32 + lane];
                    dec = __expf(logsigmoidf_(lg) / 16.f); } else { q = 0; kk = 0; dec = 0; } }
            else { q = siluf_(zr[HQ + hh * 64 + lane]); const float f = zr[HF + hh * 64 + lane]; dec = lbv + (1.f - lbv) * sigmoidf_(f); kk = (1.f - lbv) * sigmoidf_(-f); }
            sh[0][lane] = q; sh[1][lane] = kk; sh[2][lane] = dec;
            __syncthreads();
            const float v = zr[(gla ? GV : HI) + hh * 64 + lane]; float o = 0.f;
#pragma unroll
            for (int c = 0; c < 64; ++c) if (c < K) { St[c] = sh[2][c] * St[c] + sh[1][c] * v; o += St[c] * sh[0][c]; }
            const float ms = wave_sum(o * o) / 64.f; const float g = zr[(gla ? GOUT : HOUT) + hh * 64 + lane];
            const float outv = o * rsqrtf(ms + EPS) * (gla ? gla_norm[lane] : hgrn_norm[lane]) * (gla ? siluf_(g) : sigmoidf_(g));
            mixed[(size_t)(b * S + t) * D + (gla ? 0 : 384) + hh * 64 + lane] = outv;
            __syncthreads();
        }
    } else {
        const int mh = head - 12; float Cst[64]; for (int d = 0; d < 64; ++d) Cst[d] = 0.f; float nst = 0.f;
        float wq[4], wk[4]; for (int k = 0; k < 4; ++k) { wq[k] = conv[k * 512 + mh * 64 + lane]; wk[k] = conv[k * 512 + 256 + mh * 64 + lane]; }
        float qh[3] = {0, 0, 0}, kh[3] = {0, 0, 0};
        for (int t = 0; t < S; ++t) {
            const float* zr = z + (size_t)(b * S + t) * DIN;
            const float qp = zr[MQK + mh * 64 + lane], kp = zr[MQK + 256 + mh * 64 + lane];
            const float q = siluf_(wq[0] * qh[0] + wq[1] * qh[1] + wq[2] * qh[2] + wq[3] * qp);
            const float kk = siluf_(wk[0] * kh[0] + wk[1] * kh[1] + wk[2] * kh[2] + wk[3] * kp) * 0.125f;
            qh[0] = qh[1]; qh[1] = qh[2]; qh[2] = qp; kh[0] = kh[1]; kh[1] = kh[2]; kh[2] = kp;
            const float li = zr[MI + mh] + gate_b[mh], lf = logsigmoidf_(zr[MF + mh] + gate_b[4 + mh]);
            const float ig = __expf(li), fg = __expf(lf);
            nst = fg * nst + ig * kk;
            const float den = wave_sum(nst * q);
            sh[0][lane] = q; sh[1][lane] = kk;
            __syncthreads();
            const float v = zr[MV + mh * 64 + lane]; float num = 0.f;
#pragma unroll
            for (int d = 0; d < 64; ++d) { Cst[d] = fg * Cst[d] + ig * v * sh[1][d]; num += Cst[d] * sh[0][d]; }
            const float hv = num / fmaxf(fabsf(den), 1.f);
            const float mu = wave_sum(hv) / 64.f; const float hc = hv - mu; const float var = wave_sum(hc * hc) / 64.f;
            const float g = zr[MOUT + mh * 64 + lane];
            mixed[(size_t)(b * S + t) * D + 768 + mh * 64 + lane] = hc * rsqrtf(var + EPS) * mlstm_norm[mh * 64 + lane] * sigmoidf_(g);
            __syncthreads();
        }
    }
}

extern "C" void kernel_launch(void* const* d_in, const int* in_sizes, int n_in, void* d_out, int out_size, void* d_ws, size_t ws_size, hipStream_t stream) {
    const float* x = (const float*)d_in[0]; const float* c = (const float*)d_in[1]; const float* w_ada = (const float*)d_in[2]; const float* b_ada = (const float*)d_in[3];
    const float* norm_mix = (const float*)d_in[4]; const float* norm_mlp = (const float*)d_in[5]; const float* w_in = (const float*)d_in[6];
    const float* gla_w_gate = (const float*)d_in[7]; const float* gla_b_gate = (const float*)d_in[8]; const float* gla_norm = (const float*)d_in[9];
    const float* lb_logits = (const float*)d_in[10]; const float* hgrn_norm = (const float*)d_in[11]; const float* mconv = (const float*)d_in[12];
    const float* mgate_b = (const float*)d_in[13]; const float* mnorm = (const float*)d_in[14]; const float* w_out = (const float*)d_in[15];
    const float* w_ff1 = (const float*)d_in[16]; const float* w_ff2 = (const float*)d_in[17]; const float* final_norm = (const float*)d_in[18];
    char* ws = (char*)d_ws; const size_t MiB = 1u << 20;
    float* mod = (float*)(ws);
    float* lb = (float*)(ws + 1 * MiB);
    float* xb = (float*)d_out;
    float* h = (float*)(ws + 2 * MiB);
    float* mixed = h;
    float* zb = (float*)(ws + 66 * MiB);
    if (ws_size < (size_t)(66 + 256) * MiB) { fprintf(stderr, "ws too small %zu\n", ws_size); return; }
    hipMemcpyAsync(xb, x, (size_t)M * D * 4, hipMemcpyDeviceToDevice, stream);
    r_mod<<<(L * 6 * D + 255) / 256, 256, 0, stream>>>(c, w_ada, b_ada, mod);
    r_lb<<<2, 192, 0, stream>>>(lb_logits, lb);
    for (int l = 0; l < L; ++l) {
        const float* mod_l = mod + (size_t)l * NB * 6 * D;
        r_norm<<<M / 4, 256, 0, stream>>>(xb, norm_mix + l * D, mod_l, 0, 1, h, 0);
        r_gemm<<<dim3((DIN + 63) / 64, M / 64), 256, 0, stream>>>(h, w_in + (size_t)l * D * DIN, zb, M, DIN, D, 0, nullptr, 0);
        r_mixer<<<NB * 16, 64, 0, stream>>>(zb, mixed, gla_w_gate + l * 16 * 192, gla_b_gate + l * 192, gla_norm + l * 64, lb + l * 384, hgrn_norm + l * 64,
                                           mconv + l * 4 * 512, mgate_b + l * 8, mnorm + l * 256);
        r_gemm<<<dim3(D / 64, M / 64), 256, 0, stream>>>(mixed, w_out + (size_t)l * D * D, xb, M, D, D, 1, mod_l, 2);
        r_norm<<<M / 4, 256, 0, stream>>>(xb, norm_mlp + l * D, mod_l, 3, 4, h, 0);
        r_gemm<<<dim3(DFF / 64, M / 64), 256, 0, stream>>>(h, w_ff1 + (size_t)l * D * DFF, zb, M, DFF, D, 2, nullptr, 0);
        r_gemm<<<dim3(D / 64, M / 64), 256, 0, stream>>>(zb, w_ff2 + (size_t)l * DFF * D, xb, M, D, DFF, 1, mod_l, 5);
    }
    r_norm<<<M / 4, 256, 0, stream>>>(xb, final_norm, nullptr, 0, 0, (float*)d_out, 1);
}
```

```cpp
#include <hip/hip_runtime.h>
#include <cstdint>
#include <cstdio>

namespace cfg {
constexpr int D = 1024, NB = 4, S = 4096, L = 4, M = NB * S, DIN = 3736, DFF = 4096, NIN = 4096  ;
constexpr int GQ = 0, GK = 192, GV = 384, GLOW = 768, GOUT = 784, HQ = 1168, HF = 1552, HI = 1936, HOUT = 2320,
              MQK = 2704, MV = 3216, MI = 3472, MF = 3476, MOUT = 3480;
constexpr float EPS = 1e-6f;
constexpr size_t MiB = 1u << 20;
constexpr size_t WS_CTL = 0, CTL_ZERO_BYTES = 1 * MiB;
constexpr size_t WS_MOD = 256 * 1024;
constexpr size_t WS_LB = 1 * MiB;
constexpr size_t WS_GMUL = 1 * MiB + 64 * 1024;
constexpr size_t WS_BIAS = 2 * MiB;
constexpr size_t WS_MG = 3 * MiB;
constexpr size_t WS_SSQ = 4 * MiB;
constexpr size_t WS_VEC = 5 * MiB;
constexpr size_t WS_W = 8 * MiB, W_LAYER = 26 * MiB;
constexpr size_t W_IN = 0, W_OUT = 8 * MiB, W_1 = 10 * MiB, W_2 = 18 * MiB;
constexpr size_t WS_XN = 112 * MiB;
constexpr size_t WS_MIX = 144 * MiB;
constexpr size_t WS_Z = 176 * MiB;
constexpr size_t WS_U = 304 * MiB;
constexpr size_t WS_END = 356 * MiB;
}
using namespace cfg;

#define GAS __attribute__((address_space(1)))
#define LAS __attribute__((address_space(3)))
typedef unsigned short bf16;
typedef unsigned v4u __attribute__((ext_vector_type(4)));
typedef unsigned v2u __attribute__((ext_vector_type(2)));
typedef float f32x4 __attribute__((ext_vector_type(4)));
typedef float f32x16 __attribute__((ext_vector_type(16)));
typedef short bf16x8 __attribute__((ext_vector_type(8)));
typedef GAS unsigned gu32;
#define RLX_AGENT __ATOMIC_RELAXED, __HIP_MEMORY_SCOPE_AGENT

__device__ __forceinline__ unsigned f2bf(float f) { unsigned u = __builtin_bit_cast(unsigned, f); return (u + 0x7fffu + ((u >> 16) & 1u)) >> 16; }
__device__ __forceinline__ unsigned pk2(float lo, float hi) { return f2bf(lo) | (f2bf(hi) << 16); }
__device__ __forceinline__ float bf2f(unsigned short h) { return __builtin_bit_cast(float, (unsigned)h << 16); }
__device__ __forceinline__ float sigmoidf_(float x) { return 1.f / (1.f + __expf(-x)); }
__device__ __forceinline__ float siluf_(float x) { return x * sigmoidf_(x); }
__device__ __forceinline__ float logsigmoidf_(float x) { return fminf(x, 0.f) - log1pf(__expf(-fabsf(x))); }
__device__ __forceinline__ float wave_sum(float v) {
#pragma unroll
    for (int o = 1; o < 64; o <<= 1) v += __shfl_xor(v, o);
    return v;
}
__host__ __device__ __forceinline__ int in_src(int np) {
    const int pn = np >> 8, tc = np & 255, bj = tc >> 7, wc = (tc >> 5) & 3, n = (tc >> 4) & 1, g = tc & 15;
    if (pn < 6) { const int gh = pn;
        if (wc < 2) { const int c = 16 * wc + g;
            if (bj == 0) return (n == 0 ? GQ : GK) + gh * 32 + c;
            if (n == 0) return -2 - (gh * 32 + c);
            if (gh == 0 && wc == 0 && g < 8) return (g < 4) ? MI + g : MF + (g - 4);
            return -1; }
        const int e = 32 * (wc - 2) + 16 * n + g; return (bj == 0 ? GV : GOUT) + gh * 64 + e; }
    if (pn < 12) { const int hh = pn - 6, c = 16 * wc + g; const int base = bj == 0 ? (n == 0 ? HQ : HF) : (n == 0 ? HI : HOUT); return base + hh * 64 + c; }
    const int mh = pn - 12, grp = tc >> 6, c = tc & 63;
    return (grp == 0 ? MQK : grp == 1 ? MQK + 256 : grp == 2 ? MV : MOUT) + mh * 64 + c;
}
namespace pg8 {
#define PG8_LAS __attribute__((address_space(3)))
typedef unsigned short bf16_t;
typedef short bf16x8 __attribute__((ext_vector_type(8)));
typedef float f32x4 __attribute__((ext_vector_type(4)));
typedef unsigned u32x4 __attribute__((ext_vector_type(4)));
constexpr int BM = 256, BK = 64, HALF = 128, HTB = HALF * BK * 2  , STAGE_BYTES = 8 * HTB, NXCD = 8, WGM = 8;

__host__ __device__ __forceinline__ int lds_byte(int r, int c) { const int st = (r >> 4) * 2 + (c >> 5), rr = r & 15, cc = c & 31, ob = rr * 64 + cc * 2; return st * 1024 + (ob ^ (((ob >> 9) & 1) << 5)); }
__host__ __device__ __forceinline__ void stage_rc(int b, int& R, int& C) { const int st = b / 1024, sb = b % 1024, swz = sb ^ (((sb >> 9) & 1) << 5); R = (st >> 1) * 16 + swz / 64; C = (st & 1) * 32 + (swz % 64) / 2; }
__host__ __device__ __forceinline__ int perm32(int rho) { const int n = rho >> 4, i = rho & 15; return 8 * (i >> 2) + 4 * n + (i & 3); }

struct Unit { int pm, pn; };
struct Gemm { const bf16_t* A; const bf16_t* Bt; int M, N, K; };

struct StaticOrder {
    int nM, nN, nwg, G, c;
    __host__ __device__ void init(int M, int N, int G_, int c_) { nM = M / BM; nN = N / BM; nwg = nM * nN; G = G_; c = c_; }
    __host__ __device__ bool next(int i, Unit& u) const {
        const long L = (long)i * G + c; if (L >= nwg) return false;
        int wgid = (int)L; { const int q = nwg / NXCD, r = nwg % NXCD, xcd = wgid % NXCD, off = wgid / NXCD; wgid = (xcd < r ? xcd * (q + 1) : r * (q + 1) + (xcd - r) * q) + off; }
        const int nig = WGM * nN, gid = wgid / nig, fm = gid * WGM, gsz = (nM - fm) < WGM ? (nM - fm) : WGM;
        u.pm = fm + ((wgid % nig) % gsz); u.pn = (wgid % nig) / gsz; return true;
    }
    __device__ __forceinline__ void a_ready(const Unit&) const {}
    __device__ __forceinline__ void done(const Unit&) const {}
};

typedef float f32x2 __attribute__((ext_vector_type(2)));
typedef unsigned u32x2 __attribute__((ext_vector_type(2)));
__device__ __forceinline__ unsigned cvt_pk_bf16(float lo, float hi) { typedef __bf16 bf16x2_t __attribute__((ext_vector_type(2))); f32x2 v = {lo, hi}; bf16x2_t b = __builtin_convertvector(v, bf16x2_t); return __builtin_bit_cast(unsigned, b); }
__device__ __forceinline__ float row_rstd(const float* ssq, int row, int fq) {
    const f32x4 p = *(const f32x4*)(ssq + (size_t)row * 16 + 4 * fq); float s = (p[0] + p[1]) + (p[2] + p[3]);
    s += __shfl_xor(s, 16); s += __shfl_xor(s, 32);
    return rsqrtf(s * (1.0f / 1024.0f) + 1e-6f);
}
struct EpiRes {
    static constexpr bool PERM = false, AFTER_DRAIN = false;
    const float* xin; float* xout; const float* gate  ; const float* gmul  ; bf16_t* xn; float* ssq;
    __device__ __forceinline__ void operator()(const f32x4 (&acc)[2][2][4][2], const Unit& u, int wr, int wc, int fr, int fq) const {
        const int b = u.pm >> 4, col0 = u.pn * BM + wc * 32 + 4 * fq; const int row0 = u.pm * BM + wr * 64 + fr;
        const unsigned eb = (unsigned)row0 * 1024u + (unsigned)col0;
        const char* xi = (const char*)xin; char* xo_ = (char*)xout; char* xn_ = (char*)xn; const bool has_gm = gmul != nullptr;
        float s[2][4];
#pragma unroll
        for (int ai = 0; ai < 2; ++ai)
#pragma unroll
            for (int m = 0; m < 4; ++m) s[ai][m] = 0.f;
#pragma unroll
        for (int bj = 0; bj < 2; ++bj)
#pragma unroll
            for (int n = 0; n < 2; ++n) { const unsigned c = (unsigned)(col0 + bj * HALF + n * 16); const f32x4 gv = *(const f32x4*)((const char*)gate + (((unsigned)b * 6144u + c) << 2));
                f32x4 gm = (f32x4){0.f, 0.f, 0.f, 0.f}; if (has_gm) gm = *(const f32x4*)((const char*)gmul + (((unsigned)b * 1024u + c) << 2));
#pragma unroll
                for (int ai = 0; ai < 2; ++ai)
#pragma unroll
                    for (int m = 0; m < 4; ++m) { const unsigned e = eb + (unsigned)((ai * HALF + m * 16) * 1024 + bj * HALF + n * 16);
                        const f32x4 xo = *(const f32x4*)(xi + (e << 2)); const f32x4 xw = xo + gv * acc[ai][bj][m][n];
                        *(f32x4*)(xo_ + (e << 2)) = xw; s[ai][m] += (xw[0] * xw[0] + xw[1] * xw[1]) + (xw[2] * xw[2] + xw[3] * xw[3]);
                        if (has_gm) { const f32x4 p = xw * gm; u32x2 w; w.x = cvt_pk_bf16(p[0], p[1]); w.y = cvt_pk_bf16(p[2], p[3]); *(u32x2*)(xn_ + (e << 1)) = w; } }
                asm volatile("" ::: "memory"); }
#pragma unroll
        for (int ai = 0; ai < 2; ++ai)
#pragma unroll
            for (int m = 0; m < 4; ++m) { float t = s[ai][m]; t += __shfl_xor(t, 16); t += __shfl_xor(t, 32);
                if (fq == 0) *(float*)((char*)ssq + ((((unsigned)(row0 + ai * HALF + m * 16)) * 16u + (unsigned)(u.pn * 4 + wc)) << 2)) = t; }
    }
};
struct EpiFF1 {
    static constexpr bool PERM = true, AFTER_DRAIN = false;
    bf16_t* O; const float* bias  ; const float* ssq;
    __device__ __forceinline__ void operator()(const f32x4 (&acc)[2][2][4][2], const Unit& u, int wr, int wc, int fr, int fq) const {
        const int b = u.pm >> 4, col0 = u.pn * BM + wc * 32 + 8 * fq;
        f32x4 bv[2][2];
#pragma unroll
        for (int bj = 0; bj < 2; ++bj)
#pragma unroll
            for (int n = 0; n < 2; ++n) bv[bj][n] = *(const f32x4*)(bias + b * 4096 + col0 + bj * HALF + 4 * n);
#pragma unroll
        for (int ai = 0; ai < 2; ++ai)
#pragma unroll
            for (int m = 0; m < 4; ++m) { const int row = u.pm * BM + ai * HALF + wr * 64 + m * 16 + fr; const float rs = row_rstd(ssq, row, fq); bf16_t* rowp = O + (size_t)row * 4096 + col0;
#pragma unroll
                for (int bj = 0; bj < 2; ++bj) { f32x4 v0 = acc[ai][bj][m][0] * rs + bv[bj][0], v1 = acc[ai][bj][m][1] * rs + bv[bj][1];
#pragma unroll
                    for (int j = 0; j < 4; ++j) { const float a = fmaxf(v0[j], 0.f), c = fmaxf(v1[j], 0.f); v0[j] = a * a; v1[j] = c * c; }
                    u32x4 w; w.x = cvt_pk_bf16(v0[0], v0[1]); w.y = cvt_pk_bf16(v0[2], v0[3]); w.z = cvt_pk_bf16(v1[0], v1[1]); w.w = cvt_pk_bf16(v1[2], v1[3]);
                    *(u32x4*)(rowp + bj * HALF) = w; } }
    }
};
struct EpiInDbg {
    static constexpr bool PERM = false, AFTER_DRAIN = false;
    bf16_t* zd; float* glog; const float* bias  ; const float* ssq;
    __device__ __forceinline__ void operator()(const f32x4 (&acc)[2][2][4][2], const Unit& u, int wr, int wc, int fr, int fq) const {
        const int b = u.pm >> 4, col0 = u.pn * BM + wc * 32 + 4 * fq; const int row0 = u.pm * BM + wr * 64 + fr;
#pragma unroll
        for (int ai = 0; ai < 2; ++ai)
#pragma unroll
            for (int m = 0; m < 4; ++m) { const int row = row0 + ai * HALF + m * 16; const float rs = row_rstd(ssq, row, fq);
#pragma unroll
                for (int bj = 0; bj < 2; ++bj)
#pragma unroll
                    for (int n = 0; n < 2; ++n) { const int c = col0 + bj * HALF + n * 16; const f32x4 bv = *(const f32x4*)(bias + b * 4096 + c); const f32x4 v = acc[ai][bj][m][n] * rs + bv;
                        const int code = in_src(c);
                        if (code >= 0) { bf16_t* p = zd + (size_t)row * DIN + code; p[0] = (bf16_t)f2bf(v[0]); p[1] = (bf16_t)f2bf(v[1]); p[2] = (bf16_t)f2bf(v[2]); p[3] = (bf16_t)f2bf(v[3]); }
                        else if (code <= -2) { float* p = glog + (size_t)row * 192 + (-(code + 2)); p[0] = v[0]; p[1] = v[1]; p[2] = v[2]; p[3] = v[3]; } }
                asm volatile("" ::: "memory"); }
    }
};
template <class Epi, class Sched, bool ALIGN_EPI = false, bool SP2 = false>
__device__ __forceinline__ void gemm_phase(PG8_LAS unsigned char* lds, const Gemm g, const Sched& S, const Epi& E) {
    int tid_ = threadIdx.x; asm volatile("" : "+v"(tid_));
    const int tid = tid_, wid = __builtin_amdgcn_readfirstlane(tid >> 6), lane = tid & 63, wr = wid >> 2, wc = wid & 3, fr = lane & 15, fq = lane >> 4;
    const int K = g.K, nt = K / BK;
    unsigned voffA[2], voffB[2];
#pragma unroll
    for (int i = 0; i < 2; ++i) { int R, C; stage_rc(tid * 16 + i * 8192, R, C); const int Rb = Epi::PERM ? ((R & ~31) + perm32(R & 31)) : R;
        voffA[i] = (unsigned)(R * K + C) * 2u; voffB[i] = (unsigned)(Rb * K + C) * 2u; }
    const size_t kstep = (size_t)(BK * 2);
    const size_t hstep = (size_t)HALF * K * 2;
    const size_t tstep = 2 * hstep;
    const unsigned ldsw = (unsigned)wid * 1024u;
    const int aoff = lds_byte(wr * 64 + fr, fq * 8), boff = lds_byte(wc * 32 + fr, fq * 8);
#define PG8_SA(b, h) (((b) * 2 + (h)) * HTB)
#define PG8_SB(b, h) ((4 + (b) * 2 + (h)) * HTB)
#define PG8_STAGE(bufoff, gbase, voff) do { _Pragma("unroll") for (int _i = 0; _i < 2; ++_i) \
        __builtin_amdgcn_global_load_lds((const unsigned*)((const char*)(gbase) + (voff)[_i]), (PG8_LAS unsigned*)(lds + (bufoff) + ldsw + _i * 8192), 16, 0, 0); } while (0)
#define PG8_LDA(dst, b, h) do { _Pragma("unroll") for (int m = 0; m < 4; ++m) _Pragma("unroll") for (int k = 0; k < 2; ++k) dst[m][k] = *(const PG8_LAS bf16x8*)(lds + PG8_SA(b, h) + aoff + m * 2048 + k * 1024); } while (0)
#define PG8_LDB(dst, b, h) do { _Pragma("unroll") for (int n = 0; n < 2; ++n) _Pragma("unroll") for (int k = 0; k < 2; ++k) dst[n][k] = *(const PG8_LAS bf16x8*)(lds + PG8_SB(b, h) + boff + n * 2048 + k * 1024); } while (0)
#define PG8_MMA(ai, bj, At, Bt) do { __builtin_amdgcn_s_setprio(1); _Pragma("unroll") for (int m = 0; m < 4; ++m) _Pragma("unroll") for (int n = 0; n < 2; ++n) _Pragma("unroll") for (int k = 0; k < 2; ++k) \
        acc[ai][bj][m][n] = __builtin_amdgcn_mfma_f32_16x16x32_bf16(Bt[n][k], At[m][k], acc[ai][bj][m][n], 0, 0, 0); __builtin_amdgcn_s_setprio(0); } while (0)
#define PG8_WAIT_V(n) asm volatile("s_waitcnt vmcnt(" #n ")" ::: "memory")
#define PG8_WAIT_L(n) asm volatile("s_waitcnt lgkmcnt(" #n ")" ::: "memory")
#define PG8_BAR __builtin_amdgcn_s_barrier()
#define PG8_SCHED __builtin_amdgcn_sched_barrier(0)
    Unit cur, nxt; int ui = 0;
    if (!S.next(0, cur)) return;
    f32x4 acc[2][2][4][2];
#pragma unroll
    for (int a = 0; a < 2; ++a)
#pragma unroll
        for (int b = 0; b < 2; ++b)
#pragma unroll
            for (int m = 0; m < 4; ++m)
#pragma unroll
                for (int n = 0; n < 2; ++n) acc[a][b][m][n] = (f32x4){0.f, 0.f, 0.f, 0.f};
    bf16x8 At[4][2], B0[2][2], B1[2][2];
    const char* cA = (const char*)g.A + (size_t)cur.pm * tstep; const char* cB = (const char*)g.Bt + (size_t)cur.pn * tstep;
    S.a_ready(cur);
    if constexpr (SP2) {
        PG8_STAGE(PG8_SB(0, 0), cB, voffB); PG8_STAGE(PG8_SB(0, 1), cB + hstep, voffB); PG8_STAGE(PG8_SA(0, 0), cA, voffA); PG8_STAGE(PG8_SA(0, 1), cA + hstep, voffA);
        if (wr == 1) PG8_BAR;
        PG8_WAIT_V(2); PG8_BAR;
        PG8_STAGE(PG8_SB(1, 0), cB + kstep, voffB); PG8_STAGE(PG8_SA(1, 0), cA + kstep, voffA); PG8_STAGE(PG8_SB(1, 1), cB + hstep + kstep, voffB);
        PG8_WAIT_V(6); PG8_BAR;
    } else {
        PG8_STAGE(PG8_SB(0, 0), cB, voffB); PG8_STAGE(PG8_SA(0, 0), cA, voffA); PG8_STAGE(PG8_SB(0, 1), cB + hstep, voffB); PG8_STAGE(PG8_SA(0, 1), cA + hstep, voffA);
        if (wr == 1) PG8_BAR;
        PG8_WAIT_V(4); PG8_BAR;
        PG8_STAGE(PG8_SB(1, 0), cB + kstep, voffB); PG8_STAGE(PG8_SA(1, 0), cA + kstep, voffA); PG8_STAGE(PG8_SB(1, 1), cB + hstep + kstep, voffB);
        PG8_WAIT_V(6); PG8_BAR;
    }
    for (;;) {
        const bool has_next = S.next(ui + 1, nxt);
        const char* nA = has_next ? (const char*)g.A + (size_t)nxt.pm * tstep : cA; const char* nB = has_next ? (const char*)g.Bt + (size_t)nxt.pn * tstep : cB;
        for (int t = 0; t < nt; t += 2) {
            const bool last = (t == nt - 2);
            const char* a1 = cA + (size_t)(t + 1) * kstep;
            const char* a2 = last ? nA : cA + (size_t)(t + 2) * kstep; const char* b2 = last ? nB : cB + (size_t)(t + 2) * kstep;
            const char* a3 = a2 + kstep; const char* b3 = b2 + kstep;
            if (last && has_next) S.a_ready(nxt);
            if constexpr (SP2) {
            PG8_LDB(B0, 0, 0); PG8_LDB(B1, 0, 1); PG8_SCHED; PG8_LDA(At, 0, 0); PG8_STAGE(PG8_SA(1, 1), a1 + hstep, voffA);
            PG8_WAIT_V(8); PG8_WAIT_L(0); PG8_BAR; PG8_MMA(0, 0, At, B0); PG8_MMA(0, 1, At, B1); PG8_BAR; PG8_SCHED;
            PG8_LDA(At, 0, 1); PG8_STAGE(PG8_SB(0, 0), b2, voffB); PG8_STAGE(PG8_SB(0, 1), b2 + hstep, voffB); PG8_STAGE(PG8_SA(0, 0), a2, voffA);
            PG8_WAIT_V(8); PG8_WAIT_L(0); PG8_BAR; PG8_MMA(1, 0, At, B0); PG8_MMA(1, 1, At, B1); PG8_BAR; PG8_SCHED;
            PG8_LDB(B0, 1, 0); PG8_LDB(B1, 1, 1); PG8_SCHED; PG8_LDA(At, 1, 0); PG8_STAGE(PG8_SA(0, 1), a2 + hstep, voffA);
            PG8_WAIT_V(8); PG8_WAIT_L(0); PG8_BAR; PG8_MMA(0, 0, At, B0); PG8_MMA(0, 1, At, B1); PG8_BAR; PG8_SCHED;
            PG8_LDA(At, 1, 1); PG8_STAGE(PG8_SB(1, 0), b3, voffB); PG8_STAGE(PG8_SB(1, 1), b3 + hstep, voffB); PG8_STAGE(PG8_SA(1, 0), a3, voffA);
            PG8_WAIT_V(8); PG8_WAIT_L(0); PG8_BAR; PG8_MMA(1, 0, At, B0); PG8_MMA(1, 1, At, B1); PG8_BAR; PG8_SCHED;
            } else {
            PG8_LDB(B0, 0, 0); PG8_SCHED; PG8_LDA(At, 0, 0); PG8_STAGE(PG8_SA(1, 1), a1 + hstep, voffA);
            PG8_WAIT_L(8); PG8_BAR; PG8_WAIT_L(0); PG8_MMA(0, 0, At, B0); PG8_BAR; PG8_SCHED;
            PG8_LDB(B1, 0, 1); PG8_STAGE(PG8_SB(0, 0), b2, voffB);
            PG8_BAR; PG8_WAIT_L(0); PG8_MMA(0, 1, At, B1); PG8_BAR;
            PG8_LDA(At, 0, 1); PG8_STAGE(PG8_SA(0, 0), a2, voffA);
            PG8_BAR; PG8_WAIT_L(0); PG8_MMA(1, 0, At, B0); PG8_BAR; PG8_SCHED;
            PG8_STAGE(PG8_SB(0, 1), b2 + hstep, voffB);
            PG8_WAIT_V(6); PG8_BAR; PG8_MMA(1, 1, At, B1); PG8_BAR;
            PG8_LDB(B0, 1, 0); PG8_SCHED; PG8_LDA(At, 1, 0); PG8_STAGE(PG8_SA(0, 1), a2 + hstep, voffA);
            PG8_WAIT_L(8); PG8_BAR; PG8_WAIT_L(0); PG8_MMA(0, 0, At, B0); PG8_BAR; PG8_SCHED;
            PG8_LDB(B1, 1, 1); PG8_STAGE(PG8_SB(1, 0), b3, voffB);
            PG8_BAR; PG8_WAIT_L(0); PG8_MMA(0, 1, At, B1); PG8_BAR;
            PG8_LDA(At, 1, 1); PG8_STAGE(PG8_SA(1, 0), a3, voffA);
            PG8_BAR; PG8_WAIT_L(0); PG8_MMA(1, 0, At, B0); PG8_BAR; PG8_SCHED;
            PG8_STAGE(PG8_SB(1, 1), b3 + hstep, voffB);
            PG8_WAIT_V(6); PG8_BAR; PG8_MMA(1, 1, At, B1); PG8_BAR;
            }
        }
        if constexpr (ALIGN_EPI) { if (wr == 0) PG8_BAR; }
        if constexpr (!Epi::AFTER_DRAIN) { E(acc, cur, wr, wc, fr, fq); S.done(cur); }
        if (!has_next) break;
#pragma unroll
        for (int a = 0; a < 2; ++a)
#pragma unroll
            for (int b = 0; b < 2; ++b)
#pragma unroll
                for (int m = 0; m < 4; ++m)
#pragma unroll
                    for (int n = 0; n < 2; ++n) acc[a][b][m][n] = (f32x4){0.f, 0.f, 0.f, 0.f};
        cur = nxt; cA = nA; cB = nB; ++ui;
        if constexpr (ALIGN_EPI) { if (wr == 1) PG8_BAR; }
    }
    PG8_WAIT_V(0);
    if constexpr (!ALIGN_EPI) { if (wr == 0) PG8_BAR; }
    PG8_BAR;
    if constexpr (Epi::AFTER_DRAIN) { E.fused(acc, cur, wr, wc, fr, fq, lds, wid, lane); S.done(cur); }
#undef PG8_SA
#undef PG8_SB
#undef PG8_STAGE
#undef PG8_LDA
#undef PG8_LDB
#undef PG8_MMA
#undef PG8_WAIT_V
#undef PG8_WAIT_L
#undef PG8_BAR
#undef PG8_SCHED
}
}
#define XB_TMO      128
#define XB_XCNT(j)  (256  + 64 * (j))
#define XB_XSUB(j)  (1280 + 64 * (j))
#define XB_XGEN(j)  (2304 + 64 * (j))
#define XB_TOP      3328
#define XB_TOPGEN   3392
#define XCD_BAR_WORDS 3456
#define XB_SPIN_CAP (1u << 18)

__device__ __forceinline__ unsigned xb_ld(unsigned* p)              { return __hip_atomic_load(p, __ATOMIC_RELAXED, __HIP_MEMORY_SCOPE_AGENT); }
__device__ __forceinline__ unsigned xb_add(unsigned* p, unsigned v) { return __hip_atomic_fetch_add(p, v, __ATOMIC_RELAXED, __HIP_MEMORY_SCOPE_AGENT); }
__device__ __forceinline__ unsigned xb_xcc_id() { return (unsigned)__builtin_amdgcn_s_getreg((3 << 11) | 20) & 0xFu; }
#define XB_SPIN(cond, bar) do { unsigned _sp = 0; while (cond) { __builtin_amdgcn_s_sleep(1); \
    if ((++_sp & 255u) == 0u) { if (xb_ld(&(bar)[XB_TMO])) break; if (_sp > XB_SPIN_CAP) { atomicAdd(&(bar)[XB_TMO], 1u); break; } } } } while (0)

struct XcdBarrier {
    unsigned* bar; unsigned x;
    volatile LAS unsigned* st;
};

__device__ __forceinline__ XcdBarrier xcd_barrier_post(unsigned* bar, volatile LAS unsigned* st) {
    XcdBarrier b; b.bar = bar; b.x = xb_xcc_id(); b.st = st;
    if (threadIdx.x == 0) (void)xb_add(&bar[XB_XCNT(b.x)], 1u);
    return b;
}
__device__ __forceinline__ void xcd_barrier_complete(unsigned* bar, unsigned x, unsigned& nloc, unsigned& nx) {
    const unsigned G = gridDim.x * gridDim.y * gridDim.z;
    unsigned sum, cnt, mine, sp = 0u;
    for (;;) {
        sum = 0u; cnt = 0u; mine = 0u;
#pragma unroll
        for (unsigned j = 0; j < 16; ++j) { const unsigned c = xb_ld(&bar[XB_XCNT(j)]); sum += c; cnt += (c > 0u) ? 1u : 0u; mine = (j == x) ? c : mine; }
        if (sum == G) break;
        __builtin_amdgcn_s_sleep(1);
        if ((++sp & 255u) == 0u) { if (xb_ld(&bar[XB_TMO])) break; if (sp > XB_SPIN_CAP) { atomicAdd(&bar[XB_TMO], 1u); break; } }
    }
    nloc = mine > 0u ? mine : 1u; nx = cnt > 0u ? cnt : 1u;
}

__device__ __forceinline__ void xcd_barrier(const XcdBarrier& b) {
    asm volatile("s_waitcnt vmcnt(0)" ::: "memory");
    __syncthreads();
    if (threadIdx.x == 0) {
        unsigned* bar = b.bar;
        __builtin_amdgcn_s_waitcnt(0);
        unsigned nloc = b.st[0], nx = b.st[1];
        if (nloc == 0u) { xcd_barrier_complete(bar, b.x, nloc, nx); b.st[0] = nloc; b.st[1] = nx; }
        const unsigned old = xb_add(&bar[XB_XSUB(b.x)], 1u);
        const unsigned gen = old / nloc;
        if (old + 1u == (gen + 1u) * nloc) {
            __builtin_amdgcn_fence(__ATOMIC_RELEASE, "agent");
            asm volatile("s_waitcnt vmcnt(0)" ::: "memory");
            const unsigned og = xb_add(&bar[XB_TOP], 1u);
            const unsigned tg = og / nx;
            if (og + 1u == (tg + 1u) * nx) xb_add(&bar[XB_TOPGEN], 1u);
            else XB_SPIN(xb_ld(&bar[XB_TOPGEN]) == tg, bar);
            __builtin_amdgcn_fence(__ATOMIC_ACQUIRE, "agent");
            xb_add(&bar[XB_XGEN(b.x)], 1u);
            asm volatile("s_waitcnt vmcnt(0)" ::: "memory");
        } else {
            XB_SPIN(xb_ld(&bar[XB_XGEN(b.x)]) == gen, bar);
            __builtin_amdgcn_fence(__ATOMIC_ACQUIRE, "agent");
            asm volatile("s_waitcnt vmcnt(0)" ::: "memory");
        }
    }
    __syncthreads();
}
constexpr int NWAVES = 8;
constexpr int RING_BYTES = 131072, MISC_OFF = RING_BYTES + 320, LDS_BYTES = 147456;
#define LDS_WAIT() asm volatile("s_waitcnt lgkmcnt(0)" ::: "memory")
#define VM_WAIT() asm volatile("s_waitcnt vmcnt(0)" ::: "memory")

struct Args { const float* in[19]; float* out; unsigned char* ws; int ph_lo, ph_hi, li, pad; };
enum { I_X = 0, I_C, I_WADA, I_BADA, I_NMIX, I_NMLP, I_WIN, I_GWG, I_GBG, I_GNORM, I_LBL, I_HNORM, I_MCONV, I_MGB, I_MNORM, I_WOUT, I_WFF1, I_WFF2, I_FNORM };

__device__ __forceinline__ void phase_p0a(const Args& a, LAS unsigned char* lds, int tid) {
    LAS float* cond = (LAS float*)lds;
    const float* c = a.in[I_C];
    for (int i = tid; i < NB * D; i += NWAVES * 64) cond[i] = siluf_(c[i]);
    __syncthreads();
    float* modp = (float*)(a.ws + WS_U);
    const float* w_ada = a.in[I_WADA];
    const int G = gridDim.x;
    for (int t = blockIdx.x * (NWAVES * 64) + tid; t < L * 16 * 1536; t += G * NWAVES * 64) {
        const int n4 = t % 1536, kc = (t / 1536) % 16, l = t / (1536 * 16);
        const float* w = w_ada + ((size_t)l * D + kc * 64) * (6 * D) + n4 * 4;
        f32x4 acc[4];
#pragma unroll
        for (int b = 0; b < 4; ++b) acc[b] = (f32x4){0.f, 0.f, 0.f, 0.f};
#pragma unroll 8
        for (int k = 0; k < 64; ++k) { const f32x4 wv = *(const f32x4*)(w + (size_t)k * (6 * D));
#pragma unroll
            for (int b = 0; b < 4; ++b) acc[b] += cond[b * D + kc * 64 + k] * wv; }
#pragma unroll
        for (int b = 0; b < 4; ++b) *(f32x4*)(&modp[((size_t)kc * L * NB + l * NB + b) * 6 * D + n4 * 4]) = acc[b];
    }
    __syncthreads();
}
__device__ __forceinline__ void phase_p0b(const Args& a, int tid) {
    const float* modp = (const float*)(a.ws + WS_U); float* mod = (float*)(a.ws + WS_MOD); const float* b_ada = a.in[I_BADA];
    for (int i = blockIdx.x * (NWAVES * 64) + tid; i < L * NB * 1536; i += gridDim.x * NWAVES * 64) {
        const int n4 = i % 1536, lb_ = i / 1536, l = lb_ / NB;
        f32x4 s = *(const f32x4*)(b_ada + l * 6 * D + n4 * 4);
#pragma unroll
        for (int kc = 0; kc < 16; ++kc) s += *(const f32x4*)(&modp[((size_t)kc * L * NB + lb_) * 6 * D + n4 * 4]);
        *(f32x4*)(&mod[(size_t)lb_ * 6 * D + n4 * 4]) = s;
    }
    if (blockIdx.x == 0 && tid < 384) {
        const float* logits = a.in[I_LBL]; float* lb = (float*)(a.ws + WS_LB);
        float v0 = logits[tid], v1 = logits[384 + tid], v2 = logits[768 + tid], v3 = logits[1152 + tid];
        const float mx = fmaxf(fmaxf(v0, v1), fmaxf(v2, v3));
        v0 = __expf(v0 - mx); v1 = __expf(v1 - mx); v2 = __expf(v2 - mx); v3 = __expf(v3 - mx);
        const float inv = 1.f / (v0 + v1 + v2 + v3);
        lb[tid] = 0.f; lb[384 + tid] = v1 * inv; lb[768 + tid] = (v1 + v2) * inv; lb[1152 + tid] = (v1 + v2 + v3) * inv;
    }
}

__device__ __forceinline__ void conv_item(const Args& a, int it, LAS float* scr, int lane) {
    const int l = it / 416, r = it % 416;
    int kind, nb, kpart = 0;
    if (r < 128) { kind = 0; nb = r; } else if (r < 160) { kind = 1; nb = r - 128; } else if (r < 288) { kind = 2; nb = r - 160; } else { kind = 3; nb = (r - 288) >> 2; kpart = (r - 288) & 3; }
    const float* W; int N, K; bf16* WT; unsigned char* wl = a.ws + WS_W + (size_t)l * W_LAYER;
    if (kind == 0) { W = a.in[I_WIN] + (size_t)l * D * DIN; N = DIN; K = D; WT = (bf16*)(wl + W_IN); }
    else if (kind == 1) { W = a.in[I_WOUT] + (size_t)l * D * D; N = D; K = D; WT = (bf16*)(wl + W_OUT); }
    else if (kind == 2) { W = a.in[I_WFF1] + (size_t)l * D * DFF; N = DFF; K = D; WT = (bf16*)(wl + W_1); }
    else { W = a.in[I_WFF2] + (size_t)l * DFF * D; N = D; K = DFF; WT = (bf16*)(wl + W_2); }
    const int n0 = nb * 32, nl = lane & 31, kh = lane >> 5;
    int code = n0 + nl; if (kind == 0) code = in_src(n0 + nl);
    float wg[16];
#pragma unroll
    for (int q = 0; q < 16; ++q) wg[q] = 0.f;
    if (code <= -2) { const int ch = -(code + 2); const float* g = a.in[I_GWG] + (size_t)l * 16 * 192 + ch;
#pragma unroll
        for (int q = 0; q < 16; ++q) wg[q] = g[q * 192]; }
    const bool want_bias = (kind == 0 || kind == 2);
    const float* shiftp = (const float*)(a.ws + WS_MOD) + (size_t)l * NB * 6 * D + (kind == 0 ? 0 : 3) * D;
    float ab0 = 0.f, ab1 = 0.f, ab2 = 0.f, ab3 = 0.f;
    for (int kt = 0; kt < 16; ++kt) {
        const int k0 = kpart * 1024 + kt * 64;
#pragma unroll 4
        for (int i = 0; i < 32; ++i) { const int kk = 2 * i + kh; const float* wr_ = W + (size_t)(k0 + kk) * N;
            float v;
            if (code >= 0) v = wr_[code];
            else if (code == -1) v = 0.f;
            else { const f32x4 g0 = *(const f32x4*)(wr_ + GLOW), g1 = *(const f32x4*)(wr_ + GLOW + 4), g2 = *(const f32x4*)(wr_ + GLOW + 8), g3 = *(const f32x4*)(wr_ + GLOW + 12);
                v = g0[0] * wg[0] + g0[1] * wg[1] + g0[2] * wg[2] + g0[3] * wg[3] + g1[0] * wg[4] + g1[1] * wg[5] + g1[2] * wg[6] + g1[3] * wg[7]
                  + g2[0] * wg[8] + g2[1] * wg[9] + g2[2] * wg[10] + g2[3] * wg[11] + g3[0] * wg[12] + g3[1] * wg[13] + g3[2] * wg[14] + g3[3] * wg[15]; }
            scr[kk * 33 + nl] = v;
            if (want_bias) { const float* sp = shiftp + k0 + kk; ab0 += sp[0] * v; ab1 += sp[6 * D] * v; ab2 += sp[12 * D] * v; ab3 += sp[18 * D] * v; } }
        LDS_WAIT(); asm volatile("" ::: "memory");
        const int c = lane & 7;
#pragma unroll
        for (int j = 0; j < 4; ++j) { const int n = (lane >> 3) + 8 * j; const LAS float* s = scr + (8 * c) * 33 + n;
            v4u o; o.x = pk2(s[0 * 33], s[1 * 33]); o.y = pk2(s[2 * 33], s[3 * 33]); o.z = pk2(s[4 * 33], s[5 * 33]); o.w = pk2(s[6 * 33], s[7 * 33]);
            *(GAS v4u*)(WT + (size_t)(n0 + n) * K + k0 + 8 * c) = o; }
        LDS_WAIT(); asm volatile("" ::: "memory");
    }
    if (want_bias) {
        ab0 += __shfl_xor(ab0, 32); ab1 += __shfl_xor(ab1, 32); ab2 += __shfl_xor(ab2, 32); ab3 += __shfl_xor(ab3, 32);
        if (lane < 32) { float* bias = (float*)(a.ws + WS_BIAS) + (kind == 0 ? 0 : (size_t)L * NB * 4096) + (size_t)l * NB * 4096 + n0 + lane;
            bias[0] = ab0; bias[4096] = ab1; bias[8192] = ab2; bias[12288] = ab3; }
    }
}
__device__ __forceinline__ void phase_p1(const Args& a, LAS unsigned char* lds, int tid, int lane, int wave) {
    const int G = gridDim.x, gw = blockIdx.x * NWAVES + wave, NGW = G * NWAVES;
    const float* mod = (const float*)(a.ws + WS_MOD);
    { float* gm = (float*)(a.ws + WS_GMUL);
      for (int i = blockIdx.x * (NWAVES * 64) + tid; i < L * 2 * NB * D; i += G * NWAVES * 64) { const int k = i & 1023, b = (i >> 10) & 3, w = (i >> 12) & 1, l = i >> 13;
          const float gain = (w ? a.in[I_NMLP] : a.in[I_NMIX])[l * D + k]; gm[i] = gain * (1.f + mod[(size_t)(l * NB + b) * 6 * D + (w ? 4 : 1) * D + k]); } }
    { const float* x = a.in[I_X]; bf16* xn = (bf16*)(a.ws + WS_XN); float* ssq = (float*)(a.ws + WS_SSQ); const float* nm = a.in[I_NMIX];
      for (int row = gw; row < M; row += NGW) { const int b = row >> 12; const GAS f32x4* xr = (const GAS f32x4*)(x + (size_t)row * D) + lane; float s = 0.f;
          GAS unsigned long long* o8 = (GAS unsigned long long*)(xn + (size_t)row * D) + lane;
#pragma unroll
          for (int j = 0; j < 4; ++j) { const f32x4 v = xr[64 * j]; s += (v[0] * v[0] + v[1] * v[1]) + (v[2] * v[2] + v[3] * v[3]); const int k = 4 * lane + 256 * j;
              const f32x4 g = *(const f32x4*)(nm + k); const f32x4 sc = *(const f32x4*)(mod + (size_t)b * 6 * D + D + k); const f32x4 p = v * g * (sc + 1.f);
              o8[64 * j] = (unsigned long long)pk2(p[0], p[1]) | ((unsigned long long)pk2(p[2], p[3]) << 32); }
          s = wave_sum(s);
          if (lane < 16) ssq[(size_t)row * 16 + lane] = (lane == 0) ? s : 0.f; } }
    { LAS float* scr = (LAS float*)(lds + wave * 16384);
      for (int it = gw; it < L * 416; it += NGW) conv_item(a, it, scr, lane); }
}
__device__ __forceinline__ void phase_final(const Args& a, int lane, int wave) {
    const int gw = blockIdx.x * NWAVES + wave, NGW = gridDim.x * NWAVES; const float* fn = a.in[I_FNORM];
    for (int row = gw; row < M; row += NGW) { GAS f32x4* xr = (GAS f32x4*)(a.out + (size_t)row * D) + lane; f32x4 v[4]; float s = 0.f;
#pragma unroll
        for (int j = 0; j < 4; ++j) { v[j] = xr[64 * j]; s += (v[j][0] * v[j][0] + v[j][1] * v[j][1]) + (v[j][2] * v[j][2] + v[j][3] * v[j][3]); }
        const float rs = rsqrtf(wave_sum(s) * (1.f / D) + EPS);
#pragma unroll
        for (int j = 0; j < 4; ++j) { const f32x4 g = *(const f32x4*)(fn + 4 * lane + 256 * j); xr[64 * j] = v[j] * rs * g; } }
}
__device__ __forceinline__ void mixer_ref(const Args& a, int l, LAS float* sh  , int lane, int bh) {
    const bf16* z = (const bf16*)(a.ws + WS_Z); const float* glog = (const float*)(a.ws + WS_U); bf16* mixed = (bf16*)(a.ws + WS_MIX);
    const int b = bh / 16, head = bh % 16;
    if (head < 12) {
        const bool gla = head < 6; const int hh = gla ? head : head - 6; const int K = gla ? 32 : 64;
        float St[64];
#pragma unroll
        for (int c = 0; c < 64; ++c) St[c] = 0.f;
        const float lbv = gla ? 0.f : ((const float*)(a.ws + WS_LB))[l * 384 + hh * 64 + lane];
        const float bg = (gla && lane < 32) ? a.in[I_GBG][l * 192 + hh * 32 + lane] : 0.f;
        const float gn = gla ? a.in[I_GNORM][l * 64 + lane] : a.in[I_HNORM][l * 64 + lane];
        for (int t = 0; t < S; ++t) { const size_t row = (size_t)b * S + t; const bf16* zr = z + row * DIN;
            float q, kk, dec;
            if (gla) { if (lane < 32) { q = bf2f(zr[GQ + hh * 32 + lane]) * 0.17677669529663687f; kk = bf2f(zr[GK + hh * 32 + lane]);
                    dec = __expf(logsigmoidf_(glog[row * 192 + hh * 32 + lane] + bg) * (1.f / 16.f)); } else { q = 0.f; kk = 0.f; dec = 0.f; } }
            else { q = siluf_(bf2f(zr[HQ + hh * 64 + lane])); const float f = bf2f(zr[HF + hh * 64 + lane]); dec = lbv + (1.f - lbv) * sigmoidf_(f); kk = (1.f - lbv) * sigmoidf_(-f); }
            asm volatile("" ::: "memory");
            sh[lane] = q; sh[64 + lane] = kk; sh[128 + lane] = dec;
            asm volatile("s_waitcnt lgkmcnt(0)" ::: "memory");
            const float v = bf2f(zr[(gla ? GV : HI) + hh * 64 + lane]); float o = 0.f;
#pragma unroll
            for (int c = 0; c < 64; ++c) if (c < K) { St[c] = sh[128 + c] * St[c] + sh[64 + c] * v; o += St[c] * sh[c]; }
            const float ms = wave_sum(o * o) * (1.f / 64.f); const float g = bf2f(zr[(gla ? GOUT : HOUT) + hh * 64 + lane]);
            mixed[row * D + (gla ? 0 : 384) + hh * 64 + lane] = (bf16)f2bf(o * rsqrtf(ms + EPS) * gn * (gla ? siluf_(g) : sigmoidf_(g)));
            asm volatile("s_waitcnt lgkmcnt(0)" ::: "memory");
        }
    } else {
        const int mh = head - 12; float Cst[64];
#pragma unroll
        for (int d = 0; d < 64; ++d) Cst[d] = 0.f;
        float nst = 0.f; const float* conv = a.in[I_MCONV] + (size_t)l * 4 * 512; const float* gb = a.in[I_MGB] + l * 8;
        const float wq0 = conv[mh * 64 + lane], wq1 = conv[512 + mh * 64 + lane], wq2 = conv[1024 + mh * 64 + lane], wq3 = conv[1536 + mh * 64 + lane];
        const float wk0 = conv[256 + mh * 64 + lane], wk1 = conv[768 + mh * 64 + lane], wk2 = conv[1280 + mh * 64 + lane], wk3 = conv[1792 + mh * 64 + lane];
        const float gbi = gb[mh], gbf = gb[4 + mh], mn = a.in[I_MNORM][l * 256 + mh * 64 + lane];
        float q0 = 0.f, q1 = 0.f, q2 = 0.f, k0 = 0.f, k1 = 0.f, k2 = 0.f;
        for (int t = 0; t < S; ++t) { const size_t row = (size_t)b * S + t; const bf16* zr = z + row * DIN;
            const float qp = bf2f(zr[MQK + mh * 64 + lane]), kp = bf2f(zr[MQK + 256 + mh * 64 + lane]);
            const float q = siluf_(wq0 * q0 + wq1 * q1 + wq2 * q2 + wq3 * qp), kk = siluf_(wk0 * k0 + wk1 * k1 + wk2 * k2 + wk3 * kp) * 0.125f;
            q0 = q1; q1 = q2; q2 = qp; k0 = k1; k1 = k2; k2 = kp;
            const float li = bf2f(zr[MI + mh]) + gbi, lf = logsigmoidf_(bf2f(zr[MF + mh]) + gbf); const float ig = __expf(li), fg = __expf(lf);
            nst = fg * nst + ig * kk; const float den = wave_sum(nst * q);
            asm volatile("" ::: "memory");
            sh[lane] = q; sh[64 + lane] = kk;
            asm volatile("s_waitcnt lgkmcnt(0)" ::: "memory");
            const float v = bf2f(zr[MV + mh * 64 + lane]); float num = 0.f;
#pragma unroll
            for (int d = 0; d < 64; ++d) { Cst[d] = fg * Cst[d] + ig * v * sh[64 + d]; num += Cst[d] * sh[d]; }
            const float hv = num / fmaxf(fabsf(den), 1.f); const float mu = wave_sum(hv) * (1.f / 64.f); const float hc = hv - mu; const float var = wave_sum(hc * hc) * (1.f / 64.f);
            const float g = bf2f(zr[MOUT + mh * 64 + lane]);
            mixed[row * D + 768 + mh * 64 + lane] = (bf16)f2bf(hc * rsqrtf(var + EPS) * mn * sigmoidf_(g));
            asm volatile("s_waitcnt lgkmcnt(0)" ::: "memory");
        }
    }
}

constexpr int NPL = 5;
constexpr int NPRE = 3;
constexpr int NPH = NPRE + NPL * L + 1;
#ifndef MK_ONE_LAUNCH
#define MK_ONE_LAUNCH 1
#endif
__global__ void __launch_bounds__(NWAVES * 64, 2) mk_fwd(Args args) {
    extern __shared__ __attribute__((aligned(16))) unsigned char lds_raw[];
    LAS unsigned char* lds = (LAS unsigned char*)lds_raw;
    volatile LAS unsigned* MISC = (volatile LAS unsigned*)(lds + MISC_OFF);
    const int tid0 = threadIdx.x;
    for (int u = tid0; u < (LDS_BYTES - RING_BYTES) / 4; u += NWAVES * 64) ((LAS unsigned*)(lds + RING_BYTES))[u] = 0u;
    __syncthreads();
    unsigned* ctl = (unsigned*)(args.ws + WS_CTL);
    XcdBarrier bar; bar.bar = ctl + 4096; bar.x = 0; bar.st = nullptr;
    if (args.ph_hi - args.ph_lo > 1) bar = xcd_barrier_post(ctl + 4096, MISC + 8);
    unsigned char* ws = args.ws;
    for (int p = args.ph_lo; p < args.ph_hi; ++p) {
        int tid = tid0; asm volatile("" : "+v"(tid));
        const int lane = tid & 63, wave = __builtin_amdgcn_readfirstlane(tid >> 6);
        if (p == 0) phase_p0a(args, lds, tid);
        else if (p == 1) phase_p0b(args, tid);
        else if (p == 2) phase_p1(args, lds, tid, lane, wave);
        else if (p == NPH - 1) phase_final(args, lane, wave);
        else {
            const int l = (p - NPRE) / NPL, j = (p - NPRE) % NPL;
            unsigned char* wl = ws + WS_W + (size_t)l * W_LAYER;
            const float* mod_l = (const float*)(ws + WS_MOD) + (size_t)l * NB * 6 * D;
            float* ssq = (float*)(ws + WS_SSQ);
            if (j == 0) {
                pg8::Gemm g{(const bf16*)(ws + WS_XN), (const bf16*)(wl + W_IN), M, NIN, D}; pg8::StaticOrder S; S.init(M, NIN, gridDim.x, (int)blockIdx.x);
                pg8::EpiInDbg E{(bf16*)(ws + WS_Z), (float*)(ws + WS_U), (const float*)(ws + WS_BIAS) + (size_t)l * NB * 4096, ssq};
                pg8::gemm_phase<pg8::EpiInDbg, pg8::StaticOrder, true, true>(lds, g, S, E);
            } else if (j == 1) {
                if (wave == 0) { for (int bh = blockIdx.x; bh < 64; bh += gridDim.x) mixer_ref(args, l, (LAS float*)(lds), lane, bh); }
            } else if (j == 2) {
                pg8::Gemm g{(const bf16*)(ws + WS_MIX), (const bf16*)(wl + W_OUT), M, D, D}; pg8::StaticOrder S; S.init(M, D, gridDim.x, (int)blockIdx.x);
                pg8::EpiRes E{l == 0 ? args.in[I_X] : args.out, args.out, mod_l + 2 * D, (const float*)(ws + WS_GMUL) + (size_t)(l * 2 + 1) * NB * D, (bf16*)(ws + WS_XN), ssq};
                pg8::gemm_phase<pg8::EpiRes, pg8::StaticOrder, true, true>(lds, g, S, E);
            } else if (j == 3) {
                pg8::Gemm g{(const bf16*)(ws + WS_XN), (const bf16*)(wl + W_1), M, DFF, D}; pg8::StaticOrder S; S.init(M, DFF, gridDim.x, (int)blockIdx.x);
                pg8::EpiFF1 E{(bf16*)(ws + WS_Z), (const float*)(ws + WS_BIAS) + (size_t)(L + l) * NB * 4096, ssq};
                pg8::gemm_phase<pg8::EpiFF1, pg8::StaticOrder, true, true>(lds, g, S, E);
            } else {
                pg8::Gemm g{(const bf16*)(ws + WS_Z), (const bf16*)(wl + W_2), M, D, DFF}; pg8::StaticOrder S; S.init(M, D, gridDim.x, (int)blockIdx.x);
                pg8::EpiRes E{args.out, args.out, mod_l + 5 * D, l + 1 < L ? (const float*)(ws + WS_GMUL) + (size_t)((l + 1) * 2) * NB * D : nullptr, (bf16*)(ws + WS_XN), ssq};
                pg8::gemm_phase<pg8::EpiRes, pg8::StaticOrder, true, true>(lds, g, S, E);
            }
        }
        if (p + 1 < args.ph_hi) xcd_barrier(bar);
    }
}

extern "C" void kernel_launch(void* const* d_in, const int* in_sizes, int n_in, void* d_out, int out_size, void* d_ws, size_t ws_size, hipStream_t stream) {
    static int grid = 0;
    if (grid == 0) {
        if (n_in != 19 || out_size != M * D || ws_size < WS_END) { fprintf(stderr, "kernel_launch: unexpected shapes (n_in %d out %d ws %zu)\n", n_in, out_size, ws_size); grid = -1; return; }
        int dev = 0, cus = 0, per_cu = 0;
        if (hipGetDevice(&dev) != hipSuccess || hipDeviceGetAttribute(&cus, hipDeviceAttributeMultiprocessorCount, dev) != hipSuccess) { grid = -1; return; }
        if (hipFuncSetAttribute((const void*)mk_fwd, hipFuncAttributeMaxDynamicSharedMemorySize, LDS_BYTES) != hipSuccess) { fprintf(stderr, "kernel_launch: hipFuncSetAttribute failed\n"); grid = -1; return; }
        if (hipOccupancyMaxActiveBlocksPerMultiprocessor(&per_cu, (const void*)mk_fwd, NWAVES * 64, LDS_BYTES) != hipSuccess || per_cu < 1) { fprintf(stderr, "kernel_launch: occupancy query says %d blocks/CU\n", per_cu); grid = -1; (void)hipGetLastError(); return; }
        grid = cus;
    }
    if (grid < 0) return;
    (void)hipMemsetAsync((char*)d_ws + WS_CTL, 0, CTL_ZERO_BYTES, stream);
    Args a{};
    for (int i = 0; i < 19; ++i) a.in[i] = (const float*)d_in[i];
    a.out = (float*)d_out; a.ws = (unsigned char*)d_ws;
#if MK_ONE_LAUNCH
    a.ph_lo = 0; a.ph_hi = NPH; a.li = 0;
    hipLaunchKernelGGL(mk_fwd, dim3(grid), dim3(NWAVES * 64), LDS_BYTES, stream, a);
#else
    for (int p = 0; p < NPH; ++p) { a.ph_lo = p; a.ph_hi = p + 1; a.li = 0; hipLaunchKernelGGL(mk_fwd, dim3(grid), dim3(NWAVES * 64), LDS_BYTES, stream, a); }
#endif
}
```

```cpp
#include <hip/hip_runtime.h>
#include <cstdint>
#include <cstdio>

namespace cfg {
constexpr int D = 1024, NB = 4, S = 4096, L = 4, M = NB * S, DIN = 3736, DFF = 4096, NIN = 4096  ;
constexpr int GQ = 0, GK = 192, GV = 384, GLOW = 768, GOUT = 784, HQ = 1168, HF = 1552, HI = 1936, HOUT = 2320,
              MQK = 2704, MV = 3216, MI = 3472, MF = 3476, MOUT = 3480;
constexpr float EPS = 1e-6f;
constexpr size_t MiB = 1u << 20;
constexpr size_t WS_CTL = 0, CTL_ZERO_BYTES = 1 * MiB;
constexpr size_t WS_MOD = 256 * 1024;
constexpr size_t WS_LB = 1 * MiB;
constexpr size_t WS_GMUL = 1 * MiB + 64 * 1024;
constexpr size_t WS_BIAS = 2 * MiB;
constexpr size_t WS_MG = 3 * MiB;
constexpr size_t WS_SSQ = 4 * MiB;
constexpr size_t WS_VEC = 5 * MiB;
constexpr size_t WS_W = 8 * MiB, W_LAYER = 26 * MiB;
constexpr size_t W_IN = 0, W_OUT = 8 * MiB, W_1 = 10 * MiB, W_2 = 18 * MiB;
constexpr size_t WS_XN = 112 * MiB;
constexpr size_t WS_MIX = 144 * MiB;
constexpr size_t WS_Z = 176 * MiB;
constexpr size_t WS_U = 304 * MiB;
constexpr size_t WS_END = 356 * MiB;
}
using namespace cfg;

#define GAS __attribute__((address_space(1)))
#define LAS __attribute__((address_space(3)))
typedef unsigned short bf16;
typedef unsigned v4u __attribute__((ext_vector_type(4)));
typedef unsigned v2u __attribute__((ext_vector_type(2)));
typedef float f32x4 __attribute__((ext_vector_type(4)));
typedef float f32x16 __attribute__((ext_vector_type(16)));
typedef short bf16x8 __attribute__((ext_vector_type(8)));
typedef GAS unsigned gu32;
#define RLX_AGENT __ATOMIC_RELAXED, __HIP_MEMORY_SCOPE_AGENT

__device__ __forceinline__ unsigned f2bf(float f) { unsigned u = __builtin_bit_cast(unsigned, f); return (u + 0x7fffu + ((u >> 16) & 1u)) >> 16; }
__device__ __forceinline__ unsigned pk2(float lo, float hi) { return f2bf(lo) | (f2bf(hi) << 16); }
__device__ __forceinline__ float bf2f(unsigned short h) { return __builtin_bit_cast(float, (unsigned)h << 16); }
__device__ __forceinline__ float sigmoidf_(float x) { return 1.f / (1.f + __expf(-x)); }
__device__ __forceinline__ float siluf_(float x) { return x * sigmoidf_(x); }
__device__ __forceinline__ float logsigmoidf_(float x) { return fminf(x, 0.f) - log1pf(__expf(-fabsf(x))); }
__device__ __forceinline__ float wave_sum(float v) {
#pragma unroll
    for (int o = 1; o < 64; o <<= 1) v += __shfl_xor(v, o);
    return v;
}
__host__ __device__ __forceinline__ int in_src(int np) {
    const int pn = np >> 8, tc = np & 255, bj = tc >> 7, wc = (tc >> 5) & 3, n = (tc >> 4) & 1, g = tc & 15;
    if (pn < 6) { const int gh = pn;
        if (wc < 2) { const int c = 16 * wc + g;
            if (bj == 0) return (n == 0 ? GQ : GK) + gh * 32 + c;
            if (n == 0) return -2 - (gh * 32 + c);
            if (gh == 0 && wc == 0 && g < 8) return (g < 4) ? MI + g : MF + (g - 4);
            return -1; }
        const int e = 32 * (wc - 2) + 16 * n + g; return (bj == 0 ? GV : GOUT) + gh * 64 + e; }
    if (pn < 12) { const int hh = pn - 6, c = 16 * wc + g; const int base = bj == 0 ? (n == 0 ? HQ : HF) : (n == 0 ? HI : HOUT); return base + hh * 64 + c; }
    const int mh = pn - 12, grp = tc >> 6, c = tc & 63;
    return (grp == 0 ? MQK : grp == 1 ? MQK + 256 : grp == 2 ? MV : MOUT) + mh * 64 + c;
}
namespace pg8 {
#define PG8_LAS __attribute__((address_space(3)))
typedef unsigned short bf16_t;
typedef short bf16x8 __attribute__((ext_vector_type(8)));
typedef float f32x4 __attribute__((ext_vector_type(4)));
typedef unsigned u32x4 __attribute__((ext_vector_type(4)));
constexpr int BM = 256, BK = 64, HALF = 128, HTB = HALF * BK * 2  , STAGE_BYTES = 8 * HTB, NXCD = 8, WGM = 8;

__host__ __device__ __forceinline__ int lds_byte(int r, int c) { const int st = (r >> 4) * 2 + (c >> 5), rr = r & 15, cc = c & 31, ob = rr * 64 + cc * 2; return st * 1024 + (ob ^ (((ob >> 9) & 1) << 5)); }
__host__ __device__ __forceinline__ void stage_rc(int b, int& R, int& C) { const int st = b / 1024, sb = b % 1024, swz = sb ^ (((sb >> 9) & 1) << 5); R = (st >> 1) * 16 + swz / 64; C = (st & 1) * 32 + (swz % 64) / 2; }
__host__ __device__ __forceinline__ int perm32(int rho) { const int n = rho >> 4, i = rho & 15; return 8 * (i >> 2) + 4 * n + (i & 3); }

struct Unit { int pm, pn; };
struct Gemm { const bf16_t* A; const bf16_t* Bt; int M, N, K; };

struct StaticOrder {
    int nM, nN, nwg, G, c;
    __host__ __device__ void init(int M, int N, int G_, int c_) { nM = M / BM; nN = N / BM; nwg = nM * nN; G = G_; c = c_; }
    __host__ __device__ bool next(int i, Unit& u) const {
        const long L = (long)i * G + c; if (L >= nwg) return false;
        int wgid = (int)L; { const int q = nwg / NXCD, r = nwg % NXCD, xcd = wgid % NXCD, off = wgid / NXCD; wgid = (xcd < r ? xcd * (q + 1) : r * (q + 1) + (xcd - r) * q) + off; }
        const int nig = WGM * nN, gid = wgid / nig, fm = gid * WGM, gsz = (nM - fm) < WGM ? (nM - fm) : WGM;
        u.pm = fm + ((wgid % nig) % gsz); u.pn = (wgid % nig) / gsz; return true;
    }
    __device__ __forceinline__ void a_ready(const Unit&) const {}
    __device__ __forceinline__ void done(const Unit&) const {}
};

typedef float f32x2 __attribute__((ext_vector_type(2)));
typedef unsigned u32x2 __attribute__((ext_vector_type(2)));
__device__ __forceinline__ unsigned cvt_pk_bf16(float lo, float hi) { typedef __bf16 bf16x2_t __attribute__((ext_vector_type(2))); f32x2 v = {lo, hi}; bf16x2_t b = __builtin_convertvector(v, bf16x2_t); return __builtin_bit_cast(unsigned, b); }
__device__ __forceinline__ float row_rstd(const float* ssq, int row, int fq) {
    const f32x4 p = *(const f32x4*)(ssq + (size_t)row * 16 + 4 * fq); float s = (p[0] + p[1]) + (p[2] + p[3]);
    s += __shfl_xor(s, 16); s += __shfl_xor(s, 32);
    return rsqrtf(s * (1.0f / 1024.0f) + 1e-6f);
}
struct EpiRes {
    static constexpr bool PERM = false, AFTER_DRAIN = false;
    const float* xin; float* xout; const float* gate  ; const float* gmul  ; bf16_t* xn; float* ssq;
    __device__ __forceinline__ void operator()(const f32x4 (&acc)[2][2][4][2], const Unit& u, int wr, int wc, int fr, int fq) const {
        const int b = u.pm >> 4, col0 = u.pn * BM + wc * 32 + 4 * fq; const int row0 = u.pm * BM + wr * 64 + fr;
        const unsigned eb = (unsigned)row0 * 1024u + (unsigned)col0;
        const char* xi = (const char*)xin; char* xo_ = (char*)xout; char* xn_ = (char*)xn; const bool has_gm = gmul != nullptr;
        float s[2][4];
#pragma unroll
        for (int ai = 0; ai < 2; ++ai)
#pragma unroll
            for (int m = 0; m < 4; ++m) s[ai][m] = 0.f;
#pragma unroll
        for (int bj = 0; bj < 2; ++bj)
#pragma unroll
            for (int n = 0; n < 2; ++n) { const unsigned c = (unsigned)(col0 + bj * HALF + n * 16); const f32x4 gv = *(const f32x4*)((const char*)gate + (((unsigned)b * 6144u + c) << 2));
                f32x4 gm = (f32x4){0.f, 0.f, 0.f, 0.f}; if (has_gm) gm = *(const f32x4*)((const char*)gmul + (((unsigned)b * 1024u + c) << 2));
#pragma unroll
                for (int ai = 0; ai < 2; ++ai)
#pragma unroll
                    for (int m = 0; m < 4; ++m) { const unsigned e = eb + (unsigned)((ai * HALF + m * 16) * 1024 + bj * HALF + n * 16);
                        const f32x4 xo = *(const f32x4*)(xi + (e << 2)); const f32x4 xw = xo + gv * acc[ai][bj][m][n];
                        *(f32x4*)(xo_ + (e << 2)) = xw; s[ai][m] += (xw[0] * xw[0] + xw[1] * xw[1]) + (xw[2] * xw[2] + xw[3] * xw[3]);
                        if (has_gm) { const f32x4 p = xw * gm; u32x2 w; w.x = cvt_pk_bf16(p[0], p[1]); w.y = cvt_pk_bf16(p[2], p[3]); *(u32x2*)(xn_ + (e << 1)) = w; } }
                asm volatile("" ::: "memory"); }
#pragma unroll
        for (int ai = 0; ai < 2; ++ai)
#pragma unroll
            for (int m = 0; m < 4; ++m) { float t = s[ai][m]; t += __shfl_xor(t, 16); t += __shfl_xor(t, 32);
                if (fq == 0) *(float*)((char*)ssq + ((((unsigned)(row0 + ai * HALF + m * 16)) * 16u + (unsigned)(u.pn * 4 + wc)) << 2)) = t; }
    }
};
struct EpiFF1 {
    static constexpr bool PERM = true, AFTER_DRAIN = false;
    bf16_t* O; const float* bias  ; const float* ssq;
    __device__ __forceinline__ void operator()(const f32x4 (&acc)[2][2][4][2], const Unit& u, int wr, int wc, int fr, int fq) const {
        const int b = u.pm >> 4, col0 = u.pn * BM + wc * 32 + 8 * fq;
        f32x4 bv[2][2];
#pragma unroll
        for (int bj = 0; bj < 2; ++bj)
#pragma unroll
            for (int n = 0; n < 2; ++n) bv[bj][n] = *(const f32x4*)(bias + b * 4096 + col0 + bj * HALF + 4 * n);
#pragma unroll
        for (int ai = 0; ai < 2; ++ai)
#pragma unroll
            for (int m = 0; m < 4; ++m) { const int row = u.pm * BM + ai * HALF + wr * 64 + m * 16 + fr; const float rs = row_rstd(ssq, row, fq); bf16_t* rowp = O + (size_t)row * 4096 + col0;
#pragma unroll
                for (int bj = 0; bj < 2; ++bj) { f32x4 v0 = acc[ai][bj][m][0] * rs + bv[bj][0], v1 = acc[ai][bj][m][1] * rs + bv[bj][1];
#pragma unroll
                    for (int j = 0; j < 4; ++j) { const float a = fmaxf(v0[j], 0.f), c = fmaxf(v1[j], 0.f); v0[j] = a * a; v1[j] = c * c; }
                    u32x4 w; w.x = cvt_pk_bf16(v0[0], v0[1]); w.y = cvt_pk_bf16(v0[2], v0[3]); w.z = cvt_pk_bf16(v1[0], v1[1]); w.w = cvt_pk_bf16(v1[2], v1[3]);
                    *(u32x4*)(rowp + bj * HALF) = w; } }
    }
};
template <int CTRL> __device__ __forceinline__ float dpp_shr(float x) { return __builtin_bit_cast(float, __builtin_amdgcn_update_dpp(0, __builtin_bit_cast(int, x), CTRL, 0xf, 0xf, true)); }
__device__ __forceinline__ float row15(float x) { return __shfl(x, 15, 16); }
__device__ __forceinline__ float fexp(float x) { return __builtin_amdgcn_exp2f(x * 1.4426950408889634f); }
__device__ __forceinline__ float fsigmoid(float x) { return __builtin_amdgcn_rcpf(1.f + fexp(-x)); }
__device__ __forceinline__ void chunk_scan(float (&v)[4], float& r, float& last) {
    float tot[4];
#pragma unroll
    for (int m = 0; m < 4; ++m) { float x = v[m]; x += dpp_shr<0x111>(x); x += dpp_shr<0x112>(x); x += dpp_shr<0x114>(x); x += dpp_shr<0x118>(x); v[m] = x; tot[m] = row15(x); }
    r = tot[0] + tot[1]; last = (tot[0] + tot[1]) + (tot[2] + tot[3]);
    v[1] += tot[0]; v[2] += tot[0] + tot[1]; v[3] += (tot[0] + tot[1]) + tot[2];
}
struct EpiIn {
    static constexpr bool PERM = false, AFTER_DRAIN = false;
    bf16_t* Z; float* vec  ; float* mg  ; const float* bias  ; const float* ssq; const float* lbt  ; const float* bgate  ;
    __device__ __forceinline__ void operator()(f32x4 (&acc)[2][2][4][2], const Unit& u, int wr, int wc, int fr, int fq) const {
        const int b = u.pm >> 4, pn = u.pn, col0 = pn * BM + wc * 32 + 4 * fq; const int row0 = u.pm * BM + wr * 64 + fr;
#pragma unroll
        for (int ai = 0; ai < 2; ++ai)
#pragma unroll
            for (int m = 0; m < 4; ++m) { const float rs = row_rstd(ssq, row0 + ai * HALF + m * 16, fq);
#pragma unroll
                for (int bj = 0; bj < 2; ++bj)
#pragma unroll
                    for (int n = 0; n < 2; ++n) acc[ai][bj][m][n] = acc[ai][bj][m][n] * rs + *(const f32x4*)((const char*)bias + (((unsigned)b * 4096u + (unsigned)(col0 + bj * HALF + n * 16)) << 2)); }
        char* Zc = (char*)Z;
        const unsigned zb = ((unsigned)row0 * 4096u + (unsigned)(pn * BM)) * 2u;
#define ZST(ai_, m_, colbyte, val) do { const f32x4 v_ = (val); u32x2 w_; w_.x = cvt_pk_bf16(v_[0], v_[1]); w_.y = cvt_pk_bf16(v_[2], v_[3]); \
        *(u32x2*)(Zc + (zb + (unsigned)(((ai_) * HALF + (m_) * 16) * 8192) + (unsigned)(colbyte))) = w_; } while (0)
        if (pn >= 12) {
#pragma unroll
            for (int ai = 0; ai < 2; ++ai)
#pragma unroll
                for (int m = 0; m < 4; ++m)
#pragma unroll
                    for (int bj = 0; bj < 2; ++bj)
#pragma unroll
                        for (int n = 0; n < 2; ++n) { f32x4 v = acc[ai][bj][m][n]; const int tc = bj * HALF + wc * 32 + n * 16 + 4 * fq;
                            if (bj == 1 && wc >= 2) { v[0] = fsigmoid(v[0]); v[1] = fsigmoid(v[1]); v[2] = fsigmoid(v[2]); v[3] = fsigmoid(v[3]); }
                            ZST(ai, m, tc * 2, v); }
        } else if (pn >= 6) {
            const int c0 = 16 * wc + 4 * fq; const f32x4 lb4 = *(const f32x4*)(lbt + (pn - 6) * 64 + c0);
#pragma unroll
            for (int ai = 0; ai < 2; ++ai) {
                float* vp = vec + ((size_t)((b * 64 + (u.pm & 15) * 4 + 2 * ai + wr) * 16 + pn)) * 192 + c0;
#pragma unroll
                for (int j = 0; j < 4; ++j) { float v[4]; const float lbv = lb4[j];
#pragma unroll
                    for (int m = 0; m < 4; ++m) { const float f = acc[ai][0][m][1][j], sig = fsigmoid(f);
                        const float lsig = fminf(f, 0.f) - __logf(1.f + fexp(-fabsf(f)));
                        v[m] = lbv > 0.f ? __logf(lbv + (1.f - lbv) * sig) : lsig;
                        acc[ai][0][m][1][j] = 1.f - fexp(v[m]);
                        const float q = acc[ai][0][m][0][j]; acc[ai][0][m][0][j] = q * fsigmoid(q); }
                    float r, last; chunk_scan(v, r, last);
#pragma unroll
                    for (int m = 0; m < 4; ++m) { acc[ai][0][m][0][j] *= fexp(fminf(v[m] - r, 60.f)); acc[ai][0][m][1][j] *= fexp(fminf(r - v[m], 60.f)); }
                    if (fr == 0) { vp[j] = fexp(r); vp[64 + j] = fexp(last - r); vp[128 + j] = fexp(last); } }
#pragma unroll
                for (int m = 0; m < 4; ++m) { ZST(ai, m, c0 * 2, acc[ai][0][m][0]); ZST(ai, m, 128 + c0 * 2, acc[ai][0][m][1]); ZST(ai, m, 256 + c0 * 2, acc[ai][1][m][0]);
                    f32x4 g = acc[ai][1][m][1]; g[0] = fsigmoid(g[0]); g[1] = fsigmoid(g[1]); g[2] = fsigmoid(g[2]); g[3] = fsigmoid(g[3]); ZST(ai, m, 384 + c0 * 2, g); }
                asm volatile("" ::: "memory");
            }
        } else if (wc < 2) {
            const int c0 = 16 * wc + 4 * fq; const f32x4 bg4 = *(const f32x4*)(bgate + pn * 32 + c0);
#pragma unroll
            for (int ai = 0; ai < 2; ++ai) {
                float* vp = vec + ((size_t)((b * 64 + (u.pm & 15) * 4 + 2 * ai + wr) * 16 + pn)) * 192 + c0;
#pragma unroll
                for (int j = 0; j < 4; ++j) { float v[4];
#pragma unroll
                    for (int m = 0; m < 4; ++m) { const float x = acc[ai][1][m][0][j] + bg4[j]; v[m] = (fminf(x, 0.f) - __logf(1.f + fexp(-fabsf(x)))) * 0.0625f; }
                    float r, last; chunk_scan(v, r, last);
#pragma unroll
                    for (int m = 0; m < 4; ++m) { acc[ai][0][m][0][j] *= 0.17677669529663687f * fexp(fminf(v[m] - r, 60.f)); acc[ai][0][m][1][j] *= fexp(fminf(r - v[m], 60.f)); }
                    if (fr == 0) { vp[j] = fexp(r); vp[64 + j] = fexp(last - r); vp[128 + j] = fexp(last); } }
#pragma unroll
                for (int m = 0; m < 4; ++m) { ZST(ai, m, c0 * 2, acc[ai][0][m][0]); ZST(ai, m, 64 + c0 * 2, acc[ai][0][m][1]); }
                if (pn == 0 && wc == 0 && fq < 2) {
#pragma unroll
                    for (int m = 0; m < 4; ++m) *(f32x4*)(mg + (size_t)(row0 + ai * HALF + m * 16) * 8 + 4 * fq) = acc[ai][1][m][1]; }
                asm volatile("" ::: "memory");
            }
        } else {
            const int e0 = 32 * (wc - 2) + 4 * fq;
#pragma unroll
            for (int ai = 0; ai < 2; ++ai)
#pragma unroll
                for (int m = 0; m < 4; ++m)
#pragma unroll
                    for (int n = 0; n < 2; ++n) { ZST(ai, m, 256 + (e0 + 16 * n) * 2, acc[ai][0][m][n]);
                        f32x4 g = acc[ai][1][m][n]; g[0] *= fsigmoid(g[0]); g[1] *= fsigmoid(g[1]); g[2] *= fsigmoid(g[2]); g[3] *= fsigmoid(g[3]); ZST(ai, m, 384 + (e0 + 16 * n) * 2, g); }
        }
#undef ZST
    }
};
template <class Epi, class Sched, bool ALIGN_EPI = false, bool SP2 = false>
__device__ __forceinline__ void gemm_phase(PG8_LAS unsigned char* lds, const Gemm g, const Sched& S, const Epi& E) {
    int tid_ = threadIdx.x; asm volatile("" : "+v"(tid_));
    const int tid = tid_, wid = __builtin_amdgcn_readfirstlane(tid >> 6), lane = tid & 63, wr = wid >> 2, wc = wid & 3, fr = lane & 15, fq = lane >> 4;
    const int K = g.K, nt = K / BK;
    unsigned voffA[2], voffB[2];
#pragma unroll
    for (int i = 0; i < 2; ++i) { int R, C; stage_rc(tid * 16 + i * 8192, R, C); const int Rb = Epi::PERM ? ((R & ~31) + perm32(R & 31)) : R;
        voffA[i] = (unsigned)(R * K + C) * 2u; voffB[i] = (unsigned)(Rb * K + C) * 2u; }
    const size_t kstep = (size_t)(BK * 2);
    const size_t hstep = (size_t)HALF * K * 2;
    const size_t tstep = 2 * hstep;
    const unsigned ldsw = (unsigned)wid * 1024u;
    const int aoff = lds_byte(wr * 64 + fr, fq * 8), boff = lds_byte(wc * 32 + fr, fq * 8);
#define PG8_SA(b, h) (((b) * 2 + (h)) * HTB)
#define PG8_SB(b, h) ((4 + (b) * 2 + (h)) * HTB)
#define PG8_STAGE(bufoff, gbase, voff) do { _Pragma("unroll") for (int _i = 0; _i < 2; ++_i) \
        __builtin_amdgcn_global_load_lds((const unsigned*)((const char*)(gbase) + (voff)[_i]), (PG8_LAS unsigned*)(lds + (bufoff) + ldsw + _i * 8192), 16, 0, 0); } while (0)
#define PG8_LDA(dst, b, h) do { _Pragma("unroll") for (int m = 0; m < 4; ++m) _Pragma("unroll") for (int k = 0; k < 2; ++k) dst[m][k] = *(const PG8_LAS bf16x8*)(lds + PG8_SA(b, h) + aoff + m * 2048 + k * 1024); } while (0)
#define PG8_LDB(dst, b, h) do { _Pragma("unroll") for (int n = 0; n < 2; ++n) _Pragma("unroll") for (int k = 0; k < 2; ++k) dst[n][k] = *(const PG8_LAS bf16x8*)(lds + PG8_SB(b, h) + boff + n * 2048 + k * 1024); } while (0)
#define PG8_MMA(ai, bj, At, Bt) do { __builtin_amdgcn_s_setprio(1); _Pragma("unroll") for (int m = 0; m < 4; ++m) _Pragma("unroll") for (int n = 0; n < 2; ++n) _Pragma("unroll") for (int k = 0; k < 2; ++k) \
        acc[ai][bj][m][n] = __builtin_amdgcn_mfma_f32_16x16x32_bf16(Bt[n][k], At[m][k], acc[ai][bj][m][n], 0, 0, 0); __builtin_amdgcn_s_setprio(0); } while (0)
#define PG8_WAIT_V(n) asm volatile("s_waitcnt vmcnt(" #n ")" ::: "memory")
#define PG8_WAIT_L(n) asm volatile("s_waitcnt lgkmcnt(" #n ")" ::: "memory")
#define PG8_BAR __builtin_amdgcn_s_barrier()
#define PG8_SCHED __builtin_amdgcn_sched_barrier(0)
    Unit cur, nxt; int ui = 0;
    if (!S.next(0, cur)) return;
    f32x4 acc[2][2][4][2];
#pragma unroll
    for (int a = 0; a < 2; ++a)
#pragma unroll
        for (int b = 0; b < 2; ++b)
#pragma unroll
            for (int m = 0; m < 4; ++m)
#pragma unroll
                for (int n = 0; n < 2; ++n) acc[a][b][m][n] = (f32x4){0.f, 0.f, 0.f, 0.f};
    bf16x8 At[4][2], B0[2][2], B1[2][2];
    const char* cA = (const char*)g.A + (size_t)cur.pm * tstep; const char* cB = (const char*)g.Bt + (size_t)cur.pn * tstep;
    S.a_ready(cur);
    if constexpr (SP2) {
        PG8_STAGE(PG8_SB(0, 0), cB, voffB); PG8_STAGE(PG8_SB(0, 1), cB + hstep, voffB); PG8_STAGE(PG8_SA(0, 0), cA, voffA); PG8_STAGE(PG8_SA(0, 1), cA + hstep, voffA);
        if (wr == 1) PG8_BAR;
        PG8_WAIT_V(2); PG8_BAR;
        PG8_STAGE(PG8_SB(1, 0), cB + kstep, voffB); PG8_STAGE(PG8_SA(1, 0), cA + kstep, voffA); PG8_STAGE(PG8_SB(1, 1), cB + hstep + kstep, voffB);
        PG8_WAIT_V(6); PG8_BAR;
    } else {
        PG8_STAGE(PG8_SB(0, 0), cB, voffB); PG8_STAGE(PG8_SA(0, 0), cA, voffA); PG8_STAGE(PG8_SB(0, 1), cB + hstep, voffB); PG8_STAGE(PG8_SA(0, 1), cA + hstep, voffA);
        if (wr == 1) PG8_BAR;
        PG8_WAIT_V(4); PG8_BAR;
        PG8_STAGE(PG8_SB(1, 0), cB + kstep, voffB); PG8_STAGE(PG8_SA(1, 0), cA + kstep, voffA); PG8_STAGE(PG8_SB(1, 1), cB + hstep + kstep, voffB);
        PG8_WAIT_V(6); PG8_BAR;
    }
    for (;;) {
        const bool has_next = S.next(ui + 1, nxt);
        const char* nA = has_next ? (const char*)g.A + (size_t)nxt.pm * tstep : cA; const char* nB = has_next ? (const char*)g.Bt + (size_t)nxt.pn * tstep : cB;
        for (int t = 0; t < nt; t += 2) {
            const bool last = (t == nt - 2);
            const char* a1 = cA + (size_t)(t + 1) * kstep;
            const char* a2 = last ? nA : cA + (size_t)(t + 2) * kstep; const char* b2 = last ? nB : cB + (size_t)(t + 2) * kstep;
            const char* a3 = a2 + kstep; const char* b3 = b2 + kstep;
            if (last && has_next) S.a_ready(nxt);
            if constexpr (SP2) {
            PG8_LDB(B0, 0, 0); PG8_LDB(B1, 0, 1); PG8_SCHED; PG8_LDA(At, 0, 0); PG8_STAGE(PG8_SA(1, 1), a1 + hstep, voffA);
            PG8_WAIT_V(8); PG8_WAIT_L(0); PG8_BAR; PG8_MMA(0, 0, At, B0); PG8_MMA(0, 1, At, B1); PG8_BAR; PG8_SCHED;
            PG8_LDA(At, 0, 1); PG8_STAGE(PG8_SB(0, 0), b2, voffB); PG8_STAGE(PG8_SB(0, 1), b2 + hstep, voffB); PG8_STAGE(PG8_SA(0, 0), a2, voffA);
            PG8_WAIT_V(8); PG8_WAIT_L(0); PG8_BAR; PG8_MMA(1, 0, At, B0); PG8_MMA(1, 1, At, B1); PG8_BAR; PG8_SCHED;
            PG8_LDB(B0, 1, 0); PG8_LDB(B1, 1, 1); PG8_SCHED; PG8_LDA(At, 1, 0); PG8_STAGE(PG8_SA(0, 1), a2 + hstep, voffA);
            PG8_WAIT_V(8); PG8_WAIT_L(0); PG8_BAR; PG8_MMA(0, 0, At, B0); PG8_MMA(0, 1, At, B1); PG8_BAR; PG8_SCHED;
            PG8_LDA(At, 1, 1); PG8_STAGE(PG8_SB(1, 0), b3, voffB); PG8_STAGE(PG8_SB(1, 1), b3 + hstep, voffB); PG8_STAGE(PG8_SA(1, 0), a3, voffA);
            PG8_WAIT_V(8); PG8_WAIT_L(0); PG8_BAR; PG8_MMA(1, 0, At, B0); PG8_MMA(1, 1, At, B1); PG8_BAR; PG8_SCHED;
            } else {
            PG8_LDB(B0, 0, 0); PG8_SCHED; PG8_LDA(At, 0, 0); PG8_STAGE(PG8_SA(1, 1), a1 + hstep, voffA);
            PG8_WAIT_L(8); PG8_BAR; PG8_WAIT_L(0); PG8_MMA(0, 0, At, B0); PG8_BAR; PG8_SCHED;
            PG8_LDB(B1, 0, 1); PG8_STAGE(PG8_SB(0, 0), b2, voffB);
            PG8_BAR; PG8_WAIT_L(0); PG8_MMA(0, 1, At, B1); PG8_BAR;
            PG8_LDA(At, 0, 1); PG8_STAGE(PG8_SA(0, 0), a2, voffA);
            PG8_BAR; PG8_WAIT_L(0); PG8_MMA(1, 0, At, B0); PG8_BAR; PG8_SCHED;
            PG8_STAGE(PG8_SB(0, 1), b2 + hstep, voffB);
            PG8_WAIT_V(6); PG8_BAR; PG8_MMA(1, 1, At, B1); PG8_BAR;
            PG8_LDB(B0, 1, 0); PG8_SCHED; PG8_LDA(At, 1, 0); PG8_STAGE(PG8_SA(0, 1), a2 + hstep, voffA);
            PG8_WAIT_L(8); PG8_BAR; PG8_WAIT_L(0); PG8_MMA(0, 0, At, B0); PG8_BAR; PG8_SCHED;
            PG8_LDB(B1, 1, 1); PG8_STAGE(PG8_SB(1, 0), b3, voffB);
            PG8_BAR; PG8_WAIT_L(0); PG8_MMA(0, 1, At, B1); PG8_BAR;
            PG8_LDA(At, 1, 1); PG8_STAGE(PG8_SA(1, 0), a3, voffA);
            PG8_BAR; PG8_WAIT_L(0); PG8_MMA(1, 0, At, B0); PG8_BAR; PG8_SCHED;
            PG8_STAGE(PG8_SB(1, 1), b3 + hstep, voffB);
            PG8_WAIT_V(6); PG8_BAR; PG8_MMA(1, 1, At, B1); PG8_BAR;
            }
        }
        if constexpr (ALIGN_EPI) { if (wr == 0) PG8_BAR; }
        if constexpr (!Epi::AFTER_DRAIN) { E(acc, cur, wr, wc, fr, fq); S.done(cur); }
        if (!has_next) break;
#pragma unroll
        for (int a = 0; a < 2; ++a)
#pragma unroll
            for (int b = 0; b < 2; ++b)
#pragma unroll
                for (int m = 0; m < 4; ++m)
#pragma unroll
                    for (int n = 0; n < 2; ++n) acc[a][b][m][n] = (f32x4){0.f, 0.f, 0.f, 0.f};
        cur = nxt; cA = nA; cB = nB; ++ui;
        if constexpr (ALIGN_EPI) { if (wr == 1) PG8_BAR; }
    }
    PG8_WAIT_V(0);
    if constexpr (!ALIGN_EPI) { if (wr == 0) PG8_BAR; }
    PG8_BAR;
    if constexpr (Epi::AFTER_DRAIN) { E.fused(acc, cur, wr, wc, fr, fq, lds, wid, lane); S.done(cur); }
#undef PG8_SA
#undef PG8_SB
#undef PG8_STAGE
#undef PG8_LDA
#undef PG8_LDB
#undef PG8_MMA
#undef PG8_WAIT_V
#undef PG8_WAIT_L
#undef PG8_BAR
#undef PG8_SCHED
}
}
#define XB_TMO      128
#define XB_XCNT(j)  (256  + 64 * (j))
#define XB_XSUB(j)  (1280 + 64 * (j))
#define XB_XGEN(j)  (2304 + 64 * (j))
#define XB_TOP      3328
#define XB_TOPGEN   3392
#define XCD_BAR_WORDS 3456
#define XB_SPIN_CAP (1u << 18)

__device__ __forceinline__ unsigned xb_ld(unsigned* p)              { return __hip_atomic_load(p, __ATOMIC_RELAXED, __HIP_MEMORY_SCOPE_AGENT); }
__device__ __forceinline__ unsigned xb_add(unsigned* p, unsigned v) { return __hip_atomic_fetch_add(p, v, __ATOMIC_RELAXED, __HIP_MEMORY_SCOPE_AGENT); }
__device__ __forceinline__ unsigned xb_xcc_id() { return (unsigned)__builtin_amdgcn_s_getreg((3 << 11) | 20) & 0xFu; }
#define XB_SPIN(cond, bar) do { unsigned _sp = 0; while (cond) { __builtin_amdgcn_s_sleep(1); \
    if ((++_sp & 255u) == 0u) { if (xb_ld(&(bar)[XB_TMO])) break; if (_sp > XB_SPIN_CAP) { atomicAdd(&(bar)[XB_TMO], 1u); break; } } } } while (0)

struct XcdBarrier {
    unsigned* bar; unsigned x;
    volatile LAS unsigned* st;
};

__device__ __forceinline__ XcdBarrier xcd_barrier_post(unsigned* bar, volatile LAS unsigned* st) {
    XcdBarrier b; b.bar = bar; b.x = xb_xcc_id(); b.st = st;
    if (threadIdx.x == 0) (void)xb_add(&bar[XB_XCNT(b.x)], 1u);
    return b;
}
__device__ __forceinline__ void xcd_barrier_complete(unsigned* bar, unsigned x, unsigned& nloc, unsigned& nx) {
    const unsigned G = gridDim.x * gridDim.y * gridDim.z;
    unsigned sum, cnt, mine, sp = 0u;
    for (;;) {
        sum = 0u; cnt = 0u; mine = 0u;
#pragma unroll
        for (unsigned j = 0; j < 16; ++j) { const unsigned c = xb_ld(&bar[XB_XCNT(j)]); sum += c; cnt += (c > 0u) ? 1u : 0u; mine = (j == x) ? c : mine; }
        if (sum == G) break;
        __builtin_amdgcn_s_sleep(1);
        if ((++sp & 255u) == 0u) { if (xb_ld(&bar[XB_TMO])) break; if (sp > XB_SPIN_CAP) { atomicAdd(&bar[XB_TMO], 1u); break; } }
    }
    nloc = mine > 0u ? mine : 1u; nx = cnt > 0u ? cnt : 1u;
}

__device__ __forceinline__ void xcd_barrier(const XcdBarrier& b) {
    asm volatile("s_waitcnt vmcnt(0)" ::: "memory");
    __syncthreads();
    if (threadIdx.x == 0) {
        unsigned* bar = b.bar;
        __builtin_amdgcn_s_waitcnt(0);
        unsigned nloc = b.st[0], nx = b.st[1];
        if (nloc == 0u) { xcd_barrier_complete(bar, b.x, nloc, nx); b.st[0] = nloc; b.st[1] = nx; }
        const unsigned old = xb_add(&bar[XB_XSUB(b.x)], 1u);
        const unsigned gen = old / nloc;
        if (old + 1u == (gen + 1u) * nloc) {
            __builtin_amdgcn_fence(__ATOMIC_RELEASE, "agent");
            asm volatile("s_waitcnt vmcnt(0)" ::: "memory");
            const unsigned og = xb_add(&bar[XB_TOP], 1u);
            const unsigned tg = og / nx;
            if (og + 1u == (tg + 1u) * nx) xb_add(&bar[XB_TOPGEN], 1u);
            else XB_SPIN(xb_ld(&bar[XB_TOPGEN]) == tg, bar);
            __builtin_amdgcn_fence(__ATOMIC_ACQUIRE, "agent");
            xb_add(&bar[XB_XGEN(b.x)], 1u);
            asm volatile("s_waitcnt vmcnt(0)" ::: "memory");
        } else {
            XB_SPIN(xb_ld(&bar[XB_XGEN(b.x)]) == gen, bar);
            __builtin_amdgcn_fence(__ATOMIC_ACQUIRE, "agent");
            asm volatile("s_waitcnt vmcnt(0)" ::: "memory");
        }
    }
    __syncthreads();
}
constexpr int NWAVES = 8;
constexpr int RING_BYTES = 131072, MISC_OFF = RING_BYTES + 320, LDS_BYTES = 147456;
#define LDS_WAIT() asm volatile("s_waitcnt lgkmcnt(0)" ::: "memory")
#define VM_WAIT() asm volatile("s_waitcnt vmcnt(0)" ::: "memory")

struct Args { const float* in[19]; float* out; unsigned char* ws; int ph_lo, ph_hi, li, pad; };
enum { I_X = 0, I_C, I_WADA, I_BADA, I_NMIX, I_NMLP, I_WIN, I_GWG, I_GBG, I_GNORM, I_LBL, I_HNORM, I_MCONV, I_MGB, I_MNORM, I_WOUT, I_WFF1, I_WFF2, I_FNORM };

__device__ __forceinline__ void phase_p0a(const Args& a, LAS unsigned char* lds, int tid) {
    LAS float* cond = (LAS float*)lds;
    const float* c = a.in[I_C];
    for (int i = tid; i < NB * D; i += NWAVES * 64) cond[i] = siluf_(c[i]);
    __syncthreads();
    float* modp = (float*)(a.ws + WS_U);
    const float* w_ada = a.in[I_WADA];
    const int G = gridDim.x;
    for (int t = blockIdx.x * (NWAVES * 64) + tid; t < L * 16 * 1536; t += G * NWAVES * 64) {
        const int n4 = t % 1536, kc = (t / 1536) % 16, l = t / (1536 * 16);
        const float* w = w_ada + ((size_t)l * D + kc * 64) * (6 * D) + n4 * 4;
        f32x4 acc[4];
#pragma unroll
        for (int b = 0; b < 4; ++b) acc[b] = (f32x4){0.f, 0.f, 0.f, 0.f};
#pragma unroll 8
        for (int k = 0; k < 64; ++k) { const f32x4 wv = *(const f32x4*)(w + (size_t)k * (6 * D));
#pragma unroll
            for (int b = 0; b < 4; ++b) acc[b] += cond[b * D + kc * 64 + k] * wv; }
#pragma unroll
        for (int b = 0; b < 4; ++b) *(f32x4*)(&modp[((size_t)kc * L * NB + l * NB + b) * 6 * D + n4 * 4]) = acc[b];
    }
    __syncthreads();
}
__device__ __forceinline__ void phase_p0b(const Args& a, int tid) {
    const float* modp = (const float*)(a.ws + WS_U); float* mod = (float*)(a.ws + WS_MOD); const float* b_ada = a.in[I_BADA];
    for (int i = blockIdx.x * (NWAVES * 64) + tid; i < L * NB * 1536; i += gridDim.x * NWAVES * 64) {
        const int n4 = i % 1536, lb_ = i / 1536, l = lb_ / NB;
        f32x4 s = *(const f32x4*)(b_ada + l * 6 * D + n4 * 4);
#pragma unroll
        for (int kc = 0; kc < 16; ++kc) s += *(const f32x4*)(&modp[((size_t)kc * L * NB + lb_) * 6 * D + n4 * 4]);
        *(f32x4*)(&mod[(size_t)lb_ * 6 * D + n4 * 4]) = s;
    }
    if (blockIdx.x == 0 && tid < 384) {
        const float* logits = a.in[I_LBL]; float* lb = (float*)(a.ws + WS_LB);
        float v0 = logits[tid], v1 = logits[384 + tid], v2 = logits[768 + tid], v3 = logits[1152 + tid];
        const float mx = fmaxf(fmaxf(v0, v1), fmaxf(v2, v3));
        v0 = __expf(v0 - mx); v1 = __expf(v1 - mx); v2 = __expf(v2 - mx); v3 = __expf(v3 - mx);
        const float inv = 1.f / (v0 + v1 + v2 + v3);
        lb[tid] = 0.f; lb[384 + tid] = v1 * inv; lb[768 + tid] = (v1 + v2) * inv; lb[1152 + tid] = (v1 + v2 + v3) * inv;
    }
}

__device__ __forceinline__ void conv_item(const Args& a, int it, LAS float* scr, int lane) {
    const int l = it / 416, r = it % 416;
    int kind, nb, kpart = 0;
    if (r < 128) { kind = 0; nb = r; } else if (r < 160) { kind = 1; nb = r - 128; } else if (r < 288) { kind = 2; nb = r - 160; } else { kind = 3; nb = (r - 288) >> 2; kpart = (r - 288) & 3; }
    const float* W; int N, K; bf16* WT; unsigned char* wl = a.ws + WS_W + (size_t)l * W_LAYER;
    if (kind == 0) { W = a.in[I_WIN] + (size_t)l * D * DIN; N = DIN; K = D; WT = (bf16*)(wl + W_IN); }
    else if (kind == 1) { W = a.in[I_WOUT] + (size_t)l * D * D; N = D; K = D; WT = (bf16*)(wl + W_OUT); }
    else if (kind == 2) { W = a.in[I_WFF1] + (size_t)l * D * DFF; N = DFF; K = D; WT = (bf16*)(wl + W_1); }
    else { W = a.in[I_WFF2] + (size_t)l * DFF * D; N = D; K = DFF; WT = (bf16*)(wl + W_2); }
    const int n0 = nb * 32, nl = lane & 31, kh = lane >> 5;
    int code = n0 + nl; if (kind == 0) code = in_src(n0 + nl);
    float wg[16];
#pragma unroll
    for (int q = 0; q < 16; ++q) wg[q] = 0.f;
    if (code <= -2) { const int ch = -(code + 2); const float* g = a.in[I_GWG] + (size_t)l * 16 * 192 + ch;
#pragma unroll
        for (int q = 0; q < 16; ++q) wg[q] = g[q * 192]; }
    const bool want_bias = (kind == 0 || kind == 2);
    const float* shiftp = (const float*)(a.ws + WS_MOD) + (size_t)l * NB * 6 * D + (kind == 0 ? 0 : 3) * D;
    float ab0 = 0.f, ab1 = 0.f, ab2 = 0.f, ab3 = 0.f;
    for (int kt = 0; kt < 16; ++kt) {
        const int k0 = kpart * 1024 + kt * 64;
#pragma unroll 4
        for (int i = 0; i < 32; ++i) { const int kk = 2 * i + kh; const float* wr_ = W + (size_t)(k0 + kk) * N;
            float v;
            if (code >= 0) v = wr_[code];
            else if (code == -1) v = 0.f;
            else { const f32x4 g0 = *(const f32x4*)(wr_ + GLOW), g1 = *(const f32x4*)(wr_ + GLOW + 4), g2 = *(const f32x4*)(wr_ + GLOW + 8), g3 = *(const f32x4*)(wr_ + GLOW + 12);
                v = g0[0] * wg[0] + g0[1] * wg[1] + g0[2] * wg[2] + g0[3] * wg[3] + g1[0] * wg[4] + g1[1] * wg[5] + g1[2] * wg[6] + g1[3] * wg[7]
                  + g2[0] * wg[8] + g2[1] * wg[9] + g2[2] * wg[10] + g2[3] * wg[11] + g3[0] * wg[12] + g3[1] * wg[13] + g3[2] * wg[14] + g3[3] * wg[15]; }
            scr[kk * 33 + nl] = v;
            if (want_bias) { const float* sp = shiftp + k0 + kk; ab0 += sp[0] * v; ab1 += sp[6 * D] * v; ab2 += sp[12 * D] * v; ab3 += sp[18 * D] * v; } }
        LDS_WAIT(); asm volatile("" ::: "memory");
        const int c = lane & 7;
#pragma unroll
        for (int j = 0; j < 4; ++j) { const int n = (lane >> 3) + 8 * j; const LAS float* s = scr + (8 * c) * 33 + n;
            v4u o; o.x = pk2(s[0 * 33], s[1 * 33]); o.y = pk2(s[2 * 33], s[3 * 33]); o.z = pk2(s[4 * 33], s[5 * 33]); o.w = pk2(s[6 * 33], s[7 * 33]);
            *(GAS v4u*)(WT + (size_t)(n0 + n) * K + k0 + 8 * c) = o; }
        LDS_WAIT(); asm volatile("" ::: "memory");
    }
    if (want_bias) {
        ab0 += __shfl_xor(ab0, 32); ab1 += __shfl_xor(ab1, 32); ab2 += __shfl_xor(ab2, 32); ab3 += __shfl_xor(ab3, 32);
        if (lane < 32) { float* bias = (float*)(a.ws + WS_BIAS) + (kind == 0 ? 0 : (size_t)L * NB * 4096) + (size_t)l * NB * 4096 + n0 + lane;
            bias[0] = ab0; bias[4096] = ab1; bias[8192] = ab2; bias[12288] = ab3; }
    }
}
__device__ __forceinline__ void phase_p1(const Args& a, LAS unsigned char* lds, int tid, int lane, int wave) {
    const int G = gridDim.x, gw = blockIdx.x * NWAVES + wave, NGW = G * NWAVES;
    const float* mod = (const float*)(a.ws + WS_MOD);
    { float* gm = (float*)(a.ws + WS_GMUL);
      for (int i = blockIdx.x * (NWAVES * 64) + tid; i < L * 2 * NB * D; i += G * NWAVES * 64) { const int k = i & 1023, b = (i >> 10) & 3, w = (i >> 12) & 1, l = i >> 13;
          const float gain = (w ? a.in[I_NMLP] : a.in[I_NMIX])[l * D + k]; gm[i] = gain * (1.f + mod[(size_t)(l * NB + b) * 6 * D + (w ? 4 : 1) * D + k]); } }
    { const float* x = a.in[I_X]; bf16* xn = (bf16*)(a.ws + WS_XN); float* ssq = (float*)(a.ws + WS_SSQ); const float* nm = a.in[I_NMIX];
      for (int row = gw; row < M; row += NGW) { const int b = row >> 12; const GAS f32x4* xr = (const GAS f32x4*)(x + (size_t)row * D) + lane; float s = 0.f;
          GAS unsigned long long* o8 = (GAS unsigned long long*)(xn + (size_t)row * D) + lane;
#pragma unroll
          for (int j = 0; j < 4; ++j) { const f32x4 v = xr[64 * j]; s += (v[0] * v[0] + v[1] * v[1]) + (v[2] * v[2] + v[3] * v[3]); const int k = 4 * lane + 256 * j;
              const f32x4 g = *(const f32x4*)(nm + k); const f32x4 sc = *(const f32x4*)(mod + (size_t)b * 6 * D + D + k); const f32x4 p = v * g * (sc + 1.f);
              o8[64 * j] = (unsigned long long)pk2(p[0], p[1]) | ((unsigned long long)pk2(p[2], p[3]) << 32); }
          s = wave_sum(s);
          if (lane < 16) ssq[(size_t)row * 16 + lane] = (lane == 0) ? s : 0.f; } }
    { LAS float* scr = (LAS float*)(lds + wave * 16384);
      for (int it = gw; it < L * 416; it += NGW) conv_item(a, it, scr, lane); }
}
__device__ __forceinline__ void phase_final(const Args& a, int lane, int wave) {
    const int gw = blockIdx.x * NWAVES + wave, NGW = gridDim.x * NWAVES; const float* fn = a.in[I_FNORM];
    for (int row = gw; row < M; row += NGW) { GAS f32x4* xr = (GAS f32x4*)(a.out + (size_t)row * D) + lane; f32x4 v[4]; float s = 0.f;
#pragma unroll
        for (int j = 0; j < 4; ++j) { v[j] = xr[64 * j]; s += (v[j][0] * v[j][0] + v[j][1] * v[j][1]) + (v[j][2] * v[j][2] + v[j][3] * v[j][3]); }
        const float rs = rsqrtf(wave_sum(s) * (1.f / D) + EPS);
#pragma unroll
        for (int j = 0; j < 4; ++j) { const f32x4 g = *(const f32x4*)(fn + 4 * lane + 256 * j); xr[64 * j] = v[j] * rs * g; } }
}
typedef short v4i16_t __attribute__((ext_vector_type(4)));
typedef short s16x4 __attribute__((ext_vector_type(4)));
#define MFMA32(a, b, c) __builtin_amdgcn_mfma_f32_32x32x16_bf16((a), (b), (c), 0, 0, 0)
__device__ __forceinline__ s16x4 tr16(LAS const unsigned char* p) { return __builtin_bit_cast(s16x4, __builtin_amdgcn_ds_read_tr16_b64_v4i16((LAS v4i16_t*)p)); }
__device__ __forceinline__ bf16x8 cat8(s16x4 a, s16x4 b) { return __builtin_shufflevector(a, b, 0, 1, 2, 3, 4, 5, 6, 7); }
__device__ __forceinline__ unsigned cvtpk(float lo, float hi) { typedef __bf16 bf16x2_t __attribute__((ext_vector_type(2))); typedef float f32x2_t __attribute__((ext_vector_type(2))); f32x2_t v = {lo, hi}; return __builtin_bit_cast(unsigned, __builtin_convertvector(v, bf16x2_t)); }
__device__ __forceinline__ bf16x8 pack8(const f32x16& x, int s) { v4u p; p.x = cvtpk(x[8 * s], x[8 * s + 1]); p.y = cvtpk(x[8 * s + 2], x[8 * s + 3]); p.z = cvtpk(x[8 * s + 4], x[8 * s + 5]); p.w = cvtpk(x[8 * s + 6], x[8 * s + 7]); return __builtin_bit_cast(bf16x8, p); }
__device__ __forceinline__ float fexp_(float x) { return __builtin_amdgcn_exp2f(x * 1.4426950408889634f); }
__device__ __forceinline__ float fsig_(float x) { return __builtin_amdgcn_rcpf(1.f + fexp_(-x)); }
constexpr size_t U_BN = 208 * 1024, SP_BN = 104 * 1024;
__device__ __forceinline__ int u_off(int head) { return head < 6 ? head * 8192 : head < 12 ? 49152 + (head - 6) * 16384 : 147456 + (head - 12) * 16384; }
template <int NB16> __device__ __forceinline__ void stage_img(LAS unsigned char* img, const bf16* src, int lane) {
    constexpr int RPI = 64 / NB16;
#pragma unroll
    for (int i = 0; i < 64 / RPI; ++i) { const int row = i * RPI + lane / NB16, ch = lane % NB16; const v4u v = *(const v4u*)(src + (size_t)row * 4096 + ch * 8); *(LAS v4u*)(img + row * (NB16 * 16) + ch * 16) = v; }
}
template <int KCH> __device__ __forceinline__ void ktv(f32x16 (&U)[KCH / 32][2], LAS const unsigned char* kimg, LAS const unsigned char* vimg, int lane) {
    const int h = lane >> 5, g16 = (lane >> 4) & 1, q = (lane & 15) >> 2, p = lane & 3;
#pragma unroll
    for (int cb = 0; cb < KCH / 32; ++cb)
#pragma unroll
        for (int vb = 0; vb < 2; ++vb)
#pragma unroll
            for (int r = 0; r < 16; ++r) U[cb][vb][r] = 0.f;
#pragma unroll
    for (int s = 0; s < 4; ++s) { const int t0 = 16 * s + 8 * h + q; bf16x8 A[KCH / 32], B[2];
#pragma unroll
        for (int cb = 0; cb < KCH / 32; ++cb) A[cb] = cat8(tr16(kimg + t0 * (KCH * 2) + (32 * cb + 16 * g16 + 4 * p) * 2), tr16(kimg + (t0 + 4) * (KCH * 2) + (32 * cb + 16 * g16 + 4 * p) * 2));
#pragma unroll
        for (int vb = 0; vb < 2; ++vb) B[vb] = cat8(tr16(vimg + t0 * 128 + (32 * vb + 16 * g16 + 4 * p) * 2), tr16(vimg + (t0 + 4) * 128 + (32 * vb + 16 * g16 + 4 * p) * 2));
#pragma unroll
        for (int cb = 0; cb < KCH / 32; ++cb)
#pragma unroll
            for (int vb = 0; vb < 2; ++vb) U[cb][vb] = MFMA32(A[cb], B[vb], U[cb][vb]); }
}
template <int KCH> __device__ __forceinline__ void store_ut(const f32x16 (&U)[KCH / 32][2], float* UT, const float* el, int lane) {
    const int h = lane >> 5, r32 = lane & 31;
#pragma unroll
    for (int cb = 0; cb < KCH / 32; ++cb)
#pragma unroll
        for (int vb = 0; vb < 2; ++vb)
#pragma unroll
            for (int g = 0; g < 4; ++g) { const int c0 = 32 * cb + 8 * g + 4 * h; f32x4 o = {U[cb][vb][4 * g], U[cb][vb][4 * g + 1], U[cb][vb][4 * g + 2], U[cb][vb][4 * g + 3]};
                if (el) o = o * *(const f32x4*)(el + c0);
                *(f32x4*)(UT + (size_t)(32 * vb + r32) * KCH + c0) = o; }
}
template <int KCH> __device__ __forceinline__ void mix_c1_gh(const Args& a, LAS unsigned char* wl, int lane, int b, int n, int head) {
    asm volatile("" : "+v"(lane));
    const size_t row0 = (size_t)b * S + n * 64; const bf16* Zt = (const bf16*)(a.ws + WS_Z) + row0 * 4096 + head * 256;
    LAS unsigned char* kimg = wl; LAS unsigned char* vimg = wl + 8192;
    stage_img<KCH / 8>(kimg, Zt + KCH, lane); stage_img<8>(vimg, Zt + 128, lane);
    LDS_WAIT(); asm volatile("" ::: "memory");
    f32x16 U[KCH / 32][2]; ktv<KCH>(U, kimg, vimg, lane);
    const float* vp = (const float*)(a.ws + WS_VEC) + ((size_t)(b * 64 + n) * 16 + head) * 192;
    store_ut<KCH>(U, (float*)(a.ws + WS_U + (size_t)(b * 64 + n) * U_BN + u_off(head)), vp + 64, lane);
    LDS_WAIT(); asm volatile("" ::: "memory");
}
template <int KCH> __device__ __forceinline__ void mix_c3_gh(const Args& a, LAS unsigned char* wl, int lane, int b, int n, int head, int l) {
    asm volatile("" : "+v"(lane));
    const size_t row0 = (size_t)b * S + n * 64; const bf16* Zt = (const bf16*)(a.ws + WS_Z) + row0 * 4096 + head * 256;
    LAS unsigned char* vimg = wl; stage_img<8>(vimg, Zt + 128, lane);
    const int h = lane >> 5, r32 = lane & 31, g16 = (lane >> 4) & 1, q = (lane & 15) >> 2, p = lane & 3;
    constexpr int NS = KCH / 16;
    bf16x8 Qf[2][NS], Kf[2][NS];
#pragma unroll
    for (int ib = 0; ib < 2; ++ib)
#pragma unroll
        for (int s = 0; s < NS; ++s) { Qf[ib][s] = *(const bf16x8*)(Zt + (size_t)(32 * ib + r32) * 4096 + 16 * s + 8 * h); Kf[ib][s] = *(const bf16x8*)(Zt + (size_t)(32 * ib + r32) * 4096 + KCH + 16 * s + 8 * h); }
    f32x16 X00, X01, X11;
#pragma unroll
    for (int r = 0; r < 16; ++r) { X00[r] = 0.f; X01[r] = 0.f; X11[r] = 0.f; }
#pragma unroll
    for (int s = 0; s < NS; ++s) { X00 = MFMA32(Kf[0][s], Qf[0][s], X00); X01 = MFMA32(Kf[0][s], Qf[1][s], X01); X11 = MFMA32(Kf[1][s], Qf[1][s], X11); }
#pragma unroll
    for (int r = 0; r < 16; ++r) { const int jl = (r & 3) + 8 * (r >> 2) + 4 * h; if (jl > r32) { X00[r] = 0.f; X11[r] = 0.f; } }
    bf16x8 P00[2], P01[2], P11[2];
#pragma unroll
    for (int s2 = 0; s2 < 2; ++s2) { P00[s2] = pack8(X00, s2); P01[s2] = pack8(X01, s2); P11[s2] = pack8(X11, s2); }
    f32x16 O[2][2];
#pragma unroll
    for (int vb = 0; vb < 2; ++vb)
#pragma unroll
        for (int ib = 0; ib < 2; ++ib)
#pragma unroll
            for (int r = 0; r < 16; ++r) O[vb][ib][r] = 0.f;
    LDS_WAIT(); asm volatile("" ::: "memory");
#pragma unroll
    for (int vb = 0; vb < 2; ++vb)
#pragma unroll
        for (int jb = 0; jb < 2; ++jb)
#pragma unroll
            for (int s2 = 0; s2 < 2; ++s2) { const int t0 = 32 * jb + 16 * s2 + 4 * h + q; LAS const unsigned char* cp = vimg + (32 * vb + 16 * g16 + 4 * p) * 2;
                const bf16x8 A = cat8(tr16(cp + t0 * 128), tr16(cp + (t0 + 8) * 128));
                if (jb == 0) { O[vb][0] = MFMA32(A, P00[s2], O[vb][0]); O[vb][1] = MFMA32(A, P01[s2], O[vb][1]); } else O[vb][1] = MFMA32(A, P11[s2], O[vb][1]); }
    const bf16* SpT = (const bf16*)(a.ws + WS_XN + (size_t)(b * 64 + n) * SP_BN + u_off(head) / 2);
#pragma unroll
    for (int vb = 0; vb < 2; ++vb)
#pragma unroll
        for (int s = 0; s < NS; ++s) { const bf16x8 A = *(const bf16x8*)(SpT + (size_t)(32 * vb + r32) * KCH + 16 * s + 8 * h); O[vb][0] = MFMA32(A, Qf[0][s], O[vb][0]); O[vb][1] = MFMA32(A, Qf[1][s], O[vb][1]); }
    const float* gain = (head < 6 ? a.in[I_GNORM] : a.in[I_HNORM]) + l * 64; bf16* mixed = (bf16*)(a.ws + WS_MIX);
#pragma unroll
    for (int ib = 0; ib < 2; ++ib) { float ms = 0.f;
#pragma unroll
        for (int vb = 0; vb < 2; ++vb)
#pragma unroll
            for (int r = 0; r < 16; ++r) ms += O[vb][ib][r] * O[vb][ib][r];
        ms += __shfl_xor(ms, 32); const float rn = rsqrtf(ms * (1.f / 64.f) + EPS); const size_t row = row0 + 32 * ib + r32;
#pragma unroll
        for (int vb = 0; vb < 2; ++vb)
#pragma unroll
            for (int g = 0; g < 4; ++g) { const int vc0 = 32 * vb + 8 * g + 4 * h; const f32x4 gn = *(const f32x4*)(gain + vc0); const v2u gw = *(const v2u*)(Zt + (size_t)(32 * ib + r32) * 4096 + 192 + vc0);
                const float o0 = O[vb][ib][4 * g] * rn * gn[0] * bf2f((unsigned short)(gw.x & 0xffffu)), o1 = O[vb][ib][4 * g + 1] * rn * gn[1] * bf2f((unsigned short)(gw.x >> 16));
                const float o2 = O[vb][ib][4 * g + 2] * rn * gn[2] * bf2f((unsigned short)(gw.y & 0xffffu)), o3 = O[vb][ib][4 * g + 3] * rn * gn[3] * bf2f((unsigned short)(gw.y >> 16));
                v2u w; w.x = cvtpk(o0, o1); w.y = cvtpk(o2, o3); *(v2u*)(mixed + row * D + head * 64 + vc0) = w; } }
    LDS_WAIT(); asm volatile("" ::: "memory");
}
__device__ __forceinline__ float wave_scan_add(float x, int lane) {
#pragma unroll
    for (int d = 1; d < 64; d <<= 1) { const float t = __shfl_up(x, d); if (lane >= d) x += t; }
    return x;
}
__device__ __forceinline__ float wave_scan_max(float x, int lane) {
#pragma unroll
    for (int d = 1; d < 64; d <<= 1) { const float t = __shfl_up(x, d); if (lane >= d) x = fmaxf(x, t); }
    return x;
}
__device__ __forceinline__ float wave_max(float v) {
#pragma unroll
    for (int o = 1; o < 64; o <<= 1) v = fmaxf(v, __shfl_xor(v, o));
    return v;
}
struct ConvW { f32x4 w[4][2]; };
__device__ __forceinline__ void load_convw(ConvW& cw, const float* p) {
#pragma unroll
    for (int tap = 0; tap < 4; ++tap) { cw.w[tap][0] = *(const f32x4*)(p + tap * 512); cw.w[tap][1] = *(const f32x4*)(p + tap * 512 + 4); }
}
__device__ __forceinline__ void conv8(float (&y)[8], const bf16* zsrc, int t, int tglob, int d0, const ConvW& cw) {
#pragma unroll
    for (int j = 0; j < 8; ++j) y[j] = 0.f;
#pragma unroll
    for (int tap = 0; tap < 4; ++tap) { const f32x4 w0 = cw.w[tap][0], w1 = cw.w[tap][1];
        const bool ok = tglob - 3 + tap >= 0; const int rr = ok ? t - 3 + tap : 0;
        v4u rv = *(const v4u*)(zsrc + (long)rr * 4096 + d0); rv.x = ok ? rv.x : 0u; rv.y = ok ? rv.y : 0u; rv.z = ok ? rv.z : 0u; rv.w = ok ? rv.w : 0u;
        y[0] += w0[0] * bf2f((unsigned short)(rv.x & 0xffffu)); y[1] += w0[1] * bf2f((unsigned short)(rv.x >> 16)); y[2] += w0[2] * bf2f((unsigned short)(rv.y & 0xffffu)); y[3] += w0[3] * bf2f((unsigned short)(rv.y >> 16));
        y[4] += w1[0] * bf2f((unsigned short)(rv.z & 0xffffu)); y[5] += w1[1] * bf2f((unsigned short)(rv.z >> 16)); y[6] += w1[2] * bf2f((unsigned short)(rv.w & 0xffffu)); y[7] += w1[3] * bf2f((unsigned short)(rv.w >> 16)); }
#pragma unroll
    for (int j = 0; j < 8; ++j) y[j] = y[j] * fsig_(y[j]);
}
__device__ __forceinline__ bf16x8 pk8f(const float (&y)[8], float sc) { v4u p; p.x = cvtpk(y[0] * sc, y[1] * sc); p.y = cvtpk(y[2] * sc, y[3] * sc); p.z = cvtpk(y[4] * sc, y[5] * sc); p.w = cvtpk(y[6] * sc, y[7] * sc); return __builtin_bit_cast(bf16x8, p); }
__device__ __forceinline__ void mix_c1_m(const Args& a, LAS unsigned char* wl, int lane, int b, int n, int mh, int l) {
    asm volatile("" : "+v"(lane));
    const size_t row0 = (size_t)b * S + n * 64; const bf16* Zt = (const bf16*)(a.ws + WS_Z) + row0 * 4096 + (12 + mh) * 256;
    LAS unsigned char* kimg = wl; LAS unsigned char* vimg = wl + 8192;
    stage_img<8>(vimg, Zt + 128, lane);
    const float* mgp = (const float*)(a.ws + WS_MG) + (row0 + lane) * 8; const float* gb = a.in[I_MGB] + l * 8;
    const float li = mgp[mh] + gb[mh]; const float xf = mgp[4 + mh] + gb[4 + mh]; const float lf = fminf(xf, 0.f) - __logf(1.f + fexp_(-fabsf(xf)));
    const float bc = wave_scan_add(lf, lane), av = li - bc, amax = wave_max(av), blast = __shfl(bc, 63);
    const float pst = fexp_(av - amax) * 0.125f;
    const int h = lane >> 5, r32 = lane & 31; const float* cwk = a.in[I_MCONV] + (size_t)l * 2048 + 256 + mh * 64;
    { const float sc0 = __shfl(pst, r32), sc1 = __shfl(pst, r32 + 32);
#pragma unroll
      for (int s = 0; s < 4; ++s) { const int d0 = 16 * s + 8 * h; ConvW cw; load_convw(cw, cwk + d0); float y[8];
          conv8(y, Zt + 64, r32, n * 64 + r32, d0, cw); *(LAS bf16x8*)(kimg + r32 * 128 + d0 * 2) = pk8f(y, sc0);
          conv8(y, Zt + 64, r32 + 32, n * 64 + r32 + 32, d0, cw); *(LAS bf16x8*)(kimg + (r32 + 32) * 128 + d0 * 2) = pk8f(y, sc1);
          asm volatile("" ::: "memory"); } }
    LDS_WAIT(); asm volatile("" ::: "memory");
    f32x16 U[2][2]; ktv<64>(U, kimg, vimg, lane);
    store_ut<64>(U, (float*)(a.ws + WS_U + (size_t)(b * 64 + n) * U_BN + u_off(12 + mh)), nullptr, lane);
    float* vp = (float*)(a.ws + WS_VEC) + ((size_t)(b * 64 + n) * 16 + 12 + mh) * 192;
    float nu = 0.f;
#pragma unroll 8
    for (int t = 0; t < 64; ++t) nu += bf2f(*(LAS const unsigned short*)(kimg + t * 128 + lane * 2));
    vp[64 + lane] = nu; if (lane == 0) { vp[0] = amax; vp[1] = blast; }
    LDS_WAIT(); asm volatile("" ::: "memory");
}
__device__ __forceinline__ void mix_c3_m(const Args& a, LAS unsigned char* wl, int lane, int b, int n, int mh, int l) {
    asm volatile("" : "+v"(lane));
    const size_t row0 = (size_t)b * S + n * 64; const bf16* Zt = (const bf16*)(a.ws + WS_Z) + row0 * 4096 + (12 + mh) * 256;
    LAS unsigned char* vimg = wl; stage_img<8>(vimg, Zt + 128, lane);
    const float* vp = (const float*)(a.ws + WS_VEC) + ((size_t)(b * 64 + n) * 16 + 12 + mh) * 192;
    const float* mgp = (const float*)(a.ws + WS_MG) + (row0 + lane) * 8; const float* gb = a.in[I_MGB] + l * 8;
    const float li = mgp[mh] + gb[mh]; const float xf = mgp[4 + mh] + gb[4 + mh]; const float lf = fminf(xf, 0.f) - __logf(1.f + fexp_(-fabsf(xf)));
    const float bc = wave_scan_add(lf, lane), av = li - bc, amax = wave_max(av), mprev = vp[2];
    const float Mi = fmaxf(mprev, wave_scan_max(av, lane)); const float pst = fexp_(av - amax) * 0.125f;
    const int h = lane >> 5, r32 = lane & 31, g16 = (lane >> 4) & 1, q = (lane & 15) >> 2, p = lane & 3;
    const float* cwq = a.in[I_MCONV] + (size_t)l * 2048 + mh * 64; const float* cwk = cwq + 256;
    bf16x8 Qf[2][4], Kf[2][4];
    { const float sc0 = __shfl(pst, r32), sc1 = __shfl(pst, r32 + 32);
#pragma unroll
      for (int s = 0; s < 4; ++s) { const int d0 = 16 * s + 8 * h; ConvW cw; float y[8];
          load_convw(cw, cwq + d0);
          conv8(y, Zt, r32, n * 64 + r32, d0, cw); Qf[0][s] = pk8f(y, 1.f); conv8(y, Zt, r32 + 32, n * 64 + r32 + 32, d0, cw); Qf[1][s] = pk8f(y, 1.f);
          asm volatile("" ::: "memory");
          load_convw(cw, cwk + d0);
          conv8(y, Zt + 64, r32, n * 64 + r32, d0, cw); Kf[0][s] = pk8f(y, sc0); conv8(y, Zt + 64, r32 + 32, n * 64 + r32 + 32, d0, cw); Kf[1][s] = pk8f(y, sc1);
          asm volatile("" ::: "memory"); } }
    f32x16 X00, X01, X11;
#pragma unroll
    for (int r = 0; r < 16; ++r) { X00[r] = 0.f; X01[r] = 0.f; X11[r] = 0.f; }
#pragma unroll
    for (int s = 0; s < 4; ++s) { X00 = MFMA32(Kf[0][s], Qf[0][s], X00); X01 = MFMA32(Kf[0][s], Qf[1][s], X01); X11 = MFMA32(Kf[1][s], Qf[1][s], X11); }
    float Mc[2], bi[2], si[2], den[2];
#pragma unroll
    for (int ib = 0; ib < 2; ++ib) { Mc[ib] = __shfl(Mi, r32 + 32 * ib); bi[ib] = __shfl(bc, r32 + 32 * ib); si[ib] = fexp_(mprev - Mc[ib]); }
    { const float f0 = fexp_(amax - Mc[0]), f1 = fexp_(amax - Mc[1]); float d0 = 0.f, d1 = 0.f;
#pragma unroll
      for (int r = 0; r < 16; ++r) { const int jl = (r & 3) + 8 * (r >> 2) + 4 * h; const bool keep = jl <= r32;
          X00[r] = keep ? X00[r] * f0 : 0.f; X01[r] = X01[r] * f1; X11[r] = keep ? X11[r] * f1 : 0.f; d0 += X00[r]; d1 += X01[r] + X11[r]; }
      den[0] = d0 + __shfl_xor(d0, 32); den[1] = d1 + __shfl_xor(d1, 32); }
    bf16x8 P00[2], P01[2], P11[2];
#pragma unroll
    for (int s2 = 0; s2 < 2; ++s2) { P00[s2] = pack8(X00, s2); P01[s2] = pack8(X01, s2); P11[s2] = pack8(X11, s2); }
    f32x16 O[2][2];
#pragma unroll
    for (int vb = 0; vb < 2; ++vb)
#pragma unroll
        for (int ib = 0; ib < 2; ++ib)
#pragma unroll
            for (int r = 0; r < 16; ++r) O[vb][ib][r] = 0.f;
    const bf16* CpT = (const bf16*)(a.ws + WS_XN + (size_t)(b * 64 + n) * SP_BN + u_off(12 + mh) / 2);
#pragma unroll
    for (int vb = 0; vb < 2; ++vb)
#pragma unroll
        for (int s = 0; s < 4; ++s) { const bf16x8 A = *(const bf16x8*)(CpT + (size_t)(32 * vb + r32) * 64 + 16 * s + 8 * h); O[vb][0] = MFMA32(A, Qf[0][s], O[vb][0]); O[vb][1] = MFMA32(A, Qf[1][s], O[vb][1]); }
    { float qn0 = 0.f, qn1 = 0.f;
#pragma unroll
      for (int s = 0; s < 4; ++s) { const f32x4 n0 = *(const f32x4*)(vp + 128 + 16 * s + 8 * h), n1 = *(const f32x4*)(vp + 128 + 16 * s + 8 * h + 4);
#pragma unroll
          for (int j = 0; j < 4; ++j) { qn0 += bf2f((unsigned short)Qf[0][s][j]) * n0[j] + bf2f((unsigned short)Qf[0][s][4 + j]) * n1[j]; qn1 += bf2f((unsigned short)Qf[1][s][j]) * n0[j] + bf2f((unsigned short)Qf[1][s][4 + j]) * n1[j]; } }
      qn0 += __shfl_xor(qn0, 32); qn1 += __shfl_xor(qn1, 32); den[0] += si[0] * qn0; den[1] += si[1] * qn1; }
#pragma unroll
    for (int vb = 0; vb < 2; ++vb)
#pragma unroll
        for (int ib = 0; ib < 2; ++ib)
#pragma unroll
            for (int r = 0; r < 16; ++r) O[vb][ib][r] *= si[ib];
    LDS_WAIT(); asm volatile("" ::: "memory");
#pragma unroll
    for (int vb = 0; vb < 2; ++vb)
#pragma unroll
        for (int jb = 0; jb < 2; ++jb)
#pragma unroll
            for (int s2 = 0; s2 < 2; ++s2) { const int t0 = 32 * jb + 16 * s2 + 4 * h + q; LAS const unsigned char* cp = vimg + (32 * vb + 16 * g16 + 4 * p) * 2;
                const bf16x8 A = cat8(tr16(cp + t0 * 128), tr16(cp + (t0 + 8) * 128));
                if (jb == 0) { O[vb][0] = MFMA32(A, P00[s2], O[vb][0]); O[vb][1] = MFMA32(A, P01[s2], O[vb][1]); } else O[vb][1] = MFMA32(A, P11[s2], O[vb][1]); }
    const float* gain = a.in[I_MNORM] + l * 256 + mh * 64; bf16* mixed = (bf16*)(a.ws + WS_MIX);
#pragma unroll
    for (int ib = 0; ib < 2; ++ib) { const float inv = 1.f / fmaxf(fabsf(den[ib]), fexp_(-(bi[ib] + Mc[ib]))); float sm = 0.f;
#pragma unroll
        for (int vb = 0; vb < 2; ++vb)
#pragma unroll
            for (int r = 0; r < 16; ++r) { O[vb][ib][r] *= inv; sm += O[vb][ib][r]; }
        sm += __shfl_xor(sm, 32); const float mu = sm * (1.f / 64.f); float sv = 0.f;
#pragma unroll
        for (int vb = 0; vb < 2; ++vb)
#pragma unroll
            for (int r = 0; r < 16; ++r) { const float dlt = O[vb][ib][r] - mu; sv += dlt * dlt; }
        sv += __shfl_xor(sv, 32); const float rn = rsqrtf(sv * (1.f / 64.f) + EPS); const size_t row = row0 + 32 * ib + r32;
#pragma unroll
        for (int vb = 0; vb < 2; ++vb)
#pragma unroll
            for (int g = 0; g < 4; ++g) { const int vc0 = 32 * vb + 8 * g + 4 * h; const f32x4 gn = *(const f32x4*)(gain + vc0); const v2u gw = *(const v2u*)(Zt + (size_t)(32 * ib + r32) * 4096 + 192 + vc0);
                const float o0 = (O[vb][ib][4 * g] - mu) * rn * gn[0] * bf2f((unsigned short)(gw.x & 0xffffu)), o1 = (O[vb][ib][4 * g + 1] - mu) * rn * gn[1] * bf2f((unsigned short)(gw.x >> 16));
                const float o2 = (O[vb][ib][4 * g + 2] - mu) * rn * gn[2] * bf2f((unsigned short)(gw.y & 0xffffu)), o3 = (O[vb][ib][4 * g + 3] - mu) * rn * gn[3] * bf2f((unsigned short)(gw.y >> 16));
                v2u w; w.x = cvtpk(o0, o1); w.y = cvtpk(o2, o3); *(v2u*)(mixed + row * D + (12 + mh) * 64 + vc0) = w; } }
    LDS_WAIT(); asm volatile("" ::: "memory");
}
__device__ __forceinline__ void phase_c1(const Args& a, LAS unsigned char* lds, int lane, int wave, int l) {
    LAS unsigned char* wl = lds + wave * 16384; const int gw = blockIdx.x * NWAVES + wave, NGW = gridDim.x * NWAVES;
    for (int id = gw, k = 0; id < NB * 64 * 16; id += NGW, ++k) { const int bn = id >> 4, head = (id + 8 * k) & 15, b = bn >> 6, n = bn & 63;
        if (head < 6) mix_c1_gh<32>(a, wl, lane, b, n, head); else if (head < 12) mix_c1_gh<64>(a, wl, lane, b, n, head); else mix_c1_m(a, wl, lane, b, n, head - 12, l); }
}
__device__ __forceinline__ void phase_c3(const Args& a, LAS unsigned char* lds, int lane, int wave, int l) {
    LAS unsigned char* wl = lds + wave * 16384; const int gw = blockIdx.x * NWAVES + wave, NGW = gridDim.x * NWAVES;
    for (int id = gw, k = 0; id < NB * 64 * 16; id += NGW, ++k) { const int bn = id >> 4, head = (id + 8 * k) & 15, b = bn >> 6, n = bn & 63;
        if (head < 6) mix_c3_gh<32>(a, wl, lane, b, n, head, l); else if (head < 12) mix_c3_gh<64>(a, wl, lane, b, n, head, l); else mix_c3_m(a, wl, lane, b, n, head - 12, l); }
}
__device__ __forceinline__ void phase_c2(const Args& a, int tid) {
    constexpr int TPB = 6 * 512 + 6 * 1024 + 4 * 1040;
    const unsigned char* ws = a.ws; float* vecb = (float*)(a.ws + WS_VEC);
    for (int task = blockIdx.x * (NWAVES * 64) + tid; task < NB * TPB; task += gridDim.x * NWAVES * 64) {
        const int b = task / TPB; int r = task % TPB; int head, qi;
        if (r < 3072) { head = r >> 9; qi = r & 511; } else if (r < 9216) { head = 6 + ((r - 3072) >> 10); qi = (r - 3072) & 1023; } else { head = 12 + (r - 9216) / 1040; qi = (r - 9216) % 1040; }
        const int uo = u_off(head);
        if (head < 12) { const int KCH = head < 6 ? 32 : 64; const int c0 = (qi * 4) % KCH; f32x4 st = (f32x4){0.f, 0.f, 0.f, 0.f};
#pragma unroll 4
            for (int n = 0; n < 64; ++n) { const size_t bn = (size_t)(b * 64 + n); const float* vp = vecb + (bn * 16 + head) * 192;
                const f32x4 er = *(const f32x4*)(vp + c0), ed = *(const f32x4*)(vp + 128 + c0); const f32x4 u = *(const f32x4*)(ws + WS_U + bn * U_BN + uo + (size_t)qi * 16);
                const f32x4 sp = st * er; v2u w; w.x = cvtpk(sp[0], sp[1]); w.y = cvtpk(sp[2], sp[3]); *(v2u*)(a.ws + WS_XN + bn * SP_BN + uo / 2 + (size_t)qi * 8) = w;
                st = ed * st + u; }
        } else { f32x4 st = (f32x4){0.f, 0.f, 0.f, 0.f}; float m = 0.f; const bool isvec = qi >= 1024; const int dq = qi - 1024;
#pragma unroll 4
            for (int n = 0; n < 64; ++n) { const size_t bn = (size_t)(b * 64 + n); float* vp = vecb + (bn * 16 + head) * 192;
                const float amax = vp[0], blast = vp[1]; const float mnew = fmaxf(blast + m, blast + amax), so = fexp_(blast + m - mnew), sl = fexp_(blast + amax - mnew);
                if (!isvec) { const f32x4 u = *(const f32x4*)(ws + WS_U + bn * U_BN + uo + (size_t)qi * 16);
                    v2u w; w.x = cvtpk(st[0], st[1]); w.y = cvtpk(st[2], st[3]); *(v2u*)(a.ws + WS_XN + bn * SP_BN + uo / 2 + (size_t)qi * 8) = w; st = st * so + u * sl; }
                else { const f32x4 nu = *(const f32x4*)(vp + 64 + 4 * dq); *(f32x4*)(vp + 128 + 4 * dq) = st; if (dq == 0) vp[2] = m; st = st * so + nu * sl; }
                m = mnew; }
        }
    }
}
constexpr int NPL = 7;
constexpr int NPRE = 3;
constexpr int NPH = NPRE + NPL * L + 1;
#ifndef MK_ONE_LAUNCH
#define MK_ONE_LAUNCH 1
#endif
__global__ void __launch_bounds__(NWAVES * 64, 2) mk_fwd(Args args) {
    extern __shared__ __attribute__((aligned(16))) unsigned char lds_raw[];
    LAS unsigned char* lds = (LAS unsigned char*)lds_raw;
    volatile LAS unsigned* MISC = (volatile LAS unsigned*)(lds + MISC_OFF);
    const int tid0 = threadIdx.x;
    for (int u = tid0; u < (LDS_BYTES - RING_BYTES) / 4; u += NWAVES * 64) ((LAS unsigned*)(lds + RING_BYTES))[u] = 0u;
    __syncthreads();
    unsigned* ctl = (unsigned*)(args.ws + WS_CTL);
    XcdBarrier bar; bar.bar = ctl + 4096; bar.x = 0; bar.st = nullptr;
    if (args.ph_hi - args.ph_lo > 1) bar = xcd_barrier_post(ctl + 4096, MISC + 8);
    unsigned char* ws = args.ws;
    for (int p = args.ph_lo; p < args.ph_hi; ++p) {
        int tid = tid0; asm volatile("" : "+v"(tid));
        const int lane = tid & 63, wave = __builtin_amdgcn_readfirstlane(tid >> 6);
        if (p == 0) phase_p0a(args, lds, tid);
        else if (p == 1) phase_p0b(args, tid);
        else if (p == 2) phase_p1(args, lds, tid, lane, wave);
        else if (p == NPH - 1) phase_final(args, lane, wave);
        else {
            const int l = (p - NPRE) / NPL, j = (p - NPRE) % NPL;
            unsigned char* wl = ws + WS_W + (size_t)l * W_LAYER;
            const float* mod_l = (const float*)(ws + WS_MOD) + (size_t)l * NB * 6 * D;
            float* ssq = (float*)(ws + WS_SSQ);
            if (j == 0) {
                pg8::Gemm g{(const bf16*)(ws + WS_XN), (const bf16*)(wl + W_IN), M, NIN, D}; pg8::StaticOrder S; S.init(M, NIN, gridDim.x, (int)blockIdx.x);
                pg8::EpiIn E{(bf16*)(ws + WS_Z), (float*)(ws + WS_VEC), (float*)(ws + WS_MG), (const float*)(ws + WS_BIAS) + (size_t)l * NB * 4096, ssq, (const float*)(ws + WS_LB) + l * 384, args.in[I_GBG] + l * 192};
                pg8::gemm_phase<pg8::EpiIn, pg8::StaticOrder, true, true>(lds, g, S, E);
            } else if (j == 1) { phase_c1(args, lds, lane, wave, l);
            } else if (j == 2) { phase_c2(args, tid);
            } else if (j == 3) { phase_c3(args, lds, lane, wave, l);
            } else if (j == 4) {
                pg8::Gemm g{(const bf16*)(ws + WS_MIX), (const bf16*)(wl + W_OUT), M, D, D}; pg8::StaticOrder S; S.init(M, D, gridDim.x, (int)blockIdx.x);
                pg8::EpiRes E{l == 0 ? args.in[I_X] : args.out, args.out, mod_l + 2 * D, (const float*)(ws + WS_GMUL) + (size_t)(l * 2 + 1) * NB * D, (bf16*)(ws + WS_XN), ssq};
                pg8::gemm_phase<pg8::EpiRes, pg8::StaticOrder, true, true>(lds, g, S, E);
            } else if (j == 5) {
                pg8::Gemm g{(const bf16*)(ws + WS_XN), (const bf16*)(wl + W_1), M, DFF, D}; pg8::StaticOrder S; S.init(M, DFF, gridDim.x, (int)blockIdx.x);
                pg8::EpiFF1 E{(bf16*)(ws + WS_Z), (const float*)(ws + WS_BIAS) + (size_t)(L + l) * NB * 4096, ssq};
                pg8::gemm_phase<pg8::EpiFF1, pg8::StaticOrder, true, true>(lds, g, S, E);
            } else {
                pg8::Gemm g{(const bf16*)(ws + WS_Z), (const bf16*)(wl + W_2), M, D, DFF}; pg8::StaticOrder S; S.init(M, D, gridDim.x, (int)blockIdx.x);
                pg8::EpiRes E{args.out, args.out, mod_l + 5 * D, l + 1 < L ? (const float*)(ws + WS_GMUL) + (size_t)((l + 1) * 2) * NB * D : nullptr, (bf16*)(ws + WS_XN), ssq};
                pg8::gemm_phase<pg8::EpiRes, pg8::StaticOrder, true, true>(lds, g, S, E);
            }
        }
        if (p + 1 < args.ph_hi) xcd_barrier(bar);
    }
}

extern "C" void kernel_launch(void* const* d_in, const int* in_sizes, int n_in, void* d_out, int out_size, void* d_ws, size_t ws_size, hipStream_t stream) {
    static int grid = 0;
    if (grid == 0) {
        if (n_in != 19 || out_size != M * D || ws_size < WS_END) { fprintf(stderr, "kernel_launch: unexpected shapes (n_in %d out %d ws %zu)\n", n_in, out_size, ws_size); grid = -1; return; }
        int dev = 0, cus = 0, per_cu = 0;
        if (hipGetDevice(&dev) != hipSuccess || hipDeviceGetAttribute(&cus, hipDeviceAttributeMultiprocessorCount, dev) != hipSuccess) { grid = -1; return; }
        if (hipFuncSetAttribute((const void*)mk_fwd, hipFuncAttributeMaxDynamicSharedMemorySize, LDS_BYTES) != hipSuccess) { fprintf(stderr, "kernel_launch: hipFuncSetAttribute failed\n"); grid = -1; return; }
        if (hipOccupancyMaxActiveBlocksPerMultiprocessor(&per_cu, (const void*)mk_fwd, NWAVES * 64, LDS_BYTES) != hipSuccess || per_cu < 1) { fprintf(stderr, "kernel_launch: occupancy query says %d blocks/CU\n", per_cu); grid = -1; (void)hipGetLastError(); return; }
        grid = cus;
    }
    if (grid < 0) return;
    (void)hipMemsetAsync((char*)d_ws + WS_CTL, 0, CTL_ZERO_BYTES, stream);
    Args a{};
    for (int i = 0; i < 19; ++i) a.in[i] = (const float*)d_in[i];
    a.out = (float*)d_out; a.ws = (unsigned char*)d_ws;
#if MK_ONE_LAUNCH
    a.ph_lo = 0; a.ph_hi = NPH; a.li = 0;
    hipLaunchKernelGGL(mk_fwd, dim3(grid), dim3(NWAVES * 64), LDS_BYTES, stream, a);
#else
    for (int p = 0; p < NPH; ++p) { a.ph_lo = p; a.ph_hi = p + 1; a.li = 0; hipLaunchKernelGGL(mk_fwd, dim3(grid), dim3(NWAVES * 64), LDS_BYTES, stream, a); }
#endif
}
```

```cpp
#include <hip/hip_runtime.h>
#include <cstdint>
#include <cstdio>

namespace cfg {
constexpr int D = 1024, NB = 4, S = 4096, L = 4, M = NB * S, DIN = 3736, DFF = 4096, NIN = 4096  ;
constexpr int GQ = 0, GK = 192, GV = 384, GLOW = 768, GOUT = 784, HQ = 1168, HF = 1552, HI = 1936, HOUT = 2320,
              MQK = 2704, MV = 3216, MI = 3472, MF = 3476, MOUT = 3480;
constexpr float EPS = 1e-6f;
constexpr size_t MiB = 1u << 20;
constexpr size_t WS_CTL = 0, CTL_ZERO_BYTES = 1 * MiB;
constexpr size_t WS_MOD = 256 * 1024;
constexpr size_t WS_LB = 1 * MiB;
constexpr size_t WS_GMUL = 1 * MiB + 64 * 1024;
constexpr size_t WS_BIAS = 2 * MiB;
constexpr size_t WS_MG = 3 * MiB;
constexpr size_t WS_SSQ = 4 * MiB;
constexpr size_t WS_FOLD = 304 * MiB + 8 * MiB;
constexpr size_t WS_VEC = 5 * MiB;
constexpr size_t WS_W = 8 * MiB, W_LAYER = 26 * MiB;
constexpr size_t W_IN = 0, W_OUT = 8 * MiB, W_1 = 10 * MiB, W_2 = 18 * MiB;
constexpr size_t WS_XN = 112 * MiB;
constexpr size_t WS_MIX = 144 * MiB;
constexpr size_t WS_Z = 176 * MiB;
constexpr size_t WS_U = 304 * MiB;
constexpr size_t WS_END = 356 * MiB;
}
using namespace cfg;

#define GAS __attribute__((address_space(1)))
#define LAS __attribute__((address_space(3)))
typedef unsigned short bf16;
typedef unsigned v4u __attribute__((ext_vector_type(4)));
typedef unsigned v2u __attribute__((ext_vector_type(2)));
typedef float f32x4 __attribute__((ext_vector_type(4)));
typedef float f32x16 __attribute__((ext_vector_type(16)));
typedef short bf16x8 __attribute__((ext_vector_type(8)));
typedef GAS unsigned gu32;
#define RLX_AGENT __ATOMIC_RELAXED, __HIP_MEMORY_SCOPE_AGENT

__device__ __forceinline__ unsigned f2bf(float f) { unsigned u = __builtin_bit_cast(unsigned, f); return (u + 0x7fffu + ((u >> 16) & 1u)) >> 16; }
__device__ __forceinline__ unsigned pk2(float lo, float hi) { return f2bf(lo) | (f2bf(hi) << 16); }
__device__ __forceinline__ float bf2f(unsigned short h) { return __builtin_bit_cast(float, (unsigned)h << 16); }
__device__ __forceinline__ float sigmoidf_(float x) { return 1.f / (1.f + __expf(-x)); }
__device__ __forceinline__ float siluf_(float x) { return x * sigmoidf_(x); }
__device__ __forceinline__ float logsigmoidf_(float x) { return fminf(x, 0.f) - log1pf(__expf(-fabsf(x))); }
__device__ __forceinline__ float wave_sum(float v) {
#pragma unroll
    for (int o = 1; o < 64; o <<= 1) v += __shfl_xor(v, o);
    return v;
}
__host__ __device__ __forceinline__ int in_src(int np) {
    const int pn = np >> 8, tc = np & 255, bj = tc >> 7, wc = (tc >> 5) & 3, n = (tc >> 4) & 1, g = tc & 15;
    if (pn < 6) { const int gh = pn;
        if (wc < 2) { const int c = 16 * wc + g;
            if (bj == 0) return (n == 0 ? GQ : GK) + gh * 32 + c;
            if (n == 0) return -2 - (gh * 32 + c);
            if (gh == 0 && wc == 0 && g < 8) return (g < 4) ? MI + g : MF + (g - 4);
            return -1; }
        const int e = 32 * (wc - 2) + 16 * n + g; return (bj == 0 ? GV : GOUT) + gh * 64 + e; }
    if (pn < 12) { const int hh = pn - 6, c = 16 * wc + g; const int base = bj == 0 ? (n == 0 ? HQ : HF) : (n == 0 ? HI : HOUT); return base + hh * 64 + c; }
    const int mh = pn - 12, grp = tc >> 6, c = tc & 63;
    return (grp == 0 ? MQK : grp == 1 ? MQK + 256 : grp == 2 ? MV : MOUT) + mh * 64 + c;
}
namespace pg8 {
#define PG8_LAS __attribute__((address_space(3)))
typedef unsigned short bf16_t;
typedef short bf16x8 __attribute__((ext_vector_type(8)));
typedef float f32x4 __attribute__((ext_vector_type(4)));
typedef unsigned u32x4 __attribute__((ext_vector_type(4)));
constexpr int BM = 256, BK = 64, HALF = 128, HTB = HALF * BK * 2  , STAGE_BYTES = 8 * HTB, NXCD = 8, WGM = 8;

__host__ __device__ __forceinline__ int lds_byte(int r, int c) { const int st = (r >> 4) * 2 + (c >> 5), rr = r & 15, cc = c & 31, ob = rr * 64 + cc * 2; return st * 1024 + (ob ^ (((ob >> 9) & 1) << 5)); }
__host__ __device__ __forceinline__ void stage_rc(int b, int& R, int& C) { const int st = b / 1024, sb = b % 1024, swz = sb ^ (((sb >> 9) & 1) << 5); R = (st >> 1) * 16 + swz / 64; C = (st & 1) * 32 + (swz % 64) / 2; }
__host__ __device__ __forceinline__ int perm32(int rho) { const int n = rho >> 4, i = rho & 15; return 8 * (i >> 2) + 4 * n + (i & 3); }

struct Unit { int pm, pn; };
struct Gemm { const bf16_t* A; const bf16_t* Bt; int M, N, K; };

struct StaticOrder {
    int nM, nN, nwg, G, c;
    __host__ __device__ void init(int M, int N, int G_, int c_) { nM = M / BM; nN = N / BM; nwg = nM * nN; G = G_; c = c_; }
    __host__ __device__ bool next(int i, Unit& u) const {
        const long L = (long)i * G + c; if (L >= nwg) return false;
        int wgid = (int)L; { const int q = nwg / NXCD, r = nwg % NXCD, xcd = wgid % NXCD, off = wgid / NXCD; wgid = (xcd < r ? xcd * (q + 1) : r * (q + 1) + (xcd - r) * q) + off; }
        const int nig = WGM * nN, gid = wgid / nig, fm = gid * WGM, gsz = (nM - fm) < WGM ? (nM - fm) : WGM;
        u.pm = fm + ((wgid % nig) % gsz); u.pn = (wgid % nig) / gsz; return true;
    }
    __device__ __forceinline__ void a_ready(const Unit&) const {}
    __device__ __forceinline__ void done(const Unit&) const {}
};

typedef float f32x2 __attribute__((ext_vector_type(2)));
typedef unsigned u32x2 __attribute__((ext_vector_type(2)));
__device__ __forceinline__ unsigned cvt_pk_bf16(float lo, float hi) { typedef __bf16 bf16x2_t __attribute__((ext_vector_type(2))); f32x2 v = {lo, hi}; bf16x2_t b = __builtin_convertvector(v, bf16x2_t); return __builtin_bit_cast(unsigned, b); }
__device__ __forceinline__ float row_rstd(const float* ssq, int row, int fq) {
    const f32x4 p = *(const f32x4*)(ssq + (size_t)row * 16 + 4 * fq); float s = (p[0] + p[1]) + (p[2] + p[3]);
    s += __shfl_xor(s, 16); s += __shfl_xor(s, 32);
    return rsqrtf(s * (1.0f / 1024.0f) + 1e-6f);
}
struct EpiRes {
    static constexpr bool PERM = false, AFTER_DRAIN = false;
    const float* xin; float* xout; const float* gate  ; const float* gmul  ; bf16_t* xn; float* ssq;
    __device__ __forceinline__ void operator()(const f32x4 (&acc)[2][2][4][2], const Unit& u, int wr, int wc, int fr, int fq) const {
        const int b = u.pm >> 4, col0 = u.pn * BM + wc * 32 + 4 * fq; const int row0 = u.pm * BM + wr * 64 + fr;
        const unsigned eb = (unsigned)row0 * 1024u + (unsigned)col0;
        const char* xi = (const char*)xin; char* xo_ = (char*)xout; char* xn_ = (char*)xn; const bool has_gm = gmul != nullptr;
        float s[2][4];
#pragma unroll
        for (int ai = 0; ai < 2; ++ai)
#pragma unroll
            for (int m = 0; m < 4; ++m) s[ai][m] = 0.f;
#pragma unroll
        for (int bj = 0; bj < 2; ++bj)
#pragma unroll
            for (int n = 0; n < 2; ++n) { const unsigned c = (unsigned)(col0 + bj * HALF + n * 16); const f32x4 gv = *(const f32x4*)((const char*)gate + (((unsigned)b * 6144u + c) << 2));
                f32x4 gm = (f32x4){0.f, 0.f, 0.f, 0.f}; if (has_gm) gm = *(const f32x4*)((const char*)gmul + (((unsigned)b * 1024u + c) << 2));
#pragma unroll
                for (int ai = 0; ai < 2; ++ai)
#pragma unroll
                    for (int m = 0; m < 4; ++m) { const unsigned e = eb + (unsigned)((ai * HALF + m * 16) * 1024 + bj * HALF + n * 16);
                        const f32x4 xo = *(const f32x4*)(xi + (e << 2)); const f32x4 xw = xo + gv * acc[ai][bj][m][n];
                        *(f32x4*)(xo_ + (e << 2)) = xw; s[ai][m] += (xw[0] * xw[0] + xw[1] * xw[1]) + (xw[2] * xw[2] + xw[3] * xw[3]);
                        if (has_gm) { const f32x4 p = xw * gm; u32x2 w; w.x = cvt_pk_bf16(p[0], p[1]); w.y = cvt_pk_bf16(p[2], p[3]); *(u32x2*)(xn_ + (e << 1)) = w; } }
                asm volatile("" ::: "memory"); }
#pragma unroll
        for (int ai = 0; ai < 2; ++ai)
#pragma unroll
            for (int m = 0; m < 4; ++m) { float t = s[ai][m]; t += __shfl_xor(t, 16); t += __shfl_xor(t, 32);
                if (fq == 0) *(float*)((char*)ssq + ((((unsigned)(row0 + ai * HALF + m * 16)) * 16u + (unsigned)(u.pn * 4 + wc)) << 2)) = t; }
    }
};
struct EpiFF1 {
    static constexpr bool PERM = true, AFTER_DRAIN = false;
    bf16_t* O; const float* bias  ; const float* ssq;
    __device__ __forceinline__ void operator()(const f32x4 (&acc)[2][2][4][2], const Unit& u, int wr, int wc, int fr, int fq) const {
        const int b = u.pm >> 4, col0 = u.pn * BM + wc * 32 + 8 * fq;
        f32x4 bv[2][2];
#pragma unroll
        for (int bj = 0; bj < 2; ++bj)
#pragma unroll
            for (int n = 0; n < 2; ++n) bv[bj][n] = *(const f32x4*)(bias + b * 4096 + col0 + bj * HALF + 4 * n);
#pragma unroll
        for (int ai = 0; ai < 2; ++ai)
#pragma unroll
            for (int m = 0; m < 4; ++m) { const int row = u.pm * BM + ai * HALF + wr * 64 + m * 16 + fr; const float rs = row_rstd(ssq, row, fq); bf16_t* rowp = O + (size_t)row * 4096 + col0;
#pragma unroll
                for (int bj = 0; bj < 2; ++bj) { f32x4 v0 = acc[ai][bj][m][0] * rs + bv[bj][0], v1 = acc[ai][bj][m][1] * rs + bv[bj][1];
#pragma unroll
                    for (int j = 0; j < 4; ++j) { const float a = fmaxf(v0[j], 0.f), c = fmaxf(v1[j], 0.f); v0[j] = a * a; v1[j] = c * c; }
                    u32x4 w; w.x = cvt_pk_bf16(v0[0], v0[1]); w.y = cvt_pk_bf16(v0[2], v0[3]); w.z = cvt_pk_bf16(v1[0], v1[1]); w.w = cvt_pk_bf16(v1[2], v1[3]);
                    *(u32x4*)(rowp + bj * HALF) = w; } }
    }
};
template <int CTRL> __device__ __forceinline__ float dpp_shr(float x) { return __builtin_bit_cast(float, __builtin_amdgcn_update_dpp(0, __builtin_bit_cast(int, x), CTRL, 0xf, 0xf, true)); }
__device__ __forceinline__ float row15(float x) { return __shfl(x, 15, 16); }
__device__ __forceinline__ float fexp(float x) { return __builtin_amdgcn_exp2f(x * 1.4426950408889634f); }
__device__ __forceinline__ float fsigmoid(float x) { return __builtin_amdgcn_rcpf(1.f + fexp(-x)); }
__device__ __forceinline__ void chunk_scan(float (&v)[4], float& r, float& last) {
    float tot[4];
#pragma unroll
    for (int m = 0; m < 4; ++m) { float x = v[m]; x += dpp_shr<0x111>(x); x += dpp_shr<0x112>(x); x += dpp_shr<0x114>(x); x += dpp_shr<0x118>(x); v[m] = x; tot[m] = row15(x); }
    r = tot[0] + tot[1]; last = (tot[0] + tot[1]) + (tot[2] + tot[3]);
    v[1] += tot[0]; v[2] += tot[0] + tot[1]; v[3] += (tot[0] + tot[1]) + tot[2];
}
struct EpiIn {
    static constexpr bool PERM = false, AFTER_DRAIN = false;
    bf16_t* Z; float* vec  ; float* mg  ; const float* bias  ; const float* ssq; const float* lbt  ; const float* bgate  ;
    __device__ __forceinline__ void operator()(f32x4 (&acc)[2][2][4][2], const Unit& u, int wr, int wc, int fr, int fq) const {
        const int b = u.pm >> 4, pn = u.pn, col0 = pn * BM + wc * 32 + 4 * fq; const int row0 = u.pm * BM + wr * 64 + fr;
#pragma unroll
        for (int ai = 0; ai < 2; ++ai)
#pragma unroll
            for (int m = 0; m < 4; ++m) { const float rs = row_rstd(ssq, row0 + ai * HALF + m * 16, fq);
#pragma unroll
                for (int bj = 0; bj < 2; ++bj)
#pragma unroll
                    for (int n = 0; n < 2; ++n) acc[ai][bj][m][n] = acc[ai][bj][m][n] * rs + *(const f32x4*)((const char*)bias + (((unsigned)b * 4096u + (unsigned)(col0 + bj * HALF + n * 16)) << 2)); }
        char* Zc = (char*)Z;
        const unsigned zb = ((unsigned)row0 * 4096u + (unsigned)(pn * BM)) * 2u;
#define ZST(ai_, m_, colbyte, val) do { const f32x4 v_ = (val); u32x2 w_; w_.x = cvt_pk_bf16(v_[0], v_[1]); w_.y = cvt_pk_bf16(v_[2], v_[3]); \
        *(u32x2*)(Zc + (zb + (unsigned)(((ai_) * HALF + (m_) * 16) * 8192) + (unsigned)(colbyte))) = w_; } while (0)
        if (pn >= 12) {
#pragma unroll
            for (int ai = 0; ai < 2; ++ai)
#pragma unroll
                for (int m = 0; m < 4; ++m)
#pragma unroll
                    for (int bj = 0; bj < 2; ++bj)
#pragma unroll
                        for (int n = 0; n < 2; ++n) { f32x4 v = acc[ai][bj][m][n]; const int tc = bj * HALF + wc * 32 + n * 16 + 4 * fq;
                            if (bj == 1 && wc >= 2) { v[0] = fsigmoid(v[0]); v[1] = fsigmoid(v[1]); v[2] = fsigmoid(v[2]); v[3] = fsigmoid(v[3]); }
                            ZST(ai, m, tc * 2, v); }
        } else if (pn >= 6) {
            const int c0 = 16 * wc + 4 * fq; const f32x4 lb4 = *(const f32x4*)(lbt + (pn - 6) * 64 + c0);
#pragma unroll
            for (int ai = 0; ai < 2; ++ai) {
                float* vp = vec + ((size_t)((b * 64 + (u.pm & 15) * 4 + 2 * ai + wr) * 16 + pn)) * 192 + c0;
#pragma unroll
                for (int j = 0; j < 4; ++j) { float v[4]; const float lbv = lb4[j];
#pragma unroll
                    for (int m = 0; m < 4; ++m) { const float f = acc[ai][0][m][1][j], sig = fsigmoid(f);
                        const float lsig = fminf(f, 0.f) - __logf(1.f + fexp(-fabsf(f)));
                        v[m] = lbv > 0.f ? __logf(lbv + (1.f - lbv) * sig) : lsig;
                        acc[ai][0][m][1][j] = 1.f - fexp(v[m]);
                        const float q = acc[ai][0][m][0][j]; acc[ai][0][m][0][j] = q * fsigmoid(q); }
                    float r, last; chunk_scan(v, r, last);
#pragma unroll
                    for (int m = 0; m < 4; ++m) { acc[ai][0][m][0][j] *= fexp(fminf(v[m] - r, 60.f)); acc[ai][0][m][1][j] *= fexp(fminf(r - v[m], 60.f)); }
                    if (fr == 0) { vp[j] = fexp(r); vp[64 + j] = fexp(last - r); vp[128 + j] = fexp(last); } }
#pragma unroll
                for (int m = 0; m < 4; ++m) { ZST(ai, m, c0 * 2, acc[ai][0][m][0]); ZST(ai, m, 128 + c0 * 2, acc[ai][0][m][1]); ZST(ai, m, 256 + c0 * 2, acc[ai][1][m][0]);
                    f32x4 g = acc[ai][1][m][1]; g[0] = fsigmoid(g[0]); g[1] = fsigmoid(g[1]); g[2] = fsigmoid(g[2]); g[3] = fsigmoid(g[3]); ZST(ai, m, 384 + c0 * 2, g); }
                asm volatile("" ::: "memory");
            }
        } else if (wc < 2) {
            const int c0 = 16 * wc + 4 * fq; const f32x4 bg4 = *(const f32x4*)(bgate + pn * 32 + c0);
#pragma unroll
            for (int ai = 0; ai < 2; ++ai) {
                float* vp = vec + ((size_t)((b * 64 + (u.pm & 15) * 4 + 2 * ai + wr) * 16 + pn)) * 192 + c0;
#pragma unroll
                for (int j = 0; j < 4; ++j) { float v[4];
#pragma unroll
                    for (int m = 0; m < 4; ++m) { const float x = acc[ai][1][m][0][j] + bg4[j]; v[m] = (fminf(x, 0.f) - __logf(1.f + fexp(-fabsf(x)))) * 0.0625f; }
                    float r, last; chunk_scan(v, r, last);
#pragma unroll
                    for (int m = 0; m < 4; ++m) { acc[ai][0][m][0][j] *= 0.17677669529663687f * fexp(fminf(v[m] - r, 60.f)); acc[ai][0][m][1][j] *= fexp(fminf(r - v[m], 60.f)); }
                    if (fr == 0) { vp[j] = fexp(r); vp[64 + j] = fexp(last - r); vp[128 + j] = fexp(last); } }
#pragma unroll
                for (int m = 0; m < 4; ++m) { ZST(ai, m, c0 * 2, acc[ai][0][m][0]); ZST(ai, m, 64 + c0 * 2, acc[ai][0][m][1]); }
                if (pn == 0 && wc == 0 && fq < 2) {
#pragma unroll
                    for (int m = 0; m < 4; ++m) *(f32x4*)(mg + (size_t)(row0 + ai * HALF + m * 16) * 8 + 4 * fq) = acc[ai][1][m][1]; }
                asm volatile("" ::: "memory");
            }
        } else {
            const int e0 = 32 * (wc - 2) + 4 * fq;
#pragma unroll
            for (int ai = 0; ai < 2; ++ai)
#pragma unroll
                for (int m = 0; m < 4; ++m)
#pragma unroll
                    for (int n = 0; n < 2; ++n) { ZST(ai, m, 256 + (e0 + 16 * n) * 2, acc[ai][0][m][n]);
                        f32x4 g = acc[ai][1][m][n]; g[0] *= fsigmoid(g[0]); g[1] *= fsigmoid(g[1]); g[2] *= fsigmoid(g[2]); g[3] *= fsigmoid(g[3]); ZST(ai, m, 384 + (e0 + 16 * n) * 2, g); }
        }
#undef ZST
    }
};
template <class Epi, class Sched, bool ALIGN_EPI = false, bool SP2 = false>
__device__ __forceinline__ void gemm_phase(PG8_LAS unsigned char* lds, const Gemm g, const Sched& S, const Epi& E) {
    int tid_ = threadIdx.x; asm volatile("" : "+v"(tid_));
    const int tid = tid_, wid = __builtin_amdgcn_readfirstlane(tid >> 6), lane = tid & 63, wr = wid >> 2, wc = wid & 3, fr = lane & 15, fq = lane >> 4;
    const int K = g.K, nt = K / BK;
    unsigned voffA[2], voffB[2];
#pragma unroll
    for (int i = 0; i < 2; ++i) { int R, C; stage_rc(tid * 16 + i * 8192, R, C); const int Rb = Epi::PERM ? ((R & ~31) + perm32(R & 31)) : R;
        voffA[i] = (unsigned)(R * K + C) * 2u; voffB[i] = (unsigned)(Rb * K + C) * 2u; }
    const size_t kstep = (size_t)(BK * 2);
    const size_t hstep = (size_t)HALF * K * 2;
    const size_t tstep = 2 * hstep;
    const unsigned ldsw = (unsigned)wid * 1024u;
    const int aoff = lds_byte(wr * 64 + fr, fq * 8), boff = lds_byte(wc * 32 + fr, fq * 8);
#define PG8_SA(b, h) (((b) * 2 + (h)) * HTB)
#define PG8_SB(b, h) ((4 + (b) * 2 + (h)) * HTB)
#define PG8_STAGE(bufoff, gbase, voff) do { _Pragma("unroll") for (int _i = 0; _i < 2; ++_i) \
        __builtin_amdgcn_global_load_lds((const unsigned*)((const char*)(gbase) + (voff)[_i]), (PG8_LAS unsigned*)(lds + (bufoff) + ldsw + _i * 8192), 16, 0, 0); } while (0)
#define PG8_LDA(dst, b, h) do { _Pragma("unroll") for (int m = 0; m < 4; ++m) _Pragma("unroll") for (int k = 0; k < 2; ++k) dst[m][k] = *(const PG8_LAS bf16x8*)(lds + PG8_SA(b, h) + aoff + m * 2048 + k * 1024); } while (0)
#define PG8_LDB(dst, b, h) do { _Pragma("unroll") for (int n = 0; n < 2; ++n) _Pragma("unroll") for (int k = 0; k < 2; ++k) dst[n][k] = *(const PG8_LAS bf16x8*)(lds + PG8_SB(b, h) + boff + n * 2048 + k * 1024); } while (0)
#define PG8_MMA(ai, bj, At, Bt) do { __builtin_amdgcn_s_setprio(1); _Pragma("unroll") for (int m = 0; m < 4; ++m) _Pragma("unroll") for (int n = 0; n < 2; ++n) _Pragma("unroll") for (int k = 0; k < 2; ++k) \
        acc[ai][bj][m][n] = __builtin_amdgcn_mfma_f32_16x16x32_bf16(Bt[n][k], At[m][k], acc[ai][bj][m][n], 0, 0, 0); __builtin_amdgcn_s_setprio(0); } while (0)
#define PG8_WAIT_V(n) asm volatile("s_waitcnt vmcnt(" #n ")" ::: "memory")
#define PG8_WAIT_L(n) asm volatile("s_waitcnt lgkmcnt(" #n ")" ::: "memory")
#define PG8_BAR __builtin_amdgcn_s_barrier()
#define PG8_SCHED __builtin_amdgcn_sched_barrier(0)
    Unit cur, nxt; int ui = 0;
    if (!S.next(0, cur)) return;
    f32x4 acc[2][2][4][2];
#pragma unroll
    for (int a = 0; a < 2; ++a)
#pragma unroll
        for (int b = 0; b < 2; ++b)
#pragma unroll
            for (int m = 0; m < 4; ++m)
#pragma unroll
                for (int n = 0; n < 2; ++n) acc[a][b][m][n] = (f32x4){0.f, 0.f, 0.f, 0.f};
    bf16x8 At[4][2], B0[2][2], B1[2][2];
    const char* cA = (const char*)g.A + (size_t)cur.pm * tstep; const char* cB = (const char*)g.Bt + (size_t)cur.pn * tstep;
    S.a_ready(cur);
    if constexpr (SP2) {
        PG8_STAGE(PG8_SB(0, 0), cB, voffB); PG8_STAGE(PG8_SB(0, 1), cB + hstep, voffB); PG8_STAGE(PG8_SA(0, 0), cA, voffA); PG8_STAGE(PG8_SA(0, 1), cA + hstep, voffA);
        if (wr == 1) PG8_BAR;
        PG8_WAIT_V(2); PG8_BAR;
        PG8_STAGE(PG8_SB(1, 0), cB + kstep, voffB); PG8_STAGE(PG8_SA(1, 0), cA + kstep, voffA); PG8_STAGE(PG8_SB(1, 1), cB + hstep + kstep, voffB);
        PG8_WAIT_V(6); PG8_BAR;
    } else {
        PG8_STAGE(PG8_SB(0, 0), cB, voffB); PG8_STAGE(PG8_SA(0, 0), cA, voffA); PG8_STAGE(PG8_SB(0, 1), cB + hstep, voffB); PG8_STAGE(PG8_SA(0, 1), cA + hstep, voffA);
        if (wr == 1) PG8_BAR;
        PG8_WAIT_V(4); PG8_BAR;
        PG8_STAGE(PG8_SB(1, 0), cB + kstep, voffB); PG8_STAGE(PG8_SA(1, 0), cA + kstep, voffA); PG8_STAGE(PG8_SB(1, 1), cB + hstep + kstep, voffB);
        PG8_WAIT_V(6); PG8_BAR;
    }
    for (;;) {
        const bool has_next = S.next(ui + 1, nxt);
        const char* nA = has_next ? (const char*)g.A + (size_t)nxt.pm * tstep : cA; const char* nB = has_next ? (const char*)g.Bt + (size_t)nxt.pn * tstep : cB;
        for (int t = 0; t < nt; t += 2) {
            const bool last = (t == nt - 2);
            const char* a1 = cA + (size_t)(t + 1) * kstep;
            const char* a2 = last ? nA : cA + (size_t)(t + 2) * kstep; const char* b2 = last ? nB : cB + (size_t)(t + 2) * kstep;
            const char* a3 = a2 + kstep; const char* b3 = b2 + kstep;
            if (last && has_next) S.a_ready(nxt);
            if constexpr (SP2) {
            PG8_LDB(B0, 0, 0); PG8_LDB(B1, 0, 1); PG8_SCHED; PG8_LDA(At, 0, 0); PG8_STAGE(PG8_SA(1, 1), a1 + hstep, voffA);
            PG8_WAIT_V(8); PG8_WAIT_L(0); PG8_BAR; PG8_MMA(0, 0, At, B0); PG8_MMA(0, 1, At, B1); PG8_BAR; PG8_SCHED;
            PG8_LDA(At, 0, 1); PG8_STAGE(PG8_SB(0, 0), b2, voffB); PG8_STAGE(PG8_SB(0, 1), b2 + hstep, voffB); PG8_STAGE(PG8_SA(0, 0), a2, voffA);
            PG8_WAIT_V(8); PG8_WAIT_L(0); PG8_BAR; PG8_MMA(1, 0, At, B0); PG8_MMA(1, 1, At, B1); PG8_BAR; PG8_SCHED;
            PG8_LDB(B0, 1, 0); PG8_LDB(B1, 1, 1); PG8_SCHED; PG8_LDA(At, 1, 0); PG8_STAGE(PG8_SA(0, 1), a2 + hstep, voffA);
            PG8_WAIT_V(8); PG8_WAIT_L(0); PG8_BAR; PG8_MMA(0, 0, At, B0); PG8_MMA(0, 1, At, B1); PG8_BAR; PG8_SCHED;
            PG8_LDA(At, 1, 1); PG8_STAGE(PG8_SB(1, 0), b3, voffB); PG8_STAGE(PG8_SB(1, 1), b3 + hstep, voffB); PG8_STAGE(PG8_SA(1, 0), a3, voffA);
            PG8_WAIT_V(8); PG8_WAIT_L(0); PG8_BAR; PG8_MMA(1, 0, At, B0); PG8_MMA(1, 1, At, B1); PG8_BAR; PG8_SCHED;
            } else {
            PG8_LDB(B0, 0, 0); PG8_SCHED; PG8_LDA(At, 0, 0); PG8_STAGE(PG8_SA(1, 1), a1 + hstep, voffA);
            PG8_WAIT_L(8); PG8_BAR; PG8_WAIT_L(0); PG8_MMA(0, 0, At, B0); PG8_BAR; PG8_SCHED;
            PG8_LDB(B1, 0, 1); PG8_STAGE(PG8_SB(0, 0), b2, voffB);
            PG8_BAR; PG8_WAIT_L(0); PG8_MMA(0, 1, At, B1); PG8_BAR;
            PG8_LDA(At, 0, 1); PG8_STAGE(PG8_SA(0, 0), a2, voffA);
            PG8_BAR; PG8_WAIT_L(0); PG8_MMA(1, 0, At, B0); PG8_BAR; PG8_SCHED;
            PG8_STAGE(PG8_SB(0, 1), b2 + hstep, voffB);
            PG8_WAIT_V(6); PG8_BAR; PG8_MMA(1, 1, At, B1); PG8_BAR;
            PG8_LDB(B0, 1, 0); PG8_SCHED; PG8_LDA(At, 1, 0); PG8_STAGE(PG8_SA(0, 1), a2 + hstep, voffA);
            PG8_WAIT_L(8); PG8_BAR; PG8_WAIT_L(0); PG8_MMA(0, 0, At, B0); PG8_BAR; PG8_SCHED;
            PG8_LDB(B1, 1, 1); PG8_STAGE(PG8_SB(1, 0), b3, voffB);
            PG8_BAR; PG8_WAIT_L(0); PG8_MMA(0, 1, At, B1); PG8_BAR;
            PG8_LDA(At, 1, 1); PG8_STAGE(PG8_SA(1, 0), a3, voffA);
            PG8_BAR; PG8_WAIT_L(0); PG8_MMA(1, 0, At, B0); PG8_BAR; PG8_SCHED;
            PG8_STAGE(PG8_SB(1, 1), b3 + hstep, voffB);
            PG8_WAIT_V(6); PG8_BAR; PG8_MMA(1, 1, At, B1); PG8_BAR;
            }
        }
        if constexpr (ALIGN_EPI) { if (wr == 0) PG8_BAR; }
        if constexpr (!Epi::AFTER_DRAIN) { E(acc, cur, wr, wc, fr, fq); S.done(cur); }
        if (!has_next) break;
#pragma unroll
        for (int a = 0; a < 2; ++a)
#pragma unroll
            for (int b = 0; b < 2; ++b)
#pragma unroll
                for (int m = 0; m < 4; ++m)
#pragma unroll
                    for (int n = 0; n < 2; ++n) acc[a][b][m][n] = (f32x4){0.f, 0.f, 0.f, 0.f};
        cur = nxt; cA = nA; cB = nB; ++ui;
        if constexpr (ALIGN_EPI) { if (wr == 1) PG8_BAR; }
    }
    PG8_WAIT_V(0);
    if constexpr (!ALIGN_EPI) { if (wr == 0) PG8_BAR; }
    PG8_BAR;
    if constexpr (Epi::AFTER_DRAIN) { E.fused(acc, cur, wr, wc, fr, fq, lds, wid, lane); S.done(cur); }
#undef PG8_SA
#undef PG8_SB
#undef PG8_STAGE
#undef PG8_LDA
#undef PG8_LDB
#undef PG8_MMA
#undef PG8_WAIT_V
#undef PG8_WAIT_L
#undef PG8_BAR
#undef PG8_SCHED
}
}
#define XB_TMO      128
#define XB_XCNT(j)  (256  + 64 * (j))
#define XB_XSUB(j)  (1280 + 64 * (j))
#define XB_XGEN(j)  (2304 + 64 * (j))
#define XB_TOP      3328
#define XB_TOPGEN   3392
#define XCD_BAR_WORDS 3456
#define XB_SPIN_CAP (1u << 18)

__device__ __forceinline__ unsigned xb_ld(unsigned* p)              { return __hip_atomic_load(p, __ATOMIC_RELAXED, __HIP_MEMORY_SCOPE_AGENT); }
__device__ __forceinline__ unsigned xb_add(unsigned* p, unsigned v) { return __hip_atomic_fetch_add(p, v, __ATOMIC_RELAXED, __HIP_MEMORY_SCOPE_AGENT); }
__device__ __forceinline__ unsigned xb_xcc_id() { return (unsigned)__builtin_amdgcn_s_getreg((3 << 11) | 20) & 0xFu; }
#define XB_SPIN(cond, bar) do { unsigned _sp = 0; while (cond) { __builtin_amdgcn_s_sleep(1); \
    if ((++_sp & 255u) == 0u) { if (xb_ld(&(bar)[XB_TMO])) break; if (_sp > XB_SPIN_CAP) { atomicAdd(&(bar)[XB_TMO], 1u); break; } } } } while (0)

struct XcdBarrier {
    unsigned* bar; unsigned x;
    volatile LAS unsigned* st;
};

__device__ __forceinline__ XcdBarrier xcd_barrier_post(unsigned* bar, volatile LAS unsigned* st) {
    XcdBarrier b; b.bar = bar; b.x = xb_xcc_id(); b.st = st;
    if (threadIdx.x == 0) (void)xb_add(&bar[XB_XCNT(b.x)], 1u);
    return b;
}
__device__ __forceinline__ void xcd_barrier_complete(unsigned* bar, unsigned x, unsigned& nloc, unsigned& nx) {
    const unsigned G = gridDim.x * gridDim.y * gridDim.z;
    unsigned sum, cnt, mine, sp = 0u;
    for (;;) {
        sum = 0u; cnt = 0u; mine = 0u;
#pragma unroll
        for (unsigned j = 0; j < 16; ++j) { const unsigned c = xb_ld(&bar[XB_XCNT(j)]); sum += c; cnt += (c > 0u) ? 1u : 0u; mine = (j == x) ? c : mine; }
        if (sum == G) break;
        __builtin_amdgcn_s_sleep(1);
        if ((++sp & 255u) == 0u) { if (xb_ld(&bar[XB_TMO])) break; if (sp > XB_SPIN_CAP) { atomicAdd(&bar[XB_TMO], 1u); break; } }
    }
    nloc = mine > 0u ? mine : 1u; nx = cnt > 0u ? cnt : 1u;
}

__device__ __forceinline__ void xcd_barrier(const XcdBarrier& b) {
    asm volatile("s_waitcnt vmcnt(0)" ::: "memory");
    __syncthreads();
    if (threadIdx.x == 0) {
        unsigned* bar = b.bar;
        __builtin_amdgcn_s_waitcnt(0);
        unsigned nloc = b.st[0], nx = b.st[1];
        if (nloc == 0u) { xcd_barrier_complete(bar, b.x, nloc, nx); b.st[0] = nloc; b.st[1] = nx; }
        const unsigned old = xb_add(&bar[XB_XSUB(b.x)], 1u);
        const unsigned gen = old / nloc;
        if (old + 1u == (gen + 1u) * nloc) {
            __builtin_amdgcn_fence(__ATOMIC_RELEASE, "agent");
            asm volatile("s_waitcnt vmcnt(0)" ::: "memory");
            const unsigned og = xb_add(&bar[XB_TOP], 1u);
            const unsigned tg = og / nx;
            if (og + 1u == (tg + 1u) * nx) xb_add(&bar[XB_TOPGEN], 1u);
            else XB_SPIN(xb_ld(&bar[XB_TOPGEN]) == tg, bar);
            __builtin_amdgcn_fence(__ATOMIC_ACQUIRE, "agent");
            xb_add(&bar[XB_XGEN(b.x)], 1u);
            asm volatile("s_waitcnt vmcnt(0)" ::: "memory");
        } else {
            XB_SPIN(xb_ld(&bar[XB_XGEN(b.x)]) == gen, bar);
            __builtin_amdgcn_fence(__ATOMIC_ACQUIRE, "agent");
            asm volatile("s_waitcnt vmcnt(0)" ::: "memory");
        }
    }
    __syncthreads();
}
constexpr int NWAVES = 8;
constexpr int RING_BYTES = 131072, MISC_OFF = RING_BYTES + 320, LDS_BYTES = 147456;
#define LDS_WAIT() asm volatile("s_waitcnt lgkmcnt(0)" ::: "memory")
#define VM_WAIT() asm volatile("s_waitcnt vmcnt(0)" ::: "memory")

struct Args { const float* in[19]; float* out; unsigned char* ws; int ph_lo, ph_hi, li, pad; };
enum { I_X = 0, I_C, I_WADA, I_BADA, I_NMIX, I_NMLP, I_WIN, I_GWG, I_GBG, I_GNORM, I_LBL, I_HNORM, I_MCONV, I_MGB, I_MNORM, I_WOUT, I_WFF1, I_WFF2, I_FNORM };

__device__ __forceinline__ void phase_p0a(const Args& a, LAS unsigned char* lds, int tid) {
    LAS float* cond = (LAS float*)lds;
    const float* c = a.in[I_C];
    for (int i = tid; i < NB * D; i += NWAVES * 64) cond[i] = siluf_(c[i]);
    __syncthreads();
    float* modp = (float*)(a.ws + WS_U);
    const float* w_ada = a.in[I_WADA];
    const int G = gridDim.x;
    for (int t = blockIdx.x * (NWAVES * 64) + tid; t < L * 16 * 1536; t += G * NWAVES * 64) {
        const int n4 = t % 1536, kc = (t / 1536) % 16, l = t / (1536 * 16);
        const float* w = w_ada + ((size_t)l * D + kc * 64) * (6 * D) + n4 * 4;
        f32x4 acc[4];
#pragma unroll
        for (int b = 0; b < 4; ++b) acc[b] = (f32x4){0.f, 0.f, 0.f, 0.f};
#pragma unroll 16
        for (int k = 0; k < 64; ++k) { const f32x4 wv = *(const f32x4*)(w + (size_t)k * (6 * D));
#pragma unroll
            for (int b = 0; b < 4; ++b) acc[b] += cond[b * D + kc * 64 + k] * wv; }
#pragma unroll
        for (int b = 0; b < 4; ++b) *(f32x4*)(&modp[((size_t)kc * L * NB + l * NB + b) * 6 * D + n4 * 4]) = acc[b];
    }
    __syncthreads();
}
__device__ __forceinline__ void phase_p0b(const Args& a, int tid) {
    const float* modp = (const float*)(a.ws + WS_U); float* mod = (float*)(a.ws + WS_MOD); const float* b_ada = a.in[I_BADA];
    for (int i = blockIdx.x * (NWAVES * 64) + tid; i < L * NB * 1536; i += gridDim.x * NWAVES * 64) {
        const int n4 = i % 1536, lb_ = i / 1536, l = lb_ / NB;
        f32x4 s = *(const f32x4*)(b_ada + l * 6 * D + n4 * 4);
#pragma unroll
        for (int kc = 0; kc < 16; ++kc) s += *(const f32x4*)(&modp[((size_t)kc * L * NB + lb_) * 6 * D + n4 * 4]);
        *(f32x4*)(&mod[(size_t)lb_ * 6 * D + n4 * 4]) = s;
    }
    { float* wgf = (float*)(a.ws + WS_FOLD); const float* w_in = a.in[I_WIN]; const float* w_gate = a.in[I_GWG];
      for (int i = blockIdx.x * (NWAVES * 64) + tid; i < L * D * 192; i += gridDim.x * NWAVES * 64) { const int ch = i % 192, k = (i / 192) % D, l = i / (192 * D);
          const float* wr_ = w_in + ((size_t)l * D + k) * DIN + GLOW; const float* g = w_gate + (size_t)l * 16 * 192 + ch; float v = 0.f;
#pragma unroll
          for (int q = 0; q < 16; ++q) v += wr_[q] * g[q * 192];
          wgf[i] = v; } }
    if (blockIdx.x == 0 && tid < 384) {
        const float* logits = a.in[I_LBL]; float* lb = (float*)(a.ws + WS_LB);
        float v0 = logits[tid], v1 = logits[384 + tid], v2 = logits[768 + tid], v3 = logits[1152 + tid];
        const float mx = fmaxf(fmaxf(v0, v1), fmaxf(v2, v3));
        v0 = __expf(v0 - mx); v1 = __expf(v1 - mx); v2 = __expf(v2 - mx); v3 = __expf(v3 - mx);
        const float inv = 1.f / (v0 + v1 + v2 + v3);
        lb[tid] = 0.f; lb[384 + tid] = v1 * inv; lb[768 + tid] = (v1 + v2) * inv; lb[1152 + tid] = (v1 + v2 + v3) * inv;
    }
}

__device__ __forceinline__ void conv_item(const Args& a, int it, LAS float* scr, int lane) {
    asm volatile("" : "+v"(lane));
    const int l = it / 416, r = it % 416;
    int kind, nb, kpart = 0;
    if (r < 128) { kind = 0; nb = r; } else if (r < 160) { kind = 1; nb = r - 128; } else if (r < 288) { kind = 2; nb = r - 160; } else { kind = 3; nb = (r - 288) >> 2; kpart = (r - 288) & 3; }
    const float* W; int N, K; bf16* WT; unsigned char* wl = a.ws + WS_W + (size_t)l * W_LAYER;
    if (kind == 0) { W = a.in[I_WIN] + (size_t)l * D * DIN; N = DIN; K = D; WT = (bf16*)(wl + W_IN); }
    else if (kind == 1) { W = a.in[I_WOUT] + (size_t)l * D * D; N = D; K = D; WT = (bf16*)(wl + W_OUT); }
    else if (kind == 2) { W = a.in[I_WFF1] + (size_t)l * D * DFF; N = DFF; K = D; WT = (bf16*)(wl + W_1); }
    else { W = a.in[I_WFF2] + (size_t)l * DFF * D; N = D; K = DFF; WT = (bf16*)(wl + W_2); }
    const int n0 = nb * 32, nl = lane & 31, kh = lane >> 5;
    const float* sp_ = W + n0 + nl; int pitch = N; float mul = 1.f;
    if (kind == 0) { const int code = in_src(n0 + nl);
        if (code >= 0) sp_ = W + code; else if (code == -1) { sp_ = W; mul = 0.f; } else { sp_ = (const float*)(a.ws + WS_FOLD) + (size_t)l * D * 192 + (-(code + 2)); pitch = 192; } }
    sp_ += (size_t)(kpart * 1024 + kh) * pitch;
    const bool want_bias = (kind == 0 || kind == 2);
    const float* shiftp = (const float*)(a.ws + WS_MOD) + (size_t)l * NB * 6 * D + (kind == 0 ? 0 : 3) * D + kpart * 1024 + 8 * (lane & 7);
    float ab[4][4];
#pragma unroll
    for (int j = 0; j < 4; ++j)
#pragma unroll
        for (int b = 0; b < 4; ++b) ab[j][b] = 0.f;
    float cur[32], nxt[32];
#pragma unroll
    for (int i = 0; i < 32; ++i) cur[i] = sp_[(size_t)(2 * i) * pitch];
    for (int kt = 0; kt < 16; ++kt) {
        const int k0 = kpart * 1024 + kt * 64;
        if (kt + 1 < 16) {
#pragma unroll
            for (int i = 0; i < 32; ++i) nxt[i] = sp_[(size_t)(64 * (kt + 1) + 2 * i) * pitch]; }
#pragma unroll
        for (int i = 0; i < 32; ++i) scr[(2 * i + kh) * 33 + nl] = cur[i] * mul;
        LDS_WAIT(); asm volatile("" ::: "memory");
        const int c = lane & 7;
        f32x4 sh[4][2];
        if (want_bias) {
#pragma unroll
            for (int b = 0; b < 4; ++b) { sh[b][0] = *(const f32x4*)(shiftp + b * 6 * D + 64 * kt); sh[b][1] = *(const f32x4*)(shiftp + b * 6 * D + 64 * kt + 4); } }
#pragma unroll
        for (int j = 0; j < 4; ++j) { const int n = (lane >> 3) + 8 * j; const LAS float* s = scr + (8 * c) * 33 + n;
            float e[8];
#pragma unroll
            for (int q = 0; q < 8; ++q) e[q] = s[q * 33];
            v4u o; o.x = pk2(e[0], e[1]); o.y = pk2(e[2], e[3]); o.z = pk2(e[4], e[5]); o.w = pk2(e[6], e[7]);
            *(GAS v4u*)(WT + (size_t)(n0 + n) * K + k0 + 8 * c) = o;
            if (want_bias) {
#pragma unroll
                for (int b = 0; b < 4; ++b) ab[j][b] += (e[0] * sh[b][0][0] + e[1] * sh[b][0][1]) + (e[2] * sh[b][0][2] + e[3] * sh[b][0][3]) + (e[4] * sh[b][1][0] + e[5] * sh[b][1][1]) + (e[6] * sh[b][1][2] + e[7] * sh[b][1][3]); } }
        LDS_WAIT(); asm volatile("" ::: "memory");
#pragma unroll
        for (int i = 0; i < 32; ++i) cur[i] = nxt[i];
    }
    if (want_bias) {
        float* bias = (float*)(a.ws + WS_BIAS) + (kind == 0 ? 0 : (size_t)L * NB * 4096) + (size_t)l * NB * 4096 + n0;
#pragma unroll
        for (int j = 0; j < 4; ++j)
#pragma unroll
            for (int b = 0; b < 4; ++b) { float v = ab[j][b]; v += __shfl_xor(v, 1); v += __shfl_xor(v, 2); v += __shfl_xor(v, 4); if ((lane & 7) == 0) bias[b * 4096 + (lane >> 3) + 8 * j] = v; }
    }
}
__device__ __forceinline__ void phase_p1(const Args& a, LAS unsigned char* lds, int tid, int lane, int wave) {
    const int G = gridDim.x, gw = blockIdx.x * NWAVES + wave, NGW = G * NWAVES;
    const float* mod = (const float*)(a.ws + WS_MOD);
    { float* gm = (float*)(a.ws + WS_GMUL);
      for (int i = blockIdx.x * (NWAVES * 64) + tid; i < L * 2 * NB * D; i += G * NWAVES * 64) { const int k = i & 1023, b = (i >> 10) & 3, w = (i >> 12) & 1, l = i >> 13;
          const float gain = (w ? a.in[I_NMLP] : a.in[I_NMIX])[l * D + k]; gm[i] = gain * (1.f + mod[(size_t)(l * NB + b) * 6 * D + (w ? 4 : 1) * D + k]); } }
    { const float* x = a.in[I_X]; bf16* xn = (bf16*)(a.ws + WS_XN); float* ssq = (float*)(a.ws + WS_SSQ); const float* nm = a.in[I_NMIX];
      for (int row = gw; row < M; row += NGW) { const int b = row >> 12; const GAS f32x4* xr = (const GAS f32x4*)(x + (size_t)row * D) + lane; float s = 0.f;
          GAS unsigned long long* o8 = (GAS unsigned long long*)(xn + (size_t)row * D) + lane;
#pragma unroll
          for (int j = 0; j < 4; ++j) { const f32x4 v = xr[64 * j]; s += (v[0] * v[0] + v[1] * v[1]) + (v[2] * v[2] + v[3] * v[3]); const int k = 4 * lane + 256 * j;
              const f32x4 g = *(const f32x4*)(nm + k); const f32x4 sc = *(const f32x4*)(mod + (size_t)b * 6 * D + D + k); const f32x4 p = v * g * (sc + 1.f);
              o8[64 * j] = (unsigned long long)pk2(p[0], p[1]) | ((unsigned long long)pk2(p[2], p[3]) << 32); }
          s = wave_sum(s);
          if (lane < 16) ssq[(size_t)row * 16 + lane] = (lane == 0) ? s : 0.f; } }
    { LAS float* scr = (LAS float*)(lds + wave * 16384);
      for (int it = gw; it < L * 416; it += NGW) conv_item(a, it, scr, lane); }
}
__device__ __forceinline__ void phase_final(const Args& a, int lane, int wave) {
    const int gw = blockIdx.x * NWAVES + wave, NGW = gridDim.x * NWAVES; const float* fn = a.in[I_FNORM];
    for (int row = gw; row < M; row += NGW) { GAS f32x4* xr = (GAS f32x4*)(a.out + (size_t)row * D) + lane; f32x4 v[4]; float s = 0.f;
#pragma unroll
        for (int j = 0; j < 4; ++j) { v[j] = xr[64 * j]; s += (v[j][0] * v[j][0] + v[j][1] * v[j][1]) + (v[j][2] * v[j][2] + v[j][3] * v[j][3]); }
        const float rs = rsqrtf(wave_sum(s) * (1.f / D) + EPS);
#pragma unroll
        for (int j = 0; j < 4; ++j) { const f32x4 g = *(const f32x4*)(fn + 4 * lane + 256 * j); xr[64 * j] = v[j] * rs * g; } }
}
typedef short v4i16_t __attribute__((ext_vector_type(4)));
typedef short s16x4 __attribute__((ext_vector_type(4)));
#define MFMA32(a, b, c) __builtin_amdgcn_mfma_f32_32x32x16_bf16((a), (b), (c), 0, 0, 0)
__device__ __forceinline__ s16x4 tr16(LAS const unsigned char* p) { return __builtin_bit_cast(s16x4, __builtin_amdgcn_ds_read_tr16_b64_v4i16((LAS v4i16_t*)p)); }
__device__ __forceinline__ bf16x8 cat8(s16x4 a, s16x4 b) { return __builtin_shufflevector(a, b, 0, 1, 2, 3, 4, 5, 6, 7); }
__device__ __forceinline__ unsigned cvtpk(float lo, float hi) { typedef __bf16 bf16x2_t __attribute__((ext_vector_type(2))); typedef float f32x2_t __attribute__((ext_vector_type(2))); f32x2_t v = {lo, hi}; return __builtin_bit_cast(unsigned, __builtin_convertvector(v, bf16x2_t)); }
__device__ __forceinline__ bf16x8 pack8(const f32x16& x, int s) { v4u p; p.x = cvtpk(x[8 * s], x[8 * s + 1]); p.y = cvtpk(x[8 * s + 2], x[8 * s + 3]); p.z = cvtpk(x[8 * s + 4], x[8 * s + 5]); p.w = cvtpk(x[8 * s + 6], x[8 * s + 7]); return __builtin_bit_cast(bf16x8, p); }
__device__ __forceinline__ float fexp_(float x) { return __builtin_amdgcn_exp2f(x * 1.4426950408889634f); }
__device__ __forceinline__ float fsig_(float x) { return __builtin_amdgcn_rcpf(1.f + fexp_(-x)); }
constexpr size_t U_BN = 208 * 1024, SP_BN = 104 * 1024;
__device__ __forceinline__ int u_off(int head) { return head < 6 ? head * 8192 : head < 12 ? 49152 + (head - 6) * 16384 : 147456 + (head - 12) * 16384; }
template <int NB16> __device__ __forceinline__ void stage_img(LAS unsigned char* img, const bf16* src, int lane) {
    constexpr int RPI = 64 / NB16;
#pragma unroll
    for (int i = 0; i < 64 / RPI; ++i) { const int row = i * RPI + lane / NB16, ch = lane % NB16; const v4u v = *(const v4u*)(src + (size_t)row * 4096 + ch * 8); *(LAS v4u*)(img + row * (NB16 * 16) + ch * 16) = v; }
}
template <int KCH> __device__ __forceinline__ void ktv(f32x16 (&U)[KCH / 32][2], LAS const unsigned char* kimg, LAS const unsigned char* vimg, int lane) {
    const int h = lane >> 5, g16 = (lane >> 4) & 1, q = (lane & 15) >> 2, p = lane & 3;
#pragma unroll
    for (int cb = 0; cb < KCH / 32; ++cb)
#pragma unroll
        for (int vb = 0; vb < 2; ++vb)
#pragma unroll
            for (int r = 0; r < 16; ++r) U[cb][vb][r] = 0.f;
#pragma unroll
    for (int s = 0; s < 4; ++s) { const int t0 = 16 * s + 8 * h + q; bf16x8 A[KCH / 32], B[2];
#pragma unroll
        for (int cb = 0; cb < KCH / 32; ++cb) A[cb] = cat8(tr16(kimg + t0 * (KCH * 2) + (32 * cb + 16 * g16 + 4 * p) * 2), tr16(kimg + (t0 + 4) * (KCH * 2) + (32 * cb + 16 * g16 + 4 * p) * 2));
#pragma unroll
        for (int vb = 0; vb < 2; ++vb) B[vb] = cat8(tr16(vimg + t0 * 128 + (32 * vb + 16 * g16 + 4 * p) * 2), tr16(vimg + (t0 + 4) * 128 + (32 * vb + 16 * g16 + 4 * p) * 2));
#pragma unroll
        for (int cb = 0; cb < KCH / 32; ++cb)
#pragma unroll
            for (int vb = 0; vb < 2; ++vb) U[cb][vb] = MFMA32(A[cb], B[vb], U[cb][vb]); }
}
template <int KCH> __device__ __forceinline__ void store_ut(const f32x16 (&U)[KCH / 32][2], float* UT, const float* el, int lane) {
    const int h = lane >> 5, r32 = lane & 31;
#pragma unroll
    for (int cb = 0; cb < KCH / 32; ++cb)
#pragma unroll
        for (int vb = 0; vb < 2; ++vb)
#pragma unroll
            for (int g = 0; g < 4; ++g) { const int c0 = 32 * cb + 8 * g + 4 * h; f32x4 o = {U[cb][vb][4 * g], U[cb][vb][4 * g + 1], U[cb][vb][4 * g + 2], U[cb][vb][4 * g + 3]};
                if (el) o = o * *(const f32x4*)(el + c0);
                *(f32x4*)(UT + (size_t)(32 * vb + r32) * KCH + c0) = o; }
}
template <int KCH> __device__ __forceinline__ void mix_c1_gh(const Args& a, LAS unsigned char* wl, int lane, int b, int n, int head) {
    asm volatile("" : "+v"(lane));
    const size_t row0 = (size_t)b * S + n * 64; const bf16* Zt = (const bf16*)(a.ws + WS_Z) + row0 * 4096 + head * 256;
    LAS unsigned char* kimg = wl; LAS unsigned char* vimg = wl + 8192;
    stage_img<KCH / 8>(kimg, Zt + KCH, lane); stage_img<8>(vimg, Zt + 128, lane);
    LDS_WAIT(); asm volatile("" ::: "memory");
    f32x16 U[KCH / 32][2]; ktv<KCH>(U, kimg, vimg, lane);
    const float* vp = (const float*)(a.ws + WS_VEC) + ((size_t)(b * 64 + n) * 16 + head) * 192;
    store_ut<KCH>(U, (float*)(a.ws + WS_U + (size_t)(b * 64 + n) * U_BN + u_off(head)), vp + 64, lane);
    LDS_WAIT(); asm volatile("" ::: "memory");
}
template <int KCH> __device__ __forceinline__ void mix_c3_gh(const Args& a, LAS unsigned char* wl, int lane, int b, int n, int head, int l) {
    asm volatile("" : "+v"(lane));
    const size_t row0 = (size_t)b * S + n * 64; const bf16* Zt = (const bf16*)(a.ws + WS_Z) + row0 * 4096 + head * 256;
    LAS unsigned char* vimg = wl; stage_img<8>(vimg, Zt + 128, lane);
    const int h = lane >> 5, r32 = lane & 31, g16 = (lane >> 4) & 1, q = (lane & 15) >> 2, p = lane & 3;
    constexpr int NS = KCH / 16;
    bf16x8 Qf[2][NS], Kf[2][NS];
#pragma unroll
    for (int ib = 0; ib < 2; ++ib)
#pragma unroll
        for (int s = 0; s < NS; ++s) { Qf[ib][s] = *(const bf16x8*)(Zt + (size_t)(32 * ib + r32) * 4096 + 16 * s + 8 * h); Kf[ib][s] = *(const bf16x8*)(Zt + (size_t)(32 * ib + r32) * 4096 + KCH + 16 * s + 8 * h); }
    f32x16 X00, X01, X11;
#pragma unroll
    for (int r = 0; r < 16; ++r) { X00[r] = 0.f; X01[r] = 0.f; X11[r] = 0.f; }
#pragma unroll
    for (int s = 0; s < NS; ++s) { X00 = MFMA32(Kf[0][s], Qf[0][s], X00); X01 = MFMA32(Kf[0][s], Qf[1][s], X01); X11 = MFMA32(Kf[1][s], Qf[1][s], X11); }
#pragma unroll
    for (int r = 0; r < 16; ++r) { const int jl = (r & 3) + 8 * (r >> 2) + 4 * h; if (jl > r32) { X00[r] = 0.f; X11[r] = 0.f; } }
    bf16x8 P00[2], P01[2], P11[2];
#pragma unroll
    for (int s2 = 0; s2 < 2; ++s2) { P00[s2] = pack8(X00, s2); P01[s2] = pack8(X01, s2); P11[s2] = pack8(X11, s2); }
    f32x16 O[2][2];
#pragma unroll
    for (int vb = 0; vb < 2; ++vb)
#pragma unroll
        for (int ib = 0; ib < 2; ++ib)
#pragma unroll
            for (int r = 0; r < 16; ++r) O[vb][ib][r] = 0.f;
    LDS_WAIT(); asm volatile("" ::: "memory");
#pragma unroll
    for (int vb = 0; vb < 2; ++vb)
#pragma unroll
        for (int jb = 0; jb < 2; ++jb)
#pragma unroll
            for (int s2 = 0; s2 < 2; ++s2) { const int t0 = 32 * jb + 16 * s2 + 4 * h + q; LAS const unsigned char* cp = vimg + (32 * vb + 16 * g16 + 4 * p) * 2;
                const bf16x8 A = cat8(tr16(cp + t0 * 128), tr16(cp + (t0 + 8) * 128));
                if (jb == 0) { O[vb][0] = MFMA32(A, P00[s2], O[vb][0]); O[vb][1] = MFMA32(A, P01[s2], O[vb][1]); } else O[vb][1] = MFMA32(A, P11[s2], O[vb][1]); }
    const bf16* SpT = (const bf16*)(a.ws + WS_XN + (size_t)(b * 64 + n) * SP_BN + u_off(head) / 2);
#pragma unroll
    for (int vb = 0; vb < 2; ++vb)
#pragma unroll
        for (int s = 0; s < NS; ++s) { const bf16x8 A = *(const bf16x8*)(SpT + (size_t)(32 * vb + r32) * KCH + 16 * s + 8 * h); O[vb][0] = MFMA32(A, Qf[0][s], O[vb][0]); O[vb][1] = MFMA32(A, Qf[1][s], O[vb][1]); }
    const float* gain = (head < 6 ? a.in[I_GNORM] : a.in[I_HNORM]) + l * 64; bf16* mixed = (bf16*)(a.ws + WS_MIX);
#pragma unroll
    for (int ib = 0; ib < 2; ++ib) { float ms = 0.f;
#pragma unroll
        for (int vb = 0; vb < 2; ++vb)
#pragma unroll
            for (int r = 0; r < 16; ++r) ms += O[vb][ib][r] * O[vb][ib][r];
        ms += __shfl_xor(ms, 32); const float rn = rsqrtf(ms * (1.f / 64.f) + EPS); const size_t row = row0 + 32 * ib + r32;
#pragma unroll
        for (int vb = 0; vb < 2; ++vb)
#pragma unroll
            for (int g = 0; g < 4; ++g) { const int vc0 = 32 * vb + 8 * g + 4 * h; const f32x4 gn = *(const f32x4*)(gain + vc0); const v2u gw = *(const v2u*)(Zt + (size_t)(32 * ib + r32) * 4096 + 192 + vc0);
                const float o0 = O[vb][ib][4 * g] * rn * gn[0] * bf2f((unsigned short)(gw.x & 0xffffu)), o1 = O[vb][ib][4 * g + 1] * rn * gn[1] * bf2f((unsigned short)(gw.x >> 16));
                const float o2 = O[vb][ib][4 * g + 2] * rn * gn[2] * bf2f((unsigned short)(gw.y & 0xffffu)), o3 = O[vb][ib][4 * g + 3] * rn * gn[3] * bf2f((unsigned short)(gw.y >> 16));
                v2u w; w.x = cvtpk(o0, o1); w.y = cvtpk(o2, o3); *(v2u*)(mixed + row * D + head * 64 + vc0) = w; } }
    LDS_WAIT(); asm volatile("" ::: "memory");
}
__device__ __forceinline__ float wave_scan_add(float x, int lane) {
#pragma unroll
    for (int d = 1; d < 64; d <<= 1) { const float t = __shfl_up(x, d); if (lane >= d) x += t; }
    return x;
}
__device__ __forceinline__ float wave_scan_max(float x, int lane) {
#pragma unroll
    for (int d = 1; d < 64; d <<= 1) { const float t = __shfl_up(x, d); if (lane >= d) x = fmaxf(x, t); }
    return x;
}
__device__ __forceinline__ float wave_max(float v) {
#pragma unroll
    for (int o = 1; o < 64; o <<= 1) v = fmaxf(v, __shfl_xor(v, o));
    return v;
}
struct ConvW { f32x4 w[4][2]; };
__device__ __forceinline__ void load_convw(ConvW& cw, const float* p) {
#pragma unroll
    for (int tap = 0; tap < 4; ++tap) { cw.w[tap][0] = *(const f32x4*)(p + tap * 512); cw.w[tap][1] = *(const f32x4*)(p + tap * 512 + 4); }
}
__device__ __forceinline__ void conv8(float (&y)[8], const bf16* zsrc, int t, int tglob, int d0, const ConvW& cw) {
#pragma unroll
    for (int j = 0; j < 8; ++j) y[j] = 0.f;
#pragma unroll
    for (int tap = 0; tap < 4; ++tap) { const f32x4 w0 = cw.w[tap][0], w1 = cw.w[tap][1];
        const bool ok = tglob - 3 + tap >= 0; const int rr = ok ? t - 3 + tap : 0;
        v4u rv = *(const v4u*)(zsrc + (long)rr * 4096 + d0); rv.x = ok ? rv.x : 0u; rv.y = ok ? rv.y : 0u; rv.z = ok ? rv.z : 0u; rv.w = ok ? rv.w : 0u;
        y[0] += w0[0] * bf2f((unsigned short)(rv.x & 0xffffu)); y[1] += w0[1] * bf2f((unsigned short)(rv.x >> 16)); y[2] += w0[2] * bf2f((unsigned short)(rv.y & 0xffffu)); y[3] += w0[3] * bf2f((unsigned short)(rv.y >> 16));
        y[4] += w1[0] * bf2f((unsigned short)(rv.z & 0xffffu)); y[5] += w1[1] * bf2f((unsigned short)(rv.z >> 16)); y[6] += w1[2] * bf2f((unsigned short)(rv.w & 0xffffu)); y[7] += w1[3] * bf2f((unsigned short)(rv.w >> 16)); }
#pragma unroll
    for (int j = 0; j < 8; ++j) y[j] = y[j] * fsig_(y[j]);
}
__device__ __forceinline__ bf16x8 pk8f(const float (&y)[8], float sc) { v4u p; p.x = cvtpk(y[0] * sc, y[1] * sc); p.y = cvtpk(y[2] * sc, y[3] * sc); p.z = cvtpk(y[4] * sc, y[5] * sc); p.w = cvtpk(y[6] * sc, y[7] * sc); return __builtin_bit_cast(bf16x8, p); }
__device__ __forceinline__ void mix_c1_m(const Args& a, LAS unsigned char* wl, int lane, int b, int n, int mh, int l) {
    asm volatile("" : "+v"(lane));
    const size_t row0 = (size_t)b * S + n * 64; const bf16* Zt = (const bf16*)(a.ws + WS_Z) + row0 * 4096 + (12 + mh) * 256;
    LAS unsigned char* kimg = wl; LAS unsigned char* vimg = wl + 8192;
    stage_img<8>(vimg, Zt + 128, lane);
    const float* mgp = (const float*)(a.ws + WS_MG) + (row0 + lane) * 8; const float* gb = a.in[I_MGB] + l * 8;
    const float li = mgp[mh] + gb[mh]; const float xf = mgp[4 + mh] + gb[4 + mh]; const float lf = fminf(xf, 0.f) - __logf(1.f + fexp_(-fabsf(xf)));
    const float bc = wave_scan_add(lf, lane), av = li - bc, amax = wave_max(av), blast = __shfl(bc, 63);
    const float pst = fexp_(av - amax) * 0.125f;
    const int h = lane >> 5, r32 = lane & 31; const float* cwk = a.in[I_MCONV] + (size_t)l * 2048 + 256 + mh * 64;
    { const float sc0 = __shfl(pst, r32), sc1 = __shfl(pst, r32 + 32);
#pragma unroll
      for (int s = 0; s < 4; ++s) { const int d0 = 16 * s + 8 * h; ConvW cw; load_convw(cw, cwk + d0); float y[8];
          conv8(y, Zt + 64, r32, n * 64 + r32, d0, cw); *(LAS bf16x8*)(kimg + r32 * 128 + d0 * 2) = pk8f(y, sc0);
          conv8(y, Zt + 64, r32 + 32, n * 64 + r32 + 32, d0, cw); *(LAS bf16x8*)(kimg + (r32 + 32) * 128 + d0 * 2) = pk8f(y, sc1);
          asm volatile("" ::: "memory"); } }
    LDS_WAIT(); asm volatile("" ::: "memory");
    f32x16 U[2][2]; ktv<64>(U, kimg, vimg, lane);
    store_ut<64>(U, (float*)(a.ws + WS_U + (size_t)(b * 64 + n) * U_BN + u_off(12 + mh)), nullptr, lane);
    float* vp = (float*)(a.ws + WS_VEC) + ((size_t)(b * 64 + n) * 16 + 12 + mh) * 192;
    float nu = 0.f;
#pragma unroll 8
    for (int t = 0; t < 64; ++t) nu += bf2f(*(LAS const unsigned short*)(kimg + t * 128 + lane * 2));
    vp[64 + lane] = nu; if (lane == 0) { vp[0] = amax; vp[1] = blast; }
    LDS_WAIT(); asm volatile("" ::: "memory");
}
__device__ __forceinline__ void mix_c3_m(const Args& a, LAS unsigned char* wl, int lane, int b, int n, int mh, int l) {
    asm volatile("" : "+v"(lane));
    const size_t row0 = (size_t)b * S + n * 64; const bf16* Zt = (const bf16*)(a.ws + WS_Z) + row0 * 4096 + (12 + mh) * 256;
    LAS unsigned char* vimg = wl; stage_img<8>(vimg, Zt + 128, lane);
    const float* vp = (const float*)(a.ws + WS_VEC) + ((size_t)(b * 64 + n) * 16 + 12 + mh) * 192;
    const float* mgp = (const float*)(a.ws + WS_MG) + (row0 + lane) * 8; const float* gb = a.in[I_MGB] + l * 8;
    const float li = mgp[mh] + gb[mh]; const float xf = mgp[4 + mh] + gb[4 + mh]; const float lf = fminf(xf, 0.f) - __logf(1.f + fexp_(-fabsf(xf)));
    const float bc = wave_scan_add(lf, lane), av = li - bc, amax = wave_max(av), mprev = vp[2];
    const float Mi = fmaxf(mprev, wave_scan_max(av, lane)); const float pst = fexp_(av - amax) * 0.125f;
    const int h = lane >> 5, r32 = lane & 31, g16 = (lane >> 4) & 1, q = (lane & 15) >> 2, p = lane & 3;
    const float* cwq = a.in[I_MCONV] + (size_t)l * 2048 + mh * 64; const float* cwk = cwq + 256;
    bf16x8 Qf[2][4], Kf[2][4];
    { const float sc0 = __shfl(pst, r32), sc1 = __shfl(pst, r32 + 32);
#pragma unroll
      for (int s = 0; s < 4; ++s) { const int d0 = 16 * s + 8 * h; ConvW cw; float y[8];
          load_convw(cw, cwq + d0);
          conv8(y, Zt, r32, n * 64 + r32, d0, cw); Qf[0][s] = pk8f(y, 1.f); conv8(y, Zt, r32 + 32, n * 64 + r32 + 32, d0, cw); Qf[1][s] = pk8f(y, 1.f);
          asm volatile("" ::: "memory");
          load_convw(cw, cwk + d0);
          conv8(y, Zt + 64, r32, n * 64 + r32, d0, cw); Kf[0][s] = pk8f(y, sc0); conv8(y, Zt + 64, r32 + 32, n * 64 + r32 + 32, d0, cw); Kf[1][s] = pk8f(y, sc1);
          asm volatile("" ::: "memory"); } }
    f32x16 X00, X01, X11;
#pragma unroll
    for (int r = 0; r < 16; ++r) { X00[r] = 0.f; X01[r] = 0.f; X11[r] = 0.f; }
#pragma unroll
    for (int s = 0; s < 4; ++s) { X00 = MFMA32(Kf[0][s], Qf[0][s], X00); X01 = MFMA32(Kf[0][s], Qf[1][s], X01); X11 = MFMA32(Kf[1][s], Qf[1][s], X11); }
    float Mc[2], bi[2], si[2], den[2];
#pragma unroll
    for (int ib = 0; ib < 2; ++ib) { Mc[ib] = __shfl(Mi, r32 + 32 * ib); bi[ib] = __shfl(bc, r32 + 32 * ib); si[ib] = fexp_(mprev - Mc[ib]); }
    { const float f0 = fexp_(amax - Mc[0]), f1 = fexp_(amax - Mc[1]); float d0 = 0.f, d1 = 0.f;
#pragma unroll
      for (int r = 0; r < 16; ++r) { const int jl = (r & 3) + 8 * (r >> 2) + 4 * h; const bool keep = jl <= r32;
          X00[r] = keep ? X00[r] * f0 : 0.f; X01[r] = X01[r] * f1; X11[r] = keep ? X11[r] * f1 : 0.f; d0 += X00[r]; d1 += X01[r] + X11[r]; }
      den[0] = d0 + __shfl_xor(d0, 32); den[1] = d1 + __shfl_xor(d1, 32); }
    bf16x8 P00[2], P01[2], P11[2];
#pragma unroll
    for (int s2 = 0; s2 < 2; ++s2) { P00[s2] = pack8(X00, s2); P01[s2] = pack8(X01, s2); P11[s2] = pack8(X11, s2); }
    f32x16 O[2][2];
#pragma unroll
    for (int vb = 0; vb < 2; ++vb)
#pragma unroll
        for (int ib = 0; ib < 2; ++ib)
#pragma unroll
            for (int r = 0; r < 16; ++r) O[vb][ib][r] = 0.f;
    const bf16* CpT = (const bf16*)(a.ws + WS_XN + (size_t)(b * 64 + n) * SP_BN + u_off(12 + mh) / 2);
#pragma unroll
    for (int vb = 0; vb < 2; ++vb)
#pragma unroll
        for (int s = 0; s < 4; ++s) { const bf16x8 A = *(const bf16x8*)(CpT + (size_t)(32 * vb + r32) * 64 + 16 * s + 8 * h); O[vb][0] = MFMA32(A, Qf[0][s], O[vb][0]); O[vb][1] = MFMA32(A, Qf[1][s], O[vb][1]); }
    { float qn0 = 0.f, qn1 = 0.f;
#pragma unroll
      for (int s = 0; s < 4; ++s) { const f32x4 n0 = *(const f32x4*)(vp + 128 + 16 * s + 8 * h), n1 = *(const f32x4*)(vp + 128 + 16 * s + 8 * h + 4);
#pragma unroll
          for (int j = 0; j < 4; ++j) { qn0 += bf2f((unsigned short)Qf[0][s][j]) * n0[j] + bf2f((unsigned short)Qf[0][s][4 + j]) * n1[j]; qn1 += bf2f((unsigned short)Qf[1][s][j]) * n0[j] + bf2f((unsigned short)Qf[1][s][4 + j]) * n1[j]; } }
      qn0 += __shfl_xor(qn0, 32); qn1 += __shfl_xor(qn1, 32); den[0] += si[0] * qn0; den[1] += si[1] * qn1; }
#pragma unroll
    for (int vb = 0; vb < 2; ++vb)
#pragma unroll
        for (int ib = 0; ib < 2; ++ib)
#pragma unroll
            for (int r = 0; r < 16; ++r) O[vb][ib][r] *= si[ib];
    LDS_WAIT(); asm volatile("" ::: "memory");
#pragma unroll
    for (int vb = 0; vb < 2; ++vb)
#pragma unroll
        for (int jb = 0; jb < 2; ++jb)
#pragma unroll
            for (int s2 = 0; s2 < 2; ++s2) { const int t0 = 32 * jb + 16 * s2 + 4 * h + q; LAS const unsigned char* cp = vimg + (32 * vb + 16 * g16 + 4 * p) * 2;
                const bf16x8 A = cat8(tr16(cp + t0 * 128), tr16(cp + (t0 + 8) * 128));
                if (jb == 0) { O[vb][0] = MFMA32(A, P00[s2], O[vb][0]); O[vb][1] = MFMA32(A, P01[s2], O[vb][1]); } else O[vb][1] = MFMA32(A, P11[s2], O[vb][1]); }
    const float* gain = a.in[I_MNORM] + l * 256 + mh * 64; bf16* mixed = (bf16*)(a.ws + WS_MIX);
#pragma unroll
    for (int ib = 0; ib < 2; ++ib) { const float inv = 1.f / fmaxf(fabsf(den[ib]), fexp_(-(bi[ib] + Mc[ib]))); float sm = 0.f;
#pragma unroll
        for (int vb = 0; vb < 2; ++vb)
#pragma unroll
            for (int r = 0; r < 16; ++r) { O[vb][ib][r] *= inv; sm += O[vb][ib][r]; }
        sm += __shfl_xor(sm, 32); const float mu = sm * (1.f / 64.f); float sv = 0.f;
#pragma unroll
        for (int vb = 0; vb < 2; ++vb)
#pragma unroll
            for (int r = 0; r < 16; ++r) { const float dlt = O[vb][ib][r] - mu; sv += dlt * dlt; }
        sv += __shfl_xor(sv, 32); const float rn = rsqrtf(sv * (1.f / 64.f) + EPS); const size_t row = row0 + 32 * ib + r32;
#pragma unroll
        for (int vb = 0; vb < 2; ++vb)
#pragma unroll
            for (int g = 0; g < 4; ++g) { const int vc0 = 32 * vb + 8 * g + 4 * h; const f32x4 gn = *(const f32x4*)(gain + vc0); const v2u gw = *(const v2u*)(Zt + (size_t)(32 * ib + r32) * 4096 + 192 + vc0);
                const float o0 = (O[vb][ib][4 * g] - mu) * rn * gn[0] * bf2f((unsigned short)(gw.x & 0xffffu)), o1 = (O[vb][ib][4 * g + 1] - mu) * rn * gn[1] * bf2f((unsigned short)(gw.x >> 16));
                const float o2 = (O[vb][ib][4 * g + 2] - mu) * rn * gn[2] * bf2f((unsigned short)(gw.y & 0xffffu)), o3 = (O[vb][ib][4 * g + 3] - mu) * rn * gn[3] * bf2f((unsigned short)(gw.y >> 16));
                v2u w; w.x = cvtpk(o0, o1); w.y = cvtpk(o2, o3); *(v2u*)(mixed + row * D + (12 + mh) * 64 + vc0) = w; } }
    LDS_WAIT(); asm volatile("" ::: "memory");
}
__device__ __forceinline__ void phase_c1(const Args& a, LAS unsigned char* lds, int lane, int wave, int l) {
    LAS unsigned char* wl = lds + wave * 16384; const int gw = blockIdx.x * NWAVES + wave, NGW = gridDim.x * NWAVES;
    for (int id = gw, k = 0; id < NB * 64 * 16; id += NGW, ++k) { const int bn = id >> 4, head = (id + 8 * k) & 15, b = bn >> 6, n = bn & 63;
        if (head < 6) mix_c1_gh<32>(a, wl, lane, b, n, head); else if (head < 12) mix_c1_gh<64>(a, wl, lane, b, n, head); else mix_c1_m(a, wl, lane, b, n, head - 12, l); }
}
__device__ __forceinline__ void phase_c3(const Args& a, LAS unsigned char* lds, int lane, int wave, int l) {
    LAS unsigned char* wl = lds + wave * 16384; const int gw = blockIdx.x * NWAVES + wave, NGW = gridDim.x * NWAVES;
    for (int id = gw, k = 0; id < NB * 64 * 16; id += NGW, ++k) { const int bn = id >> 4, head = (id + 8 * k) & 15, b = bn >> 6, n = bn & 63;
        if (head < 6) mix_c3_gh<32>(a, wl, lane, b, n, head, l); else if (head < 12) mix_c3_gh<64>(a, wl, lane, b, n, head, l); else mix_c3_m(a, wl, lane, b, n, head - 12, l); }
}
__device__ __forceinline__ void phase_c2(const Args& a, int tid) {
    constexpr int TPB = 6 * 512 + 6 * 1024 + 4 * 1040;
    const unsigned char* ws = a.ws; float* vecb = (float*)(a.ws + WS_VEC);
    for (int task = blockIdx.x * (NWAVES * 64) + tid; task < NB * TPB; task += gridDim.x * NWAVES * 64) {
        const int b = task / TPB; int r = task % TPB; int head, qi;
        if (r < 3072) { head = r >> 9; qi = r & 511; } else if (r < 9216) { head = 6 + ((r - 3072) >> 10); qi = (r - 3072) & 1023; } else { head = 12 + (r - 9216) / 1040; qi = (r - 9216) % 1040; }
        const int uo = u_off(head);
        if (head < 12) { const int KCH = head < 6 ? 32 : 64; const int c0 = (qi * 4) % KCH; f32x4 st = (f32x4){0.f, 0.f, 0.f, 0.f};
#pragma unroll 4
            for (int n = 0; n < 64; ++n) { const size_t bn = (size_t)(b * 64 + n); const float* vp = vecb + (bn * 16 + head) * 192;
                const f32x4 er = *(const f32x4*)(vp + c0), ed = *(const f32x4*)(vp + 128 + c0); const f32x4 u = *(const f32x4*)(ws + WS_U + bn * U_BN + uo + (size_t)qi * 16);
                const f32x4 sp = st * er; v2u w; w.x = cvtpk(sp[0], sp[1]); w.y = cvtpk(sp[2], sp[3]); *(v2u*)(a.ws + WS_XN + bn * SP_BN + uo / 2 + (size_t)qi * 8) = w;
                st = ed * st + u; }
        } else { f32x4 st = (f32x4){0.f, 0.f, 0.f, 0.f}; float m = 0.f; const bool isvec = qi >= 1024; const int dq = qi - 1024;
#pragma unroll 4
            for (int n = 0; n < 64; ++n) { const size_t bn = (size_t)(b * 64 + n); float* vp = vecb + (bn * 16 + head) * 192;
                const float amax = vp[0], blast = vp[1]; const float mnew = fmaxf(blast + m, blast + amax), so = fexp_(blast + m - mnew), sl = fexp_(blast + amax - mnew);
                if (!isvec) { const f32x4 u = *(const f32x4*)(ws + WS_U + bn * U_BN + uo + (size_t)qi * 16);
                    v2u w; w.x = cvtpk(st[0], st[1]); w.y = cvtpk(st[2], st[3]); *(v2u*)(a.ws + WS_XN + bn * SP_BN + uo / 2 + (size_t)qi * 8) = w; st = st * so + u * sl; }
                else { const f32x4 nu = *(const f32x4*)(vp + 64 + 4 * dq); *(f32x4*)(vp + 128 + 4 * dq) = st; if (dq == 0) vp[2] = m; st = st * so + nu * sl; }
                m = mnew; }
        }
    }
}
constexpr int NPL = 7;
constexpr int NPRE = 3;
constexpr int NPH = NPRE + NPL * L + 1;
#ifndef MK_REP_MASK
#define MK_REP_MASK 0
#endif
#ifndef MK_REP_N
#define MK_REP_N 1
#endif
#ifndef MK_ONE_LAUNCH
#define MK_ONE_LAUNCH 1
#endif
__global__ void __launch_bounds__(NWAVES * 64, 2) mk_fwd(Args args) {
    extern __shared__ __attribute__((aligned(16))) unsigned char lds_raw[];
    LAS unsigned char* lds = (LAS unsigned char*)lds_raw;
    volatile LAS unsigned* MISC = (volatile LAS unsigned*)(lds + MISC_OFF);
    const int tid0 = threadIdx.x;
    for (int u = tid0; u < (LDS_BYTES - RING_BYTES) / 4; u += NWAVES * 64) ((LAS unsigned*)(lds + RING_BYTES))[u] = 0u;
    __syncthreads();
    unsigned* ctl = (unsigned*)(args.ws + WS_CTL);
    XcdBarrier bar; bar.bar = ctl + 4096; bar.x = 0; bar.st = nullptr;
    if (args.ph_hi - args.ph_lo > 1) bar = xcd_barrier_post(ctl + 4096, MISC + 8);
    unsigned char* ws = args.ws;
    for (int p = args.ph_lo; p < args.ph_hi; ++p) {
        const int kind = p < NPRE ? p : (p == NPH - 1 ? 10 : 3 + (p - NPRE) % NPL);
        const int reps = ((MK_REP_MASK >> kind) & 1) ? 1 + MK_REP_N : 1;
      for (int rr = 0; rr < reps; ++rr) {
        const bool dry = rr > 0;
        int tid = tid0; asm volatile("" : "+v"(tid));
        const int lane = tid & 63, wave = __builtin_amdgcn_readfirstlane(tid >> 6);
        if (p == 0) phase_p0a(args, lds, tid);
        else if (p == 1) phase_p0b(args, tid);
        else if (p == 2) phase_p1(args, lds, tid, lane, wave);
        else if (p == NPH - 1) { if (!dry) phase_final(args, lane, wave); }
        else {
            const int l = (p - NPRE) / NPL, j = (p - NPRE) % NPL;
            unsigned char* wl = ws + WS_W + (size_t)l * W_LAYER;
            const float* mod_l = (const float*)(ws + WS_MOD) + (size_t)l * NB * 6 * D;
            float* ssq = (float*)(ws + WS_SSQ);
            float* xdst = dry ? (float*)(ws + WS_U) : args.out; bf16* xndst = dry ? (bf16*)(ws + WS_MIX) : (bf16*)(ws + WS_XN); float* ssqdst = dry ? (float*)(ws + WS_U + 64 * MiB) : ssq;
            if (j == 0) {
                pg8::Gemm g{(const bf16*)(ws + WS_XN), (const bf16*)(wl + W_IN), M, NIN, D}; pg8::StaticOrder S; S.init(M, NIN, gridDim.x, (int)blockIdx.x);
                pg8::EpiIn E{(bf16*)(ws + WS_Z), (float*)(ws + WS_VEC), (float*)(ws + WS_MG), (const float*)(ws + WS_BIAS) + (size_t)l * NB * 4096, ssq, (const float*)(ws + WS_LB) + l * 384, args.in[I_GBG] + l * 192};
                pg8::gemm_phase<pg8::EpiIn, pg8::StaticOrder, true, true>(lds, g, S, E);
            } else if (j == 1) { phase_c1(args, lds, lane, wave, l);
            } else if (j == 2) { phase_c2(args, tid);
            } else if (j == 3) { phase_c3(args, lds, lane, wave, l);
            } else if (j == 4) {
                pg8::Gemm g{(const bf16*)(ws + WS_MIX), (const bf16*)(wl + W_OUT), M, D, D}; pg8::StaticOrder S; S.init(M, D, gridDim.x, (int)blockIdx.x);
                pg8::EpiRes E{l == 0 ? args.in[I_X] : args.out, dry ? (float*)(ws + WS_Z) : args.out, mod_l + 2 * D, (const float*)(ws + WS_GMUL) + (size_t)(l * 2 + 1) * NB * D, dry ? (bf16*)(ws + WS_Z + 64 * MiB) : (bf16*)(ws + WS_XN), dry ? (float*)(ws + WS_Z + 96 * MiB) : ssq};
                pg8::gemm_phase<pg8::EpiRes, pg8::StaticOrder, true, true>(lds, g, S, E);
            } else if (j == 5) {
                pg8::Gemm g{(const bf16*)(ws + WS_XN), (const bf16*)(wl + W_1), M, DFF, D}; pg8::StaticOrder S; S.init(M, DFF, gridDim.x, (int)blockIdx.x);
                pg8::EpiFF1 E{(bf16*)(ws + WS_Z), (const float*)(ws + WS_BIAS) + (size_t)(L + l) * NB * 4096, ssq};
                pg8::gemm_phase<pg8::EpiFF1, pg8::StaticOrder, true, true>(lds, g, S, E);
            } else {
                pg8::Gemm g{(const bf16*)(ws + WS_Z), (const bf16*)(wl + W_2), M, D, DFF}; pg8::StaticOrder S; S.init(M, D, gridDim.x, (int)blockIdx.x);
                pg8::EpiRes E{args.out, xdst, mod_l + 5 * D, l + 1 < L ? (const float*)(ws + WS_GMUL) + (size_t)((l + 1) * 2) * NB * D : nullptr, xndst, ssqdst};
                pg8::gemm_phase<pg8::EpiRes, pg8::StaticOrder, true, true>(lds, g, S, E);
            }
        }
        if (p + 1 < args.ph_hi || rr + 1 < reps) xcd_barrier(bar);
      }
    }
}

extern "C" void kernel_launch(void* const* d_in, const int* in_sizes, int n_in, void* d_out, int out_size, void* d_ws, size_t ws_size, hipStream_t stream) {
    static int grid = 0;
    if (grid == 0) {
        if (n_in != 19 || out_size != M * D || ws_size < WS_END) { fprintf(stderr, "kernel_launch: unexpected shapes (n_in %d out %d ws %zu)\n", n_in, out_size, ws_size); grid = -1; return; }
        int dev = 0, cus = 0, per_cu = 0;
        if (hipGetDevice(&dev) != hipSuccess || hipDeviceGetAttribute(&cus, hipDeviceAttributeMultiprocessorCount, dev) != hipSuccess) { grid = -1; return; }
        if (hipFuncSetAttribute((const void*)mk_fwd, hipFuncAttributeMaxDynamicSharedMemorySize, LDS_BYTES) != hipSuccess) { fprintf(stderr, "kernel_launch: hipFuncSetAttribute failed\n"); grid = -1; return; }
        if (hipOccupancyMaxActiveBlocksPerMultiprocessor(&per_cu, (const void*)mk_fwd, NWAVES * 64, LDS_BYTES) != hipSuccess || per_cu < 1) { fprintf(stderr, "kernel_launch: occupancy query says %d blocks/CU\n", per_cu); grid = -1; (void)hipGetLastError(); return; }
        grid = cus;
    }
    if (grid < 0) return;
    (void)hipMemsetAsync((char*)d_ws + WS_CTL, 0, CTL_ZERO_BYTES, stream);
    Args a{};
    for (int i = 0; i < 19; ++i) a.in[i] = (const float*)d_in[i];
    a.out = (float*)d_out; a.ws = (unsigned char*)d_ws;
#if MK_ONE_LAUNCH
    a.ph_lo = 0; a.ph_hi = NPH; a.li = 0;
    hipLaunchKernelGGL(mk_fwd, dim3(grid), dim3(NWAVES * 64), LDS_BYTES, stream, a);
#else
    for (int p = 0; p < NPH; ++p) { a.ph_lo = p; a.ph_hi = p + 1; a.li = 0; hipLaunchKernelGGL(mk_fwd, dim3(grid), dim3(NWAVES * 64), LDS_BYTES, stream, a); }
#endif
}
```

```cpp
#include <hip/hip_runtime.h>
#include <cstdint>
#include <cstdio>

#ifndef MK_KLOOP_ALIGN
#define MK_KLOOP_ALIGN 6
#endif
#ifndef MK_KLOOP_PAD
#define MK_KLOOP_PAD 8
#endif
#ifndef MK_SEG_ALIGN
#define MK_SEG_ALIGN 0
#endif
#ifndef MK_NT_LOADS
#define MK_NT_LOADS 1
#endif
#ifndef MK_WT_STORES
#define MK_WT_STORES 1
#endif
namespace cfg {
constexpr int D = 1024, NB = 4, S = 4096, L = 4, M = NB * S, DIN = 3736, DFF = 4096, NIN = 4096  ;
constexpr int GQ = 0, GK = 192, GV = 384, GLOW = 768, GOUT = 784, HQ = 1168, HF = 1552, HI = 1936, HOUT = 2320,
              MQK = 2704, MV = 3216, MI = 3472, MF = 3476, MOUT = 3480;
constexpr float EPS = 1e-6f;
constexpr size_t MiB = 1u << 20;
constexpr size_t WS_CTL = 0, CTL_ZERO_BYTES = 64 * 1024;
constexpr size_t WS_MOD = 256 * 1024;
constexpr size_t WS_LB = 1 * MiB;
constexpr size_t WS_GMUL = 1 * MiB + 64 * 1024;
constexpr size_t WS_BIAS = 2 * MiB;
constexpr size_t WS_MG = 3 * MiB;
constexpr size_t WS_SSQ = 4 * MiB;
constexpr size_t WS_FOLD = 356 * MiB;
constexpr size_t WS_VEC = 5 * MiB;
constexpr size_t WS_W = 8 * MiB, W_LAYER = 26 * MiB;
constexpr size_t W_IN = 0, W_OUT = 8 * MiB, W_1 = 10 * MiB, W_2 = 18 * MiB;
constexpr size_t WS_XN = 112 * MiB;
constexpr size_t WS_XB = 144 * MiB;
constexpr size_t WS_MIX = 304 * MiB;
constexpr size_t WS_Z = 176 * MiB;
constexpr size_t WS_U = 304 * MiB;
constexpr size_t WS_END = 360 * MiB;
}
using namespace cfg;

#define GAS __attribute__((address_space(1)))
#define LAS __attribute__((address_space(3)))
typedef unsigned short bf16;
typedef unsigned v4u __attribute__((ext_vector_type(4)));
typedef unsigned v2u __attribute__((ext_vector_type(2)));
typedef float f32x4 __attribute__((ext_vector_type(4)));
typedef float f32x16 __attribute__((ext_vector_type(16)));
typedef short bf16x8 __attribute__((ext_vector_type(8)));
typedef GAS unsigned gu32;
#define RLX_AGENT __ATOMIC_RELAXED, __HIP_MEMORY_SCOPE_AGENT

__device__ __forceinline__ void st16_wt(void* p, v4u v) {
#if MK_WT_STORES
    asm volatile("global_store_dwordx4 %0, %1, off sc1\n\ts_nop 1" :: "v"(p), "v"(v) : "memory");
#else
    *(v4u*)p = v;
#endif
}
__device__ __forceinline__ void st16_wtnt(void* p, v4u v) {
#if MK_WT_STORES
    asm volatile("global_store_dwordx4 %0, %1, off sc1 nt\n\ts_nop 1" :: "v"(p), "v"(v) : "memory");
#else
    *(v4u*)p = v;
#endif
}
__device__ __forceinline__ void st8_wt(void* p, v2u v) {
#if MK_WT_STORES
    *(v2u*)p = v;
#else
    *(v2u*)p = v;
#endif
}
#if MK_NT_LOADS
#define NT_LD(p) __builtin_nontemporal_load(p)
#else
#define NT_LD(p) (*(p))
#endif
__device__ __forceinline__ unsigned f2bf(float f) { unsigned u = __builtin_bit_cast(unsigned, f); return (u + 0x7fffu + ((u >> 16) & 1u)) >> 16; }
__device__ __forceinline__ unsigned pk2(float lo, float hi) { return f2bf(lo) | (f2bf(hi) << 16); }
__device__ __forceinline__ float bf2f(unsigned short h) { return __builtin_bit_cast(float, (unsigned)h << 16); }
__device__ __forceinline__ float sigmoidf_(float x) { return 1.f / (1.f + __expf(-x)); }
__device__ __forceinline__ float siluf_(float x) { return x * sigmoidf_(x); }
__device__ __forceinline__ float logsigmoidf_(float x) { return fminf(x, 0.f) - log1pf(__expf(-fabsf(x))); }
__device__ __forceinline__ float wave_sum(float v) {
#pragma unroll
    for (int o = 1; o < 64; o <<= 1) v += __shfl_xor(v, o);
    return v;
}
__host__ __device__ __forceinline__ int in_src(int np) {
    const int pn = np >> 8, tc = np & 255, bj = tc >> 7, wc = (tc >> 5) & 3, n = (tc >> 4) & 1, g = tc & 15;
    if (pn < 6) { const int gh = pn;
        if (wc < 2) { const int c = 16 * wc + g;
            if (bj == 0) return (n == 0 ? GQ : GK) + gh * 32 + c;
            if (n == 0) return -2 - (gh * 32 + c);
            if (gh == 0 && wc == 0 && g < 8) return (g < 4) ? MI + g : MF + (g - 4);
            return -1; }
        const int e = 32 * (wc - 2) + 16 * n + g; return (bj == 0 ? GV : GOUT) + gh * 64 + e; }
    if (pn < 12) { const int hh = pn - 6, c = 16 * wc + g; const int base = bj == 0 ? (n == 0 ? HQ : HF) : (n == 0 ? HI : HOUT); return base + hh * 64 + c; }
    const int mh = pn - 12, grp = tc >> 6, c = tc & 63;
    return (grp == 0 ? MQK : grp == 1 ? MQK + 256 : grp == 2 ? MV : MOUT) + mh * 64 + c;
}
namespace pg8 {
#define PG8_LAS __attribute__((address_space(3)))
typedef unsigned short bf16_t;
typedef short bf16x8 __attribute__((ext_vector_type(8)));
typedef float f32x4 __attribute__((ext_vector_type(4)));
typedef unsigned u32x4 __attribute__((ext_vector_type(4)));
constexpr int BM = 256, BK = 64, HALF = 128, HTB = HALF * BK * 2  , STAGE_BYTES = 8 * HTB, NXCD = 8, WGM = 8;

__host__ __device__ __forceinline__ int lds_byte(int r, int c) { const int st = (r >> 4) * 2 + (c >> 5), rr = r & 15, cc = c & 31, ob = rr * 64 + cc * 2; return st * 1024 + (ob ^ (((ob >> 9) & 1) << 5)); }
__host__ __device__ __forceinline__ void stage_rc(int b, int& R, int& C) { const int st = b / 1024, sb = b % 1024, swz = sb ^ (((sb >> 9) & 1) << 5); R = (st >> 1) * 16 + swz / 64; C = (st & 1) * 32 + (swz % 64) / 2; }
__host__ __device__ __forceinline__ int perm32(int rho) { const int n = rho >> 4, i = rho & 15; return 8 * (i >> 2) + 4 * n + (i & 3); }

struct Unit { int pm, pn, ui; };
struct Gemm { const bf16_t* A; const bf16_t* Bt; int M, N, K; };

struct StaticOrder {
    int nM, nN, nwg, G, c;
    __host__ __device__ void init(int M, int N, int G_, int c_) { nM = M / BM; nN = N / BM; nwg = nM * nN; G = G_; c = c_; }
    __host__ __device__ bool next(int i, Unit& u) const {
        const long L = (long)i * G + c; if (L >= nwg) return false;
        int wgid = (int)L; { const int q = nwg / NXCD, r = nwg % NXCD, xcd = wgid % NXCD, off = wgid / NXCD; wgid = (xcd < r ? xcd * (q + 1) : r * (q + 1) + (xcd - r) * q) + off; }
        const int nig = WGM * nN, gid = wgid / nig, fm = gid * WGM, gsz = (nM - fm) < WGM ? (nM - fm) : WGM;
        u.pm = fm + ((wgid % nig) % gsz); u.pn = (wgid % nig) / gsz; u.ui = i; return true;
    }
    __device__ __forceinline__ void a_ready(const Unit&) const {}
    __device__ __forceinline__ void done(const Unit&) const {}
};

typedef float f32x2 __attribute__((ext_vector_type(2)));
typedef unsigned u32x2 __attribute__((ext_vector_type(2)));
__device__ __forceinline__ unsigned cvt_pk_bf16(float lo, float hi) { typedef __bf16 bf16x2_t __attribute__((ext_vector_type(2))); f32x2 v = {lo, hi}; bf16x2_t b = __builtin_convertvector(v, bf16x2_t); return __builtin_bit_cast(unsigned, b); }
__device__ __forceinline__ float row_rstd(const float* ssq, int row, int fq) {
    const f32x4 p = *(const f32x4*)(ssq + (size_t)row * 16 + 4 * fq); float s = (p[0] + p[1]) + (p[2] + p[3]);
    s += __shfl_xor(s, 16); s += __shfl_xor(s, 32);
    return rsqrtf(s * (1.0f / 1024.0f) + 1e-6f);
}
__device__ __forceinline__ void fill_rstd(PG8_LAS float* rt, const float* ssq, const StaticOrder& S, int tid) {
    for (int ui = tid >> 8; ui < 12; ui += 2) { Unit u;
        if (S.next(ui, u)) { const f32x4* p = (const f32x4*)(ssq + (size_t)(u.pm * BM + (tid & 255)) * 16); const f32x4 a = p[0], b = p[1], c = p[2], d = p[3];
            const float s = (((a[0] + a[1]) + (a[2] + a[3])) + ((b[0] + b[1]) + (b[2] + b[3]))) + (((c[0] + c[1]) + (c[2] + c[3])) + ((d[0] + d[1]) + (d[2] + d[3])));
            rt[ui * 256 + (tid & 255)] = rsqrtf(s * (1.0f / 1024.0f) + 1e-6f); } }
}
__device__ __forceinline__ void fill_bias(PG8_LAS float* bt, const float* bias  , const StaticOrder& S, int tid) {
    for (int ui = tid >> 8; ui < 12; ui += 2) { Unit u; if (S.next(ui, u)) bt[ui * 256 + (tid & 255)] = bias[(u.pm >> 4) * 4096 + u.pn * BM + (tid & 255)]; }
}
struct EpiRes {
    static constexpr bool PERM = true, AFTER_DRAIN = false;
    const float* xin32  ; const bf16_t* xin; bf16_t* xout; const float* gate  ; const float* gmul  ; bf16_t* xn; float* ssq;
    __device__ __forceinline__ void operator()(const f32x4 (&acc)[2][2][4][2], const Unit& u, int wr, int wc, int fr, int fq) const {
        const int b = u.pm >> 4, col0 = u.pn * BM + wc * 32 + 8 * fq; const int row0 = u.pm * BM + wr * 64 + fr;
        const unsigned eb = (unsigned)row0 * 1024u + (unsigned)col0;
        const char* xi32 = (const char*)xin32; const char* xi = (const char*)xin; char* xo_ = (char*)xout; char* xn_ = (char*)xn; const bool has_gm = gmul != nullptr, in32 = xin32 != nullptr;
        float s[2][4];
#pragma unroll
        for (int ai = 0; ai < 2; ++ai)
#pragma unroll
            for (int m = 0; m < 4; ++m) s[ai][m] = 0.f;
#pragma unroll
        for (int bj = 0; bj < 2; ++bj) { const unsigned c = (unsigned)(col0 + bj * HALF);
            const f32x4 gv0 = *(const f32x4*)((const char*)gate + (((unsigned)b * 6144u + c) << 2)), gv1 = *(const f32x4*)((const char*)gate + (((unsigned)b * 6144u + c + 4u) << 2));
            f32x4 gm0 = (f32x4){0.f, 0.f, 0.f, 0.f}, gm1 = gm0; if (has_gm) { gm0 = *(const f32x4*)((const char*)gmul + (((unsigned)b * 1024u + c) << 2)); gm1 = *(const f32x4*)((const char*)gmul + (((unsigned)b * 1024u + c + 4u) << 2)); }
#pragma unroll
            for (int ai = 0; ai < 2; ++ai) {
#pragma unroll
                for (int m = 0; m < 4; ++m) { const unsigned e = eb + (unsigned)((ai * HALF + m * 16) * 1024 + bj * HALF);
                    f32x4 xa, xb;
                    if (in32) { xa = *(const f32x4*)(xi32 + (e << 2)); xb = *(const f32x4*)(xi32 + (e << 2) + 16); }
                    else { const u32x4 r = *(const u32x4*)(xi + (e << 1)); xa = (f32x4){__builtin_bit_cast(float, r.x << 16), __builtin_bit_cast(float, r.x & 0xffff0000u), __builtin_bit_cast(float, r.y << 16), __builtin_bit_cast(float, r.y & 0xffff0000u)};
                        xb = (f32x4){__builtin_bit_cast(float, r.z << 16), __builtin_bit_cast(float, r.z & 0xffff0000u), __builtin_bit_cast(float, r.w << 16), __builtin_bit_cast(float, r.w & 0xffff0000u)}; }
                    const f32x4 wa = xa + gv0 * acc[ai][bj][m][0], wb = xb + gv1 * acc[ai][bj][m][1];
                    u32x4 xw; xw.x = cvt_pk_bf16(wa[0], wa[1]); xw.y = cvt_pk_bf16(wa[2], wa[3]); xw.z = cvt_pk_bf16(wb[0], wb[1]); xw.w = cvt_pk_bf16(wb[2], wb[3]);
                    *(u32x4*)(xo_ + (e << 1)) = xw;
                    const float r0 = __builtin_bit_cast(float, xw.x << 16), r1 = __builtin_bit_cast(float, xw.x & 0xffff0000u), r2 = __builtin_bit_cast(float, xw.y << 16), r3 = __builtin_bit_cast(float, xw.y & 0xffff0000u);
                    const float r4 = __builtin_bit_cast(float, xw.z << 16), r5 = __builtin_bit_cast(float, xw.z & 0xffff0000u), r6 = __builtin_bit_cast(float, xw.w << 16), r7 = __builtin_bit_cast(float, xw.w & 0xffff0000u);
                    s[ai][m] += ((r0 * r0 + r1 * r1) + (r2 * r2 + r3 * r3)) + ((r4 * r4 + r5 * r5) + (r6 * r6 + r7 * r7));
                    if (has_gm) { u32x4 w; w.x = cvt_pk_bf16(r0 * gm0[0], r1 * gm0[1]); w.y = cvt_pk_bf16(r2 * gm0[2], r3 * gm0[3]); w.z = cvt_pk_bf16(r4 * gm1[0], r5 * gm1[1]); w.w = cvt_pk_bf16(r6 * gm1[2], r7 * gm1[3]); *(u32x4*)(xn_ + (e << 1)) = w; } }
                asm volatile("" ::: "memory"); } }
#pragma unroll
        for (int ai = 0; ai < 2; ++ai)
#pragma unroll
            for (int m = 0; m < 4; ++m) { float t = s[ai][m]; t += __shfl_xor(t, 16); t += __shfl_xor(t, 32);
                if (fq == 0) *(float*)((char*)ssq + ((((unsigned)(row0 + ai * HALF + m * 16)) * 16u + (unsigned)(u.pn * 4 + wc)) << 2)) = t; }
    }
};
struct EpiFF1 {
    static constexpr bool PERM = true, AFTER_DRAIN = false;
    bf16_t* O; PG8_LAS const float* bt; PG8_LAS const float* rt;
    __device__ __forceinline__ void operator()(const f32x4 (&acc)[2][2][4][2], const Unit& u, int wr, int wc, int fr, int fq) const {
        if (!O) return;
        const int col0 = u.pn * BM + wc * 32 + 8 * fq;
        f32x4 bv[2][2];
#pragma unroll
        for (int bj = 0; bj < 2; ++bj)
#pragma unroll
            for (int n = 0; n < 2; ++n) bv[bj][n] = *(PG8_LAS const f32x4*)(bt + u.ui * 256 + wc * 32 + 8 * fq + bj * HALF + 4 * n);
#pragma unroll
        for (int ai = 0; ai < 2; ++ai)
#pragma unroll
            for (int m = 0; m < 4; ++m) { const int row = u.pm * BM + ai * HALF + wr * 64 + m * 16 + fr; const float rs = rt[u.ui * 256 + ai * HALF + wr * 64 + m * 16 + fr]; bf16_t* rowp = O + (size_t)row * 4096 + col0;
#pragma unroll
                for (int bj = 0; bj < 2; ++bj) { f32x4 v0 = acc[ai][bj][m][0] * rs + bv[bj][0], v1 = acc[ai][bj][m][1] * rs + bv[bj][1];
#pragma unroll
                    for (int j = 0; j < 4; ++j) { const float a = fmaxf(v0[j], 0.f), c = fmaxf(v1[j], 0.f); v0[j] = a * a; v1[j] = c * c; }
                    u32x4 w; w.x = cvt_pk_bf16(v0[0], v0[1]); w.y = cvt_pk_bf16(v0[2], v0[3]); w.z = cvt_pk_bf16(v1[0], v1[1]); w.w = cvt_pk_bf16(v1[2], v1[3]);
                    st16_wt(rowp + bj * HALF, w); } }
    }
};
template <int CTRL> __device__ __forceinline__ float dpp_shr(float x) { return __builtin_bit_cast(float, __builtin_amdgcn_update_dpp(0, __builtin_bit_cast(int, x), CTRL, 0xf, 0xf, true)); }
__device__ __forceinline__ float row15(float x) { return __shfl(x, 15, 16); }
__device__ __forceinline__ float fexp(float x) { return __builtin_amdgcn_exp2f(x * 1.4426950408889634f); }
__device__ __forceinline__ float fsigmoid(float x) { return __builtin_amdgcn_rcpf(1.f + fexp(-x)); }
__device__ __forceinline__ void chunk_scan(float (&v)[4], float& r, float& last) {
    float tot[4];
#pragma unroll
    for (int m = 0; m < 4; ++m) { float x = v[m]; x += dpp_shr<0x111>(x); x += dpp_shr<0x112>(x); x += dpp_shr<0x114>(x); x += dpp_shr<0x118>(x); v[m] = x; tot[m] = row15(x); }
    r = tot[0] + tot[1]; last = (tot[0] + tot[1]) + (tot[2] + tot[3]);
    v[1] += tot[0]; v[2] += tot[0] + tot[1]; v[3] += (tot[0] + tot[1]) + tot[2];
}
struct EpiIn {
    static constexpr bool PERM = false, AFTER_DRAIN = false;
    bf16_t* Z; float* vec  ; float* mg  ; PG8_LAS const float* bt; PG8_LAS const float* rt; const float* lbt  ; const float* bgate  ;
    __device__ __forceinline__ void operator()(f32x4 (&acc)[2][2][4][2], const Unit& u, int wr, int wc, int fr, int fq) const {
        if (!Z) return;
        const int b = u.pm >> 4, pn = u.pn, col0 = pn * BM + wc * 32 + 4 * fq; const int row0 = u.pm * BM + wr * 64 + fr;
#pragma unroll
        for (int ai = 0; ai < 2; ++ai)
#pragma unroll
            for (int m = 0; m < 4; ++m) { const float rs = rt[u.ui * 256 + ai * HALF + wr * 64 + m * 16 + fr];
#pragma unroll
                for (int bj = 0; bj < 2; ++bj)
#pragma unroll
                    for (int n = 0; n < 2; ++n) acc[ai][bj][m][n] = acc[ai][bj][m][n] * rs + *(PG8_LAS const f32x4*)(bt + u.ui * 256 + wc * 32 + 4 * fq + bj * HALF + n * 16); }
        char* Zc = (char*)Z;
        const unsigned zb = ((unsigned)row0 * 4096u + (unsigned)(pn * BM)) * 2u;
        const bool odd = (fq & 1) != 0;
#define ZST2(ai_, m_, colA, valA, colB, valB) do { const f32x4 a_ = (valA), b_ = (valB); u32x2 wa_, wb_; wa_.x = cvt_pk_bf16(a_[0], a_[1]); wa_.y = cvt_pk_bf16(a_[2], a_[3]); wb_.x = cvt_pk_bf16(b_[0], b_[1]); wb_.y = cvt_pk_bf16(b_[2], b_[3]); \
        const unsigned gx_ = odd ? wa_.x : wb_.x, gy_ = odd ? wa_.y : wb_.y; const unsigned rx_ = (unsigned)__shfl_xor((int)gx_, 16), ry_ = (unsigned)__shfl_xor((int)gy_, 16); \
        v4u o_; o_.x = odd ? rx_ : wa_.x; o_.y = odd ? ry_ : wa_.y; o_.z = odd ? wb_.x : rx_; o_.w = odd ? wb_.y : ry_; \
        *(v4u*)(Zc + (zb + (unsigned)(((ai_) * HALF + (m_) * 16) * 8192) + (unsigned)(odd ? (colB) - 8 : (colA)))) = o_; } while (0)
        if (pn >= 12) {
#pragma unroll
            for (int ai = 0; ai < 2; ++ai)
#pragma unroll
                for (int m = 0; m < 4; ++m)
#pragma unroll
                    for (int bj = 0; bj < 2; ++bj) { f32x4 v0 = acc[ai][bj][m][0], v1 = acc[ai][bj][m][1]; const int tc = bj * HALF + wc * 32 + 4 * fq;
                        if (bj == 1 && wc >= 2) { v0[0] = fsigmoid(v0[0]); v0[1] = fsigmoid(v0[1]); v0[2] = fsigmoid(v0[2]); v0[3] = fsigmoid(v0[3]); v1[0] = fsigmoid(v1[0]); v1[1] = fsigmoid(v1[1]); v1[2] = fsigmoid(v1[2]); v1[3] = fsigmoid(v1[3]); }
                        ZST2(ai, m, tc * 2, v0, (tc + 16) * 2, v1); }
        } else if (pn >= 6) {
            const int c0 = 16 * wc + 4 * fq; const f32x4 lb4 = *(const f32x4*)(lbt + (pn - 6) * 64 + c0);
#pragma unroll
            for (int ai = 0; ai < 2; ++ai) {
                float* vp = vec + ((size_t)((b * 64 + (u.pm & 15) * 4 + 2 * ai + wr) * 16 + pn)) * 192 + c0;
#pragma unroll
                for (int j = 0; j < 4; ++j) { float v[4]; const float lbv = lb4[j];
#pragma unroll
                    for (int m = 0; m < 4; ++m) { const float f = fmaxf(acc[ai][0][m][1][j], -80.f), ee = fexp(-f), sig = __builtin_amdgcn_rcpf(1.f + ee);
                        v[m] = __logf(lbv + (1.f - lbv) * sig);
                        acc[ai][0][m][1][j] = (1.f - lbv) * ee * sig;
                        const float q = acc[ai][0][m][0][j]; acc[ai][0][m][0][j] = q * fsigmoid(q); }
                    float r, last; chunk_scan(v, r, last);
#pragma unroll
                    for (int m = 0; m < 4; ++m) { acc[ai][0][m][0][j] *= fexp(fminf(v[m] - r, 60.f)); acc[ai][0][m][1][j] *= fexp(fminf(r - v[m], 60.f)); }
                    if (fr == 0) { vp[j] = fexp(r); vp[64 + j] = fexp(last - r); vp[128 + j] = fexp(last); } }
#pragma unroll
                for (int m = 0; m < 4; ++m) { ZST2(ai, m, c0 * 2, acc[ai][0][m][0], 128 + c0 * 2, acc[ai][0][m][1]);
                    f32x4 g = acc[ai][1][m][1]; g[0] = fsigmoid(g[0]); g[1] = fsigmoid(g[1]); g[2] = fsigmoid(g[2]); g[3] = fsigmoid(g[3]); ZST2(ai, m, 256 + c0 * 2, acc[ai][1][m][0], 384 + c0 * 2, g); }
                asm volatile("" ::: "memory");
            }
        } else if (wc < 2) {
            const int c0 = 16 * wc + 4 * fq; const f32x4 bg4 = *(const f32x4*)(bgate + pn * 32 + c0);
#pragma unroll
            for (int ai = 0; ai < 2; ++ai) {
                float* vp = vec + ((size_t)((b * 64 + (u.pm & 15) * 4 + 2 * ai + wr) * 16 + pn)) * 192 + c0;
#pragma unroll
                for (int j = 0; j < 4; ++j) { float v[4];
#pragma unroll
                    for (int m = 0; m < 4; ++m) { const float x = acc[ai][1][m][0][j] + bg4[j]; v[m] = (fminf(x, 0.f) - __logf(1.f + fexp(-fabsf(x)))) * 0.0625f; }
                    float r, last; chunk_scan(v, r, last);
#pragma unroll
                    for (int m = 0; m < 4; ++m) { acc[ai][0][m][0][j] *= 0.17677669529663687f * fexp(fminf(v[m] - r, 60.f)); acc[ai][0][m][1][j] *= fexp(fminf(r - v[m], 60.f)); }
                    if (fr == 0) { vp[j] = fexp(r); vp[64 + j] = fexp(last - r); vp[128 + j] = fexp(last); } }
#pragma unroll
                for (int m = 0; m < 4; ++m) ZST2(ai, m, c0 * 2, acc[ai][0][m][0], 64 + c0 * 2, acc[ai][0][m][1]);
                if (pn == 0 && wc == 0 && fq < 2) {
#pragma unroll
                    for (int m = 0; m < 4; ++m) *(f32x4*)(mg + (size_t)(row0 + ai * HALF + m * 16) * 8 + 4 * fq) = acc[ai][1][m][1]; }
                asm volatile("" ::: "memory");
            }
        } else {
            const int e0 = 32 * (wc - 2) + 4 * fq;
#pragma unroll
            for (int ai = 0; ai < 2; ++ai)
#pragma unroll
                for (int m = 0; m < 4; ++m)
#pragma unroll
                    for (int n = 0; n < 2; ++n) { f32x4 g = acc[ai][1][m][n]; g[0] *= fsigmoid(g[0]); g[1] *= fsigmoid(g[1]); g[2] *= fsigmoid(g[2]); g[3] *= fsigmoid(g[3]);
                        ZST2(ai, m, 256 + (e0 + 16 * n) * 2, acc[ai][0][m][n], 384 + (e0 + 16 * n) * 2, g); }
        }
#undef ZST2
    }
};
#if MK_SEG_ALIGN
#define PG8_SEGALIGN asm volatile(".p2align 6\n\t.rept " PG8_STR(MK_KLOOP_PAD) "\n\ts_nop 0\n\t.endr" ::: "memory")
#else
#define PG8_SEGALIGN do {} while (0)
#endif
#define PG8_STR2(x) #x
#define PG8_STR(x) PG8_STR2(x)
template <class Epi, class Sched, bool ALIGN_EPI = false, bool SP2 = false, int AUX_A = 0>
__device__ __forceinline__ void gemm_phase(PG8_LAS unsigned char* lds, const Gemm g, const Sched& S, const Epi& E, int wave_in) {
    int tid_; asm volatile("v_mbcnt_lo_u32_b32 %0, -1, 0\n\tv_mbcnt_hi_u32_b32 %0, -1, %0" : "=v"(tid_)); tid_ += wave_in * 64;
    const int tid = tid_, wid = __builtin_amdgcn_readfirstlane(tid >> 6), lane = tid & 63, wr = wid >> 2, wc = wid & 3, fr = lane & 15, fq = lane >> 4;
    const int K = g.K, nt = K / BK;
    unsigned voffA[2], voffB[2];
#pragma unroll
    for (int i = 0; i < 2; ++i) { int R, C; stage_rc(tid * 16 + i * 8192, R, C); const int Rb = Epi::PERM ? ((R & ~31) + perm32(R & 31)) : R;
        voffA[i] = (unsigned)(R * K + C) * 2u; voffB[i] = (unsigned)(Rb * K + C) * 2u; }
    const size_t kstep = (size_t)(BK * 2);
    const size_t hstep = (size_t)HALF * K * 2;
    const size_t tstep = 2 * hstep;
    const unsigned ldsw = (unsigned)wid * 1024u;
    const int aoff = lds_byte(wr * 64 + fr, fq * 8), boff = lds_byte(wc * 32 + fr, fq * 8);
#define PG8_SA(b, h) (((b) * 2 + (h)) * HTB)
#define PG8_SB(b, h) ((4 + (b) * 2 + (h)) * HTB)
#define PG8_STAGE(bufoff, gbase, voff) do { _Pragma("unroll") for (int _i = 0; _i < 2; ++_i) { \
        if ((voff) == voffA && AUX_A != 0) __builtin_amdgcn_global_load_lds((const unsigned*)((const char*)(gbase) + (voff)[_i]), (PG8_LAS unsigned*)(lds + (bufoff) + ldsw + _i * 8192), 16, 0, AUX_A); \
        else __builtin_amdgcn_global_load_lds((const unsigned*)((const char*)(gbase) + (voff)[_i]), (PG8_LAS unsigned*)(lds + (bufoff) + ldsw + _i * 8192), 16, 0, 0); } } while (0)
#define PG8_LDA(dst, b, h) do { _Pragma("unroll") for (int m = 0; m < 4; ++m) _Pragma("unroll") for (int k = 0; k < 2; ++k) dst[m][k] = *(const PG8_LAS bf16x8*)(lds + PG8_SA(b, h) + aoff + m * 2048 + k * 1024); } while (0)
#define PG8_LDB(dst, b, h) do { _Pragma("unroll") for (int n = 0; n < 2; ++n) _Pragma("unroll") for (int k = 0; k < 2; ++k) dst[n][k] = *(const PG8_LAS bf16x8*)(lds + PG8_SB(b, h) + boff + n * 2048 + k * 1024); } while (0)
#define PG8_MMA(ai, bj, At, Bt) do { __builtin_amdgcn_s_setprio(1); _Pragma("unroll") for (int m = 0; m < 4; ++m) _Pragma("unroll") for (int n = 0; n < 2; ++n) _Pragma("unroll") for (int k = 0; k < 2; ++k) \
        acc[ai][bj][m][n] = __builtin_amdgcn_mfma_f32_16x16x32_bf16(Bt[n][k], At[m][k], acc[ai][bj][m][n], 0, 0, 0); __builtin_amdgcn_s_setprio(0); } while (0)
#define PG8_WAIT_V(n) asm volatile("s_waitcnt vmcnt(" #n ")" ::: "memory")
#define PG8_WAIT_L(n) asm volatile("s_waitcnt lgkmcnt(" #n ")" ::: "memory")
#define PG8_BAR __builtin_amdgcn_s_barrier()
#define PG8_SCHED __builtin_amdgcn_sched_barrier(0)
    Unit cur, nxt; int ui = 0;
    if (!S.next(0, cur)) return;
    f32x4 acc[2][2][4][2];
#pragma unroll
    for (int a = 0; a < 2; ++a)
#pragma unroll
        for (int b = 0; b < 2; ++b)
#pragma unroll
            for (int m = 0; m < 4; ++m)
#pragma unroll
                for (int n = 0; n < 2; ++n) acc[a][b][m][n] = (f32x4){0.f, 0.f, 0.f, 0.f};
    bf16x8 At[4][2], B0[2][2], B1[2][2];
    const char* cA = (const char*)g.A + (size_t)cur.pm * tstep; const char* cB = (const char*)g.Bt + (size_t)cur.pn * tstep;
    S.a_ready(cur);
    if constexpr (SP2) {
        PG8_STAGE(PG8_SB(0, 0), cB, voffB); PG8_STAGE(PG8_SB(0, 1), cB + hstep, voffB); PG8_STAGE(PG8_SA(0, 0), cA, voffA); PG8_STAGE(PG8_SA(0, 1), cA + hstep, voffA);
        if (wr == 1) PG8_BAR;
        PG8_WAIT_V(2); PG8_BAR;
        PG8_STAGE(PG8_SB(1, 0), cB + kstep, voffB); PG8_STAGE(PG8_SA(1, 0), cA + kstep, voffA); PG8_STAGE(PG8_SB(1, 1), cB + hstep + kstep, voffB);
        PG8_WAIT_V(6); PG8_BAR;
    } else {
        PG8_STAGE(PG8_SB(0, 0), cB, voffB); PG8_STAGE(PG8_SA(0, 0), cA, voffA); PG8_STAGE(PG8_SB(0, 1), cB + hstep, voffB); PG8_STAGE(PG8_SA(0, 1), cA + hstep, voffA);
        if (wr == 1) PG8_BAR;
        PG8_WAIT_V(4); PG8_BAR;
        PG8_STAGE(PG8_SB(1, 0), cB + kstep, voffB); PG8_STAGE(PG8_SA(1, 0), cA + kstep, voffA); PG8_STAGE(PG8_SB(1, 1), cB + hstep + kstep, voffB);
        PG8_WAIT_V(6); PG8_BAR;
    }
    for (;;) {
        const bool has_next = S.next(ui + 1, nxt);
        const char* nA = has_next ? (const char*)g.A + (size_t)nxt.pm * tstep : cA; const char* nB = has_next ? (const char*)g.Bt + (size_t)nxt.pn * tstep : cB;
        for (int t = 0; t < nt; t += 2) {
            asm volatile(".p2align " PG8_STR(MK_KLOOP_ALIGN) "\n\t.rept " PG8_STR(MK_KLOOP_PAD) "\n\ts_nop 0\n\t.endr" ::: "memory");
            const bool last = (t == nt - 2);
            const char* a1 = cA + (size_t)(t + 1) * kstep;
            const char* a2 = last ? nA : cA + (size_t)(t + 2) * kstep; const char* b2 = last ? nB : cB + (size_t)(t + 2) * kstep;
            const char* a3 = a2 + kstep; const char* b3 = b2 + kstep;
            if (last && has_next) S.a_ready(nxt);
            if constexpr (SP2) {
            PG8_LDB(B0, 0, 0); PG8_LDB(B1, 0, 1); PG8_SCHED; PG8_LDA(At, 0, 0); PG8_STAGE(PG8_SA(1, 1), a1 + hstep, voffA);
            PG8_WAIT_V(8); PG8_WAIT_L(0); PG8_BAR; PG8_MMA(0, 0, At, B0); PG8_MMA(0, 1, At, B1); PG8_BAR; PG8_SCHED; PG8_SEGALIGN;
            PG8_LDA(At, 0, 1); PG8_STAGE(PG8_SB(0, 0), b2, voffB); PG8_STAGE(PG8_SB(0, 1), b2 + hstep, voffB); PG8_STAGE(PG8_SA(0, 0), a2, voffA);
            PG8_WAIT_V(8); PG8_WAIT_L(0); PG8_BAR; PG8_MMA(1, 0, At, B0); PG8_MMA(1, 1, At, B1); PG8_BAR; PG8_SCHED; PG8_SEGALIGN;
            PG8_LDB(B0, 1, 0); PG8_LDB(B1, 1, 1); PG8_SCHED; PG8_LDA(At, 1, 0); PG8_STAGE(PG8_SA(0, 1), a2 + hstep, voffA);
            PG8_WAIT_V(8); PG8_WAIT_L(0); PG8_BAR; PG8_MMA(0, 0, At, B0); PG8_MMA(0, 1, At, B1); PG8_BAR; PG8_SCHED; PG8_SEGALIGN;
            PG8_LDA(At, 1, 1); PG8_STAGE(PG8_SB(1, 0), b3, voffB); PG8_STAGE(PG8_SB(1, 1), b3 + hstep, voffB); PG8_STAGE(PG8_SA(1, 0), a3, voffA);
            PG8_WAIT_V(8); PG8_WAIT_L(0); PG8_BAR; PG8_MMA(1, 0, At, B0); PG8_MMA(1, 1, At, B1); PG8_BAR; PG8_SCHED; PG8_SEGALIGN;
            } else {
            PG8_LDB(B0, 0, 0); PG8_SCHED; PG8_LDA(At, 0, 0); PG8_STAGE(PG8_SA(1, 1), a1 + hstep, voffA);
            PG8_WAIT_L(8); PG8_BAR; PG8_WAIT_L(0); PG8_MMA(0, 0, At, B0); PG8_BAR; PG8_SCHED;
            PG8_LDB(B1, 0, 1); PG8_STAGE(PG8_SB(0, 0), b2, voffB);
            PG8_BAR; PG8_WAIT_L(0); PG8_MMA(0, 1, At, B1); PG8_BAR;
            PG8_LDA(At, 0, 1); PG8_STAGE(PG8_SA(0, 0), a2, voffA);
            PG8_BAR; PG8_WAIT_L(0); PG8_MMA(1, 0, At, B0); PG8_BAR; PG8_SCHED;
            PG8_STAGE(PG8_SB(0, 1), b2 + hstep, voffB);
            PG8_WAIT_V(6); PG8_BAR; PG8_MMA(1, 1, At, B1); PG8_BAR;
            PG8_LDB(B0, 1, 0); PG8_SCHED; PG8_LDA(At, 1, 0); PG8_STAGE(PG8_SA(0, 1), a2 + hstep, voffA);
            PG8_WAIT_L(8); PG8_BAR; PG8_WAIT_L(0); PG8_MMA(0, 0, At, B0); PG8_BAR; PG8_SCHED;
            PG8_LDB(B1, 1, 1); PG8_STAGE(PG8_SB(1, 0), b3, voffB);
            PG8_BAR; PG8_WAIT_L(0); PG8_MMA(0, 1, At, B1); PG8_BAR;
            PG8_LDA(At, 1, 1); PG8_STAGE(PG8_SA(1, 0), a3, voffA);
            PG8_BAR; PG8_WAIT_L(0); PG8_MMA(1, 0, At, B0); PG8_BAR; PG8_SCHED;
            PG8_STAGE(PG8_SB(1, 1), b3 + hstep, voffB);
            PG8_WAIT_V(6); PG8_BAR; PG8_MMA(1, 1, At, B1); PG8_BAR;
            }
        }
        if constexpr (ALIGN_EPI) { if (wr == 0) PG8_BAR; }
        if constexpr (!Epi::AFTER_DRAIN) { E(acc, cur, wr, wc, fr, fq); S.done(cur); }
        if (!has_next) break;
#pragma unroll
        for (int a = 0; a < 2; ++a)
#pragma unroll
            for (int b = 0; b < 2; ++b)
#pragma unroll
                for (int m = 0; m < 4; ++m)
#pragma unroll
                    for (int n = 0; n < 2; ++n) acc[a][b][m][n] = (f32x4){0.f, 0.f, 0.f, 0.f};
        cur = nxt; cA = nA; cB = nB; ++ui;
        if constexpr (ALIGN_EPI) { if (wr == 1) PG8_BAR; }
    }
    PG8_WAIT_V(0);
    if constexpr (!ALIGN_EPI) { if (wr == 0) PG8_BAR; }
    PG8_BAR;
    if constexpr (Epi::AFTER_DRAIN) { E.fused(acc, cur, wr, wc, fr, fq, lds, wid, lane); S.done(cur); }
#undef PG8_SA
#undef PG8_SB
#undef PG8_STAGE
#undef PG8_LDA
#undef PG8_LDB
#undef PG8_MMA
#undef PG8_WAIT_V
#undef PG8_WAIT_L
#undef PG8_BAR
#undef PG8_SCHED
}
}
#define XB_TMO      128
#define XB_XCNT(j)  (256  + 64 * (j))
#define XB_XSUB(j)  (1280 + 64 * (j))
#define XB_XGEN(j)  (2304 + 64 * (j))
#define XB_TOP      3328
#define XB_TOPGEN   3392
#define XCD_BAR_WORDS 3456
#define XB_SPIN_CAP (1u << 18)
#ifndef MK_FLAT_RELEASE
#define MK_FLAT_RELEASE 1
#endif

__device__ __forceinline__ unsigned xb_ld(unsigned* p)              { return __hip_atomic_load(p, __ATOMIC_RELAXED, __HIP_MEMORY_SCOPE_AGENT); }
__device__ __forceinline__ unsigned xb_add(unsigned* p, unsigned v) { return __hip_atomic_fetch_add(p, v, __ATOMIC_RELAXED, __HIP_MEMORY_SCOPE_AGENT); }
__device__ __forceinline__ unsigned xb_xcc_id() { return (unsigned)__builtin_amdgcn_s_getreg((3 << 11) | 20) & 0xFu; }
#define XB_SPIN(cond, bar) do { unsigned _sp = 0; while (cond) { __builtin_amdgcn_s_sleep(1); \
    if ((++_sp & 255u) == 0u) { if (xb_ld(&(bar)[XB_TMO])) break; if (_sp > XB_SPIN_CAP) { atomicAdd(&(bar)[XB_TMO], 1u); break; } } } } while (0)

struct XcdBarrier {
    unsigned* bar; unsigned x;
    volatile LAS unsigned* st;
};

__device__ __forceinline__ XcdBarrier xcd_barrier_post(unsigned* bar, volatile LAS unsigned* st) {
    XcdBarrier b; b.bar = bar; b.x = xb_xcc_id(); b.st = st;
    if (threadIdx.x == 0) (void)xb_add(&bar[XB_XCNT(b.x)], 1u);
    return b;
}
__device__ __forceinline__ void xcd_barrier_complete(unsigned* bar, unsigned x, unsigned& nloc, unsigned& nx) {
    const unsigned G = gridDim.x * gridDim.y * gridDim.z;
    unsigned sum, cnt, mine, sp = 0u;
    for (;;) {
        sum = 0u; cnt = 0u; mine = 0u;
#pragma unroll
        for (unsigned j = 0; j < 16; ++j) { const unsigned c = xb_ld(&bar[XB_XCNT(j)]); sum += c; cnt += (c > 0u) ? 1u : 0u; mine = (j == x) ? c : mine; }
        if (sum == G) break;
        __builtin_amdgcn_s_sleep(1);
        if ((++sp & 255u) == 0u) { if (xb_ld(&bar[XB_TMO])) break; if (sp > XB_SPIN_CAP) { atomicAdd(&bar[XB_TMO], 1u); break; } }
    }
    nloc = mine > 0u ? mine : 1u; nx = cnt > 0u ? cnt : 1u;
}

__device__ __forceinline__ void xcd_barrier(const XcdBarrier& b) {
    asm volatile("s_waitcnt vmcnt(0)" ::: "memory");
    __syncthreads();
    if (threadIdx.x == 0) {
        unsigned* bar = b.bar;
        __builtin_amdgcn_s_waitcnt(0);
        asm volatile("buffer_inv sc1" ::: "memory");
        unsigned nloc = b.st[0], nx = b.st[1];
        if (nloc == 0u) { xcd_barrier_complete(bar, b.x, nloc, nx); b.st[0] = nloc; b.st[1] = nx; }
        const unsigned old = xb_add(&bar[XB_XSUB(b.x)], 1u);
        const unsigned gen = old / nloc;
        if (old + 1u == (gen + 1u) * nloc) {
            asm volatile("buffer_wbl2 sc1\n\ts_waitcnt vmcnt(0)" ::: "memory");
            const unsigned og = xb_add(&bar[XB_TOP], 1u);
            const unsigned tg = og / nx;
            if (og + 1u == (tg + 1u) * nx) {
#pragma unroll
                for (unsigned j = 0; j < 16; ++j) xb_add(&bar[XB_XGEN(j)], 1u);
            }
        }
        XB_SPIN(xb_ld(&bar[XB_XGEN(b.x)]) == gen, bar);
        asm volatile("s_waitcnt vmcnt(0)" ::: "memory");
    }
    __syncthreads();
}
#ifndef MK_CONV_P1_LAYERS
#define MK_CONV_P1_LAYERS 4
#endif
#ifndef MK_CONV_WGS
#define MK_CONV_WGS 144
#endif
constexpr int NWAVES = 8;
constexpr int RING_BYTES = 131072, MISC_OFF = RING_BYTES + 320, LDS_BYTES = 163840;
#define LDS_WAIT() asm volatile("s_waitcnt lgkmcnt(0)" ::: "memory")
#define VM_WAIT() asm volatile("s_waitcnt vmcnt(0)" ::: "memory")

struct Args { const float* in[19]; float* out; unsigned char* ws; int ph_lo, ph_hi, li, pad; };
enum { I_X = 0, I_C, I_WADA, I_BADA, I_NMIX, I_NMLP, I_WIN, I_GWG, I_GBG, I_GNORM, I_LBL, I_HNORM, I_MCONV, I_MGB, I_MNORM, I_WOUT, I_WFF1, I_WFF2, I_FNORM };

__device__ __forceinline__ void phase_p0(const Args& a, LAS unsigned char* lds, int tid) {
    LAS float* cond = (LAS float*)lds;
    LAS f32x4* red = (LAS f32x4*)(lds + 16384);
    const float* c = a.in[I_C];
    for (int i = tid; i < NB * D; i += NWAVES * 64) cond[i] = siluf_(c[i]);
    __syncthreads();
    float* mod = (float*)(a.ws + WS_MOD); const float* w_ada = a.in[I_WADA]; const float* b_ada = a.in[I_BADA];
    const int cg = tid & 31, ks = tid >> 5;
    for (int cb = blockIdx.x; cb < L * 48; cb += gridDim.x) {
        const int l = cb / 48, nb0 = (cb % 48) * 128, n0 = nb0 + 4 * cg;
        { const int k0 = ks * 64; const float* w = w_ada + ((size_t)l * D + k0) * (6 * D) + n0;
            f32x4 acc[4];
#pragma unroll
            for (int b = 0; b < 4; ++b) acc[b] = (f32x4){0.f, 0.f, 0.f, 0.f};
#pragma unroll 16
            for (int k = 0; k < 64; ++k) { const f32x4 wv = NT_LD((const f32x4*)(w + (size_t)k * (6 * D)));
#pragma unroll
                for (int b = 0; b < 4; ++b) acc[b] += cond[b * D + k0 + k] * wv; }
#pragma unroll
            for (int b = 0; b < 4; ++b) red[(ks * 4 + b) * 32 + cg] = acc[b]; }
        __syncthreads();
        if (tid < 128) { const int b = tid >> 5, g = tid & 31; f32x4 s = *(const f32x4*)(b_ada + l * 6 * D + nb0 + 4 * g);
#pragma unroll
            for (int q = 0; q < 16; ++q) s += red[(q * 4 + b) * 32 + g];
            *(f32x4*)(&mod[(size_t)(l * NB + b) * 6 * D + nb0 + 4 * g]) = s; }
        __syncthreads();
    }
    { float* wgf = (float*)(a.ws + WS_FOLD); const float* w_in = a.in[I_WIN]; const float* w_gate = a.in[I_GWG];
      for (int i = blockIdx.x * (NWAVES * 64) + tid; i < L * D * 192; i += gridDim.x * NWAVES * 64) { const int ch = i % 192, k = (i / 192) % D, l = i / (192 * D);
          const float* wr_ = w_in + ((size_t)l * D + k) * DIN + GLOW; const float* g = w_gate + (size_t)l * 16 * 192 + ch; float v = 0.f;
#pragma unroll
          for (int q = 0; q < 16; ++q) v += wr_[q] * g[q * 192];
          wgf[i] = v; } }
    if (blockIdx.x == 0 && tid < 384) {
        const float* logits = a.in[I_LBL]; float* lb = (float*)(a.ws + WS_LB);
        float v0 = logits[tid], v1 = logits[384 + tid], v2 = logits[768 + tid], v3 = logits[1152 + tid];
        const float mx = fmaxf(fmaxf(v0, v1), fmaxf(v2, v3));
        v0 = __expf(v0 - mx); v1 = __expf(v1 - mx); v2 = __expf(v2 - mx); v3 = __expf(v3 - mx);
        const float inv = 1.f / (v0 + v1 + v2 + v3);
        lb[tid] = 0.f; lb[384 + tid] = v1 * inv; lb[768 + tid] = (v1 + v2) * inv; lb[1152 + tid] = (v1 + v2 + v3) * inv;
    }
    __syncthreads();
}

__device__ __forceinline__ void conv_item(const Args& a, int it, int lane) {
    asm volatile("" : "+v"(lane));
    const int l = it / 416, r = it % 416;
    int kind, nb, kpart = 0;
    if (r < 128) { kind = 0; nb = r; } else if (r < 160) { kind = 1; nb = r - 128; } else if (r < 288) { kind = 2; nb = r - 160; } else { kind = 3; nb = (r - 288) >> 2; kpart = (r - 288) & 3; }
    const float* W; int N, K; bf16* WT; unsigned char* wl = a.ws + WS_W + (size_t)l * W_LAYER;
    if (kind == 0) { W = a.in[I_WIN] + (size_t)l * D * DIN; N = DIN; K = D; WT = (bf16*)(wl + W_IN); }
    else if (kind == 1) { W = a.in[I_WOUT] + (size_t)l * D * D; N = D; K = D; WT = (bf16*)(wl + W_OUT); }
    else if (kind == 2) { W = a.in[I_WFF1] + (size_t)l * D * DFF; N = DFF; K = D; WT = (bf16*)(wl + W_1); }
    else { W = a.in[I_WFF2] + (size_t)l * DFF * D; N = D; K = DFF; WT = (bf16*)(wl + W_2); }
    const int kg = lane >> 3, ng = lane & 7, n0 = nb * 32 + 4 * ng;
    const float* sp_ = W + n0; int pitch = N; float mul = 1.f;
    if (kind == 0) { const int code = in_src(n0);
        if (code >= 0) sp_ = W + code; else if (code == -1) { sp_ = W; mul = 0.f; } else { sp_ = (const float*)(a.ws + WS_FOLD) + (size_t)l * D * 192 + (-(code + 2)); pitch = 192; } }
    sp_ += (size_t)(kpart * 1024 + 8 * kg) * pitch;
    const bool want_bias = (kind == 0 || kind == 2);
    const float* shiftp = (const float*)(a.ws + WS_MOD) + (size_t)l * NB * 6 * D + (kind == 0 ? 0 : 3) * D + kpart * 1024 + 8 * kg;
    f32x4 ab[4];
#pragma unroll
    for (int b = 0; b < 4; ++b) ab[b] = (f32x4){0.f, 0.f, 0.f, 0.f};
    bf16* wt = WT + (size_t)n0 * K + kpart * 1024 + 8 * kg;
    f32x4 ring[4][8];
#pragma unroll
    for (int t = 0; t < 3; ++t)
#pragma unroll
        for (int i = 0; i < 8; ++i) ring[t][i] = NT_LD((const f32x4*)(sp_ + (size_t)(64 * t + i) * pitch));
#pragma unroll
    for (int kt = 0; kt < 16; ++kt) {
        if (kt + 3 < 16) {
#pragma unroll
            for (int i = 0; i < 8; ++i) ring[(kt + 3) & 3][i] = NT_LD((const f32x4*)(sp_ + (size_t)(64 * (kt + 3) + i) * pitch)); }
        f32x4 cur[8];
#pragma unroll
        for (int i = 0; i < 8; ++i) cur[i] = ring[kt & 3][i] * mul;
#pragma unroll
        for (int j = 0; j < 4; ++j) { v4u o; o.x = pk2(cur[0][j], cur[1][j]); o.y = pk2(cur[2][j], cur[3][j]); o.z = pk2(cur[4][j], cur[5][j]); o.w = pk2(cur[6][j], cur[7][j]);
            st16_wt(wt + (size_t)j * K + 64 * kt, o); }
        if (want_bias) {
#pragma unroll
            for (int b = 0; b < 4; ++b) { const f32x4 s0 = *(const f32x4*)(shiftp + b * 6 * D + 64 * kt), s1 = *(const f32x4*)(shiftp + b * 6 * D + 64 * kt + 4);
                ab[b] += (cur[0] * s0[0] + cur[1] * s0[1]) + (cur[2] * s0[2] + cur[3] * s0[3]) + (cur[4] * s1[0] + cur[5] * s1[1]) + (cur[6] * s1[2] + cur[7] * s1[3]); } }
    }
    if (want_bias) {
        float* bias = (float*)(a.ws + WS_BIAS) + (kind == 0 ? 0 : (size_t)L * NB * 4096) + (size_t)l * NB * 4096 + n0;
#pragma unroll
        for (int b = 0; b < 4; ++b) { f32x4 v = ab[b];
#pragma unroll
            for (int j = 0; j < 4; ++j) { v[j] += __shfl_xor(v[j], 8); v[j] += __shfl_xor(v[j], 16); v[j] += __shfl_xor(v[j], 32); }
            if (kg == 0) *(f32x4*)(bias + b * 4096) = v; }
    }
}
__device__ __forceinline__ void phase_p1(const Args& a, LAS unsigned char* lds, int tid, int lane, int wave) {
    const int G = gridDim.x, gw = blockIdx.x * NWAVES + wave, NGW = G * NWAVES;
    const float* mod = (const float*)(a.ws + WS_MOD);
    { float* gm = (float*)(a.ws + WS_GMUL);
      for (int i = blockIdx.x * (NWAVES * 64) + tid; i < L * 2 * NB * D; i += G * NWAVES * 64) { const int k = i & 1023, b = (i >> 10) & 3, w = (i >> 12) & 1, l = i >> 13;
          const float gain = (w ? a.in[I_NMLP] : a.in[I_NMIX])[l * D + k]; gm[i] = gain * (1.f + mod[(size_t)(l * NB + b) * 6 * D + (w ? 4 : 1) * D + k]); } }
    { const float* x = a.in[I_X]; bf16* xn = (bf16*)(a.ws + WS_XN); float* ssq = (float*)(a.ws + WS_SSQ); const float* nm = a.in[I_NMIX];
      for (int r0 = gw; r0 < S / 2; r0 += NGW)
        for (int b = 0; b < NB; ++b) { f32x4 gmv[4];
#pragma unroll
          for (int j = 0; j < 4; ++j) { const int k = 4 * lane + 256 * j; gmv[j] = *(const f32x4*)(nm + k) * (*(const f32x4*)(mod + (size_t)b * 6 * D + D + k) + 1.f); }
          const int rowA = b * S + r0, rowB = rowA + S / 2; f32x4 va[4], vb[4];
          const GAS f32x4* xa = (const GAS f32x4*)(x + (size_t)rowA * D) + lane; const GAS f32x4* xb_ = (const GAS f32x4*)(x + (size_t)rowB * D) + lane;
#pragma unroll
          for (int j = 0; j < 4; ++j) { va[j] = NT_LD((const f32x4*)(xa + 64 * j)); vb[j] = NT_LD((const f32x4*)(xb_ + 64 * j)); }
          float sa = 0.f, sb = 0.f; GAS unsigned long long* oa = (GAS unsigned long long*)(xn + (size_t)rowA * D) + lane; GAS unsigned long long* ob = (GAS unsigned long long*)(xn + (size_t)rowB * D) + lane;
#pragma unroll
          for (int j = 0; j < 4; ++j) { sa += (va[j][0] * va[j][0] + va[j][1] * va[j][1]) + (va[j][2] * va[j][2] + va[j][3] * va[j][3]); sb += (vb[j][0] * vb[j][0] + vb[j][1] * vb[j][1]) + (vb[j][2] * vb[j][2] + vb[j][3] * vb[j][3]);
              const f32x4 pa = va[j] * gmv[j], pb = vb[j] * gmv[j];
              oa[64 * j] = (unsigned long long)pk2(pa[0], pa[1]) | ((unsigned long long)pk2(pa[2], pa[3]) << 32); ob[64 * j] = (unsigned long long)pk2(pb[0], pb[1]) | ((unsigned long long)pk2(pb[2], pb[3]) << 32); }
          sa = wave_sum(sa); sb = wave_sum(sb);
          if (lane < 16) { ssq[(size_t)rowA * 16 + lane] = (lane == 0) ? sa : 0.f; ssq[(size_t)rowB * 16 + lane] = (lane == 0) ? sb : 0.f; } } }
    for (int it = gw; it < MK_CONV_P1_LAYERS * 416; it += NGW) conv_item(a, it, lane);
}
__device__ __forceinline__ void conv_phase(const Args& a, int lane, int wave, int layer) {
    const int gwr = (gridDim.x - 1 - blockIdx.x) * NWAVES + wave;
    for (int it = gwr; it < 416; it += MK_CONV_WGS * NWAVES) { if (gwr < MK_CONV_WGS * NWAVES) conv_item(a, layer * 416 + it, lane); }
}
__device__ __forceinline__ void phase_final(const Args& a, int lane, int wave) {
    const int gw = blockIdx.x * NWAVES + wave, NGW = gridDim.x * NWAVES; const float* fn = a.in[I_FNORM]; const bf16* xb = (const bf16*)(a.ws + WS_XB);
    f32x4 g[4];
#pragma unroll
    for (int j = 0; j < 4; ++j) g[j] = *(const f32x4*)(fn + 16 * lane + 4 * j);
    for (int r0 = gw; r0 < M / 4; r0 += NGW) { v4u ra[4], rb[4];
#pragma unroll
        for (int q = 0; q < 4; ++q) { const v4u* xr = (const v4u*)(xb + (size_t)(r0 + q * (M / 4)) * D + 16 * lane); ra[q] = xr[0]; rb[q] = xr[1]; }
#pragma unroll
        for (int q = 0; q < 4; ++q) { float v[16]; const unsigned w[8] = {ra[q].x, ra[q].y, ra[q].z, ra[q].w, rb[q].x, rb[q].y, rb[q].z, rb[q].w}; float s = 0.f;
#pragma unroll
            for (int j = 0; j < 8; ++j) { v[2 * j] = __builtin_bit_cast(float, w[j] << 16); v[2 * j + 1] = __builtin_bit_cast(float, w[j] & 0xffff0000u); s += v[2 * j] * v[2 * j] + v[2 * j + 1] * v[2 * j + 1]; }
            const float rs = rsqrtf(wave_sum(s) * (1.f / D) + EPS); f32x4* o = (f32x4*)(a.out + (size_t)(r0 + q * (M / 4)) * D + 16 * lane);
#pragma unroll
            for (int j = 0; j < 4; ++j) o[j] = (f32x4){v[4 * j] * rs * g[j][0], v[4 * j + 1] * rs * g[j][1], v[4 * j + 2] * rs * g[j][2], v[4 * j + 3] * rs * g[j][3]}; } }
}
typedef short v4i16_t __attribute__((ext_vector_type(4)));
typedef short s16x4 __attribute__((ext_vector_type(4)));
#define MFMA32(a, b, c) __builtin_amdgcn_mfma_f32_32x32x16_bf16((a), (b), (c), 0, 0, 0)
__device__ __forceinline__ s16x4 tr16(LAS const unsigned char* p) { return __builtin_bit_cast(s16x4, __builtin_amdgcn_ds_read_tr16_b64_v4i16((LAS v4i16_t*)p)); }
__device__ __forceinline__ bf16x8 cat8(s16x4 a, s16x4 b) { return __builtin_shufflevector(a, b, 0, 1, 2, 3, 4, 5, 6, 7); }
__device__ __forceinline__ unsigned cvtpk(float lo, float hi) { typedef __bf16 bf16x2_t __attribute__((ext_vector_type(2))); typedef float f32x2_t __attribute__((ext_vector_type(2))); f32x2_t v = {lo, hi}; return __builtin_bit_cast(unsigned, __builtin_convertvector(v, bf16x2_t)); }
__device__ __forceinline__ bf16x8 pack8(const f32x16& x, int s) { v4u p; p.x = cvtpk(x[8 * s], x[8 * s + 1]); p.y = cvtpk(x[8 * s + 2], x[8 * s + 3]); p.z = cvtpk(x[8 * s + 4], x[8 * s + 5]); p.w = cvtpk(x[8 * s + 6], x[8 * s + 7]); return __builtin_bit_cast(bf16x8, p); }
__device__ __forceinline__ float fexp_(float x) { return __builtin_amdgcn_exp2f(x * 1.4426950408889634f); }
__device__ __forceinline__ float fsig_(float x) { return __builtin_amdgcn_rcpf(1.f + fexp_(-x)); }
constexpr size_t U_BN = 208 * 1024, SP_BN = 104 * 1024;
__device__ __forceinline__ int u_off(int head) { return head < 6 ? head * 8192 : head < 12 ? 49152 + (head - 6) * 16384 : 147456 + (head - 12) * 16384; }
template <int NB16> __device__ __forceinline__ void stage_img(LAS unsigned char* img, const bf16* src, int lane) {
    constexpr int RPI = 64 / NB16;
#pragma unroll
    for (int i = 0; i < 64 / RPI; ++i) { const int row = i * RPI + lane / NB16, ch = lane % NB16; const v4u v = *(const v4u*)(src + (size_t)row * 4096 + ch * 8); *(LAS v4u*)(img + row * (NB16 * 16) + ch * 16) = v; }
}
template <int KCH> __device__ __forceinline__ void ktv(f32x16 (&U)[KCH / 32][2], LAS const unsigned char* kimg, LAS const unsigned char* vimg, int lane) {
    const int h = lane >> 5, g16 = (lane >> 4) & 1, q = (lane & 15) >> 2, p = lane & 3;
#pragma unroll
    for (int cb = 0; cb < KCH / 32; ++cb)
#pragma unroll
        for (int vb = 0; vb < 2; ++vb)
#pragma unroll
            for (int r = 0; r < 16; ++r) U[cb][vb][r] = 0.f;
#pragma unroll
    for (int s = 0; s < 4; ++s) { const int t0 = 16 * s + 8 * h + q; bf16x8 A[KCH / 32], B[2];
#pragma unroll
        for (int cb = 0; cb < KCH / 32; ++cb) A[cb] = cat8(tr16(kimg + t0 * (KCH * 2) + (32 * cb + 16 * g16 + 4 * p) * 2), tr16(kimg + (t0 + 4) * (KCH * 2) + (32 * cb + 16 * g16 + 4 * p) * 2));
#pragma unroll
        for (int vb = 0; vb < 2; ++vb) B[vb] = cat8(tr16(vimg + t0 * 128 + (32 * vb + 16 * g16 + 4 * p) * 2), tr16(vimg + (t0 + 4) * 128 + (32 * vb + 16 * g16 + 4 * p) * 2));
#pragma unroll
        for (int cb = 0; cb < KCH / 32; ++cb)
#pragma unroll
            for (int vb = 0; vb < 2; ++vb) U[cb][vb] = MFMA32(A[cb], B[vb], U[cb][vb]); }
}
template <int KCH> __device__ __forceinline__ void store_ut(const f32x16 (&U)[KCH / 32][2], float* UT, const float* el, int lane) {
    const int h = lane >> 5, r32 = lane & 31;
#pragma unroll
    for (int cb = 0; cb < KCH / 32; ++cb)
#pragma unroll
        for (int vb = 0; vb < 2; ++vb)
#pragma unroll
            for (int g = 0; g < 4; ++g) { const int c0 = 32 * cb + 8 * g + 4 * h; f32x4 o = {U[cb][vb][4 * g], U[cb][vb][4 * g + 1], U[cb][vb][4 * g + 2], U[cb][vb][4 * g + 3]};
                if (el) o = o * *(const f32x4*)(el + c0);
                *(f32x4*)(UT + (size_t)(32 * vb + r32) * KCH + c0) = o; }
}
template <int KCH> __device__ __forceinline__ void mix_c1_gh(const Args& a, LAS unsigned char* wl, int lane, int b, int n, int head) {
    asm volatile("" : "+v"(lane));
    const size_t row0 = (size_t)b * S + n * 64; const bf16* Zt = (const bf16*)(a.ws + WS_Z) + row0 * 4096 + head * 256;
    LAS unsigned char* kimg = wl; LAS unsigned char* vimg = wl + 8192;
    stage_img<KCH / 8>(kimg, Zt + KCH, lane); stage_img<8>(vimg, Zt + 128, lane);
    LDS_WAIT(); asm volatile("" ::: "memory");
    f32x16 U[KCH / 32][2]; ktv<KCH>(U, kimg, vimg, lane);
    const float* vp = (const float*)(a.ws + WS_VEC) + ((size_t)(b * 64 + n) * 16 + head) * 192;
    store_ut<KCH>(U, (float*)(a.ws + WS_U + (size_t)(b * 64 + n) * U_BN + u_off(head)), vp + 64, lane);
    LDS_WAIT(); asm volatile("" ::: "memory");
}
template <int CPR> __device__ __forceinline__ int imgoff(int row, int ch) { return row * (CPR * 16) + ((ch ^ ((row >> (CPR == 8 ? 1 : 2)) & (CPR - 1))) << 4); }
template <int KCH> __device__ __forceinline__ void mix_c3_gh(const Args& a, LAS unsigned char* wl, int lane, int b, int n, int head, int l) {
    asm volatile("" : "+v"(lane));
    const size_t row0 = (size_t)b * S + n * 64; const bf16* Zt = (const bf16*)(a.ws + WS_Z) + row0 * 4096 + head * 256;
    LAS unsigned char* bufA = wl; LAS unsigned char* bufB = wl + 8192;
    const int h = lane >> 5, r32 = lane & 31, g16 = (lane >> 4) & 1, q = (lane & 15) >> 2, p = lane & 3;
    constexpr int NS = KCH / 16, CPR = KCH / 8, RPI = 64 / CPR, NI = 64 / RPI;
    const int srow = lane / CPR, sch = lane % CPR, vrow = lane >> 3, vch = lane & 7; const unsigned char* zb = (const unsigned char*)Zt;
    const unsigned loff = (unsigned)(vrow * 8192 + vch * 16), soff = (unsigned)(srow * 8192 + sch * 16);
    const bf16* SpT = (const bf16*)(a.ws + WS_XN + (size_t)(b * 64 + n) * SP_BN + u_off(head) / 2);
    v4u rq[NI], rk[NI], rs[NI], rv[8], rg[8];
#pragma unroll
    for (int i = 0; i < NI; ++i) { rq[i] = *(const v4u*)(zb + (size_t)i * (RPI * 8192) + soff); rk[i] = *(const v4u*)(zb + (size_t)i * (RPI * 8192) + KCH * 2 + soff); }
#pragma unroll
    for (int i = 0; i < 8; ++i) rv[i] = *(const v4u*)(zb + (size_t)i * 65536 + 256 + loff);
#pragma unroll
    for (int i = 0; i < NI; ++i) rs[i] = *(const v4u*)((const unsigned char*)SpT + i * 1024 + (unsigned)(lane * 16));
#pragma unroll
    for (int i = 0; i < 8; ++i) rg[i] = *(const v4u*)(zb + (size_t)i * 65536 + 384 + loff);
#pragma unroll
    for (int i = 0; i < NI; ++i) { *(LAS v4u*)(bufA + imgoff<CPR>(i * RPI + srow, sch)) = rq[i]; *(LAS v4u*)(bufB + imgoff<CPR>(i * RPI + srow, sch)) = rk[i]; }
    bf16x8 Qf[2][NS], Kf[2][NS], Sf[2][NS];
#pragma unroll
    for (int ib = 0; ib < 2; ++ib)
#pragma unroll
        for (int s = 0; s < NS; ++s) { Qf[ib][s] = *(LAS const bf16x8*)(bufA + imgoff<CPR>(32 * ib + r32, 2 * s + h)); Kf[ib][s] = *(LAS const bf16x8*)(bufB + imgoff<CPR>(32 * ib + r32, 2 * s + h)); }
    LDS_WAIT(); asm volatile("" ::: "memory");
#pragma unroll
    for (int i = 0; i < 8; ++i) *(LAS v4u*)(bufA + (i * 8 + vrow) * 128 + vch * 16) = rv[i];
#pragma unroll
    for (int i = 0; i < NI; ++i) *(LAS v4u*)(bufB + imgoff<CPR>(i * RPI + srow, sch)) = rs[i];
    f32x16 X00, X01, X11;
#pragma unroll
    for (int r = 0; r < 16; ++r) { X00[r] = 0.f; X01[r] = 0.f; X11[r] = 0.f; }
#pragma unroll
    for (int s = 0; s < NS; ++s) { X00 = MFMA32(Kf[0][s], Qf[0][s], X00); X01 = MFMA32(Kf[0][s], Qf[1][s], X01); X11 = MFMA32(Kf[1][s], Qf[1][s], X11); }
#pragma unroll
    for (int r = 0; r < 16; ++r) { const int jl = (r & 3) + 8 * (r >> 2) + 4 * h; if (jl > r32) { X00[r] = 0.f; X11[r] = 0.f; } }
    bf16x8 P00[2], P01[2], P11[2];
#pragma unroll
    for (int s2 = 0; s2 < 2; ++s2) { P00[s2] = pack8(X00, s2); P01[s2] = pack8(X01, s2); P11[s2] = pack8(X11, s2); }
#pragma unroll
    for (int vb = 0; vb < 2; ++vb)
#pragma unroll
        for (int s = 0; s < NS; ++s) Sf[vb][s] = *(LAS const bf16x8*)(bufB + imgoff<CPR>(32 * vb + r32, 2 * s + h));
    LDS_WAIT(); asm volatile("" ::: "memory");
#pragma unroll
    for (int i = 0; i < 8; ++i) *(LAS v4u*)(bufB + imgoff<8>(i * 8 + vrow, vch)) = rg[i];
    f32x16 O[2][2];
#pragma unroll
    for (int vb = 0; vb < 2; ++vb)
#pragma unroll
        for (int ib = 0; ib < 2; ++ib)
#pragma unroll
            for (int r = 0; r < 16; ++r) O[vb][ib][r] = 0.f;
    LDS_WAIT(); asm volatile("" ::: "memory");
#pragma unroll
    for (int vb = 0; vb < 2; ++vb)
#pragma unroll
        for (int jb = 0; jb < 2; ++jb)
#pragma unroll
            for (int s2 = 0; s2 < 2; ++s2) { const int t0 = 32 * jb + 16 * s2 + 4 * h + q; LAS const unsigned char* cp = bufA + (32 * vb + 16 * g16 + 4 * p) * 2;
                const bf16x8 A = cat8(tr16(cp + t0 * 128), tr16(cp + (t0 + 8) * 128));
                if (jb == 0) { O[vb][0] = MFMA32(A, P00[s2], O[vb][0]); O[vb][1] = MFMA32(A, P01[s2], O[vb][1]); } else O[vb][1] = MFMA32(A, P11[s2], O[vb][1]); }
#pragma unroll
    for (int vb = 0; vb < 2; ++vb)
#pragma unroll
        for (int s = 0; s < NS; ++s) { O[vb][0] = MFMA32(Sf[vb][s], Qf[0][s], O[vb][0]); O[vb][1] = MFMA32(Sf[vb][s], Qf[1][s], O[vb][1]); }
    const float* gain = (head < 6 ? a.in[I_GNORM] : a.in[I_HNORM]) + l * 64; bf16* mixed = (bf16*)(a.ws + WS_MIX);
    LDS_WAIT(); asm volatile("" ::: "memory");
#pragma unroll
    for (int ib = 0; ib < 2; ++ib) { float ms = 0.f;
#pragma unroll
        for (int vb = 0; vb < 2; ++vb)
#pragma unroll
            for (int r = 0; r < 16; ++r) ms += O[vb][ib][r] * O[vb][ib][r];
        ms += __shfl_xor(ms, 32); const float rn = rsqrtf(ms * (1.f / 64.f) + EPS); const int trow = 32 * ib + r32;
#pragma unroll
        for (int vb = 0; vb < 2; ++vb)
#pragma unroll
            for (int g = 0; g < 4; ++g) { const int vc0 = 32 * vb + 8 * g + 4 * h; const f32x4 gn = *(const f32x4*)(gain + vc0); const v2u gw = *(LAS const v2u*)(bufB + imgoff<8>(trow, 4 * vb + g) + 8 * h);
                const float o0 = O[vb][ib][4 * g] * rn * gn[0] * bf2f((unsigned short)(gw.x & 0xffffu)), o1 = O[vb][ib][4 * g + 1] * rn * gn[1] * bf2f((unsigned short)(gw.x >> 16));
                const float o2 = O[vb][ib][4 * g + 2] * rn * gn[2] * bf2f((unsigned short)(gw.y & 0xffffu)), o3 = O[vb][ib][4 * g + 3] * rn * gn[3] * bf2f((unsigned short)(gw.y >> 16));
                v2u w; w.x = cvtpk(o0, o1); w.y = cvtpk(o2, o3); *(LAS v2u*)(bufA + imgoff<8>(trow, 4 * vb + g) + 8 * h) = w; } }
    LDS_WAIT(); asm volatile("" ::: "memory");
#pragma unroll
    for (int i = 0; i < 8; ++i) { const v4u o = *(LAS const v4u*)(bufA + imgoff<8>(i * 8 + vrow, vch)); *(v4u*)((unsigned char*)(mixed + row0 * D + head * 64) + i * 16384 + (unsigned)(vrow * 2048 + vch * 16)) = o; }
    LDS_WAIT(); asm volatile("" ::: "memory");
}
__device__ __forceinline__ float wave_scan_add(float x, int lane) {
#pragma unroll
    for (int d = 1; d < 64; d <<= 1) { const float t = __shfl_up(x, d); if (lane >= d) x += t; }
    return x;
}
__device__ __forceinline__ float wave_scan_max(float x, int lane) {
#pragma unroll
    for (int d = 1; d < 64; d <<= 1) { const float t = __shfl_up(x, d); if (lane >= d) x = fmaxf(x, t); }
    return x;
}
__device__ __forceinline__ float wave_max(float v) {
#pragma unroll
    for (int o = 1; o < 64; o <<= 1) v = fmaxf(v, __shfl_xor(v, o));
    return v;
}
struct ConvW { f32x4 w[4][2]; };
__device__ __forceinline__ void load_convw(ConvW& cw, const float* p) {
#pragma unroll
    for (int tap = 0; tap < 4; ++tap) { cw.w[tap][0] = *(const f32x4*)(p + tap * 512); cw.w[tap][1] = *(const f32x4*)(p + tap * 512 + 4); }
}
__device__ __forceinline__ void conv8(float (&y)[8], const bf16* zsrc, int t, int tglob, int d0, const ConvW& cw) {
#pragma unroll
    for (int j = 0; j < 8; ++j) y[j] = 0.f;
#pragma unroll
    for (int tap = 0; tap < 4; ++tap) { const f32x4 w0 = cw.w[tap][0], w1 = cw.w[tap][1];
        const bool ok = tglob - 3 + tap >= 0; const int rr = ok ? t - 3 + tap : 0;
        v4u rv = *(const v4u*)(zsrc + (long)rr * 4096 + d0); rv.x = ok ? rv.x : 0u; rv.y = ok ? rv.y : 0u; rv.z = ok ? rv.z : 0u; rv.w = ok ? rv.w : 0u;
        y[0] += w0[0] * bf2f((unsigned short)(rv.x & 0xffffu)); y[1] += w0[1] * bf2f((unsigned short)(rv.x >> 16)); y[2] += w0[2] * bf2f((unsigned short)(rv.y & 0xffffu)); y[3] += w0[3] * bf2f((unsigned short)(rv.y >> 16));
        y[4] += w1[0] * bf2f((unsigned short)(rv.z & 0xffffu)); y[5] += w1[1] * bf2f((unsigned short)(rv.z >> 16)); y[6] += w1[2] * bf2f((unsigned short)(rv.w & 0xffffu)); y[7] += w1[3] * bf2f((unsigned short)(rv.w >> 16)); }
#pragma unroll
    for (int j = 0; j < 8; ++j) y[j] = y[j] * fsig_(y[j]);
}
__device__ __forceinline__ bf16x8 pk8f(const float (&y)[8], float sc) { v4u p; p.x = cvtpk(y[0] * sc, y[1] * sc); p.y = cvtpk(y[2] * sc, y[3] * sc); p.z = cvtpk(y[4] * sc, y[5] * sc); p.w = cvtpk(y[6] * sc, y[7] * sc); return __builtin_bit_cast(bf16x8, p); }
template <bool LO> __device__ __forceinline__ void conv8_lds(float (&y)[8], LAS const unsigned char* img, LAS const unsigned char* halo, int t, int ch, const ConvW& cw) {
#pragma unroll
    for (int j = 0; j < 8; ++j) y[j] = 0.f;
#pragma unroll
    for (int tap = 0; tap < 4; ++tap) { const f32x4 w0 = cw.w[tap][0], w1 = cw.w[tap][1];
        const int rr = t - 3 + tap; int off = imgoff<8>(rr < 0 ? 0 : rr, ch); LAS const unsigned char* base = img;
        if (LO && tap < 3) { const bool neg = rr < 0; off = neg ? (rr + 3) * 128 + ch * 16 : off; base = neg ? halo : img; }
        const v4u rv = *(LAS const v4u*)(base + off);
        y[0] += w0[0] * bf2f((unsigned short)(rv.x & 0xffffu)); y[1] += w0[1] * bf2f((unsigned short)(rv.x >> 16)); y[2] += w0[2] * bf2f((unsigned short)(rv.y & 0xffffu)); y[3] += w0[3] * bf2f((unsigned short)(rv.y >> 16));
        y[4] += w1[0] * bf2f((unsigned short)(rv.z & 0xffffu)); y[5] += w1[1] * bf2f((unsigned short)(rv.z >> 16)); y[6] += w1[2] * bf2f((unsigned short)(rv.w & 0xffffu)); y[7] += w1[3] * bf2f((unsigned short)(rv.w >> 16)); }
#pragma unroll
    for (int j = 0; j < 8; ++j) y[j] = y[j] * fsig_(y[j]);
}
__device__ __forceinline__ void mix_c1_m(const Args& a, LAS unsigned char* wl, LAS unsigned char* halo, int lane, int b, int n, int mh, int l) {
    asm volatile("" : "+v"(lane));
    const size_t row0 = (size_t)b * S + n * 64; const bf16* Zt = (const bf16*)(a.ws + WS_Z) + row0 * 4096 + (12 + mh) * 256;
    LAS unsigned char* kimg = wl; LAS unsigned char* vimg = wl + 8192;
    const int vrow = lane >> 3, vch = lane & 7; const unsigned char* zb = (const unsigned char*)Zt; const unsigned loff = (unsigned)(vrow * 8192 + vch * 16);
    v4u rk[8], rv[8], rh;
#pragma unroll
    for (int i = 0; i < 8; ++i) rk[i] = *(const v4u*)(zb + (size_t)i * 65536 + 128 + loff);
    { const int hl = lane < 24 ? lane : 0, rr = hl >> 3; const bool ok = n > 0;
      rh = *(const v4u*)(zb - (ok ? 3 * 8192 : 0) + (unsigned)(rr * 8192 + 128 + vch * 16)); rh.x = ok ? rh.x : 0u; rh.y = ok ? rh.y : 0u; rh.z = ok ? rh.z : 0u; rh.w = ok ? rh.w : 0u; }
#pragma unroll
    for (int i = 0; i < 8; ++i) rv[i] = *(const v4u*)(zb + (size_t)i * 65536 + 256 + loff);
    const float* mgp = (const float*)(a.ws + WS_MG) + (row0 + lane) * 8; const float* gb = a.in[I_MGB] + l * 8;
    const float li = mgp[mh] + gb[mh]; const float xf = mgp[4 + mh] + gb[4 + mh]; const float lf = fminf(xf, 0.f) - __logf(1.f + fexp_(-fabsf(xf)));
#pragma unroll
    for (int i = 0; i < 8; ++i) *(LAS v4u*)(vimg + imgoff<8>(i * 8 + vrow, vch)) = rk[i];
    if (lane < 24) *(LAS v4u*)(halo + lane * 16) = rh;
    const float bc = wave_scan_add(lf, lane), av = li - bc, amax = wave_max(av), blast = __shfl(bc, 63);
    const float pst = fexp_(av - amax) * 0.125f;
    const int h = lane >> 5, r32 = lane & 31; const float* cwk = a.in[I_MCONV] + (size_t)l * 2048 + 256 + mh * 64;
    LDS_WAIT(); asm volatile("" ::: "memory");
    { const float sc0 = __shfl(pst, r32), sc1 = __shfl(pst, r32 + 32);
#pragma unroll
      for (int s = 0; s < 4; ++s) { const int d0 = 16 * s + 8 * h; ConvW cw; load_convw(cw, cwk + d0); float y[8];
          conv8_lds<true>(y, vimg, halo, r32, 2 * s + h, cw); *(LAS bf16x8*)(kimg + r32 * 128 + d0 * 2) = pk8f(y, sc0);
          conv8_lds<false>(y, vimg, halo, r32 + 32, 2 * s + h, cw); *(LAS bf16x8*)(kimg + (r32 + 32) * 128 + d0 * 2) = pk8f(y, sc1);
          asm volatile("" ::: "memory"); } }
    LDS_WAIT(); asm volatile("" ::: "memory");
#pragma unroll
    for (int i = 0; i < 8; ++i) *(LAS v4u*)(vimg + (i * 8 + vrow) * 128 + vch * 16) = rv[i];
    LDS_WAIT(); asm volatile("" ::: "memory");
    f32x16 U[2][2]; ktv<64>(U, kimg, vimg, lane);
    store_ut<64>(U, (float*)(a.ws + WS_U + (size_t)(b * 64 + n) * U_BN + u_off(12 + mh)), nullptr, lane);
    float* vp = (float*)(a.ws + WS_VEC) + ((size_t)(b * 64 + n) * 16 + 12 + mh) * 192;
    float nu = 0.f;
#pragma unroll 8
    for (int t = 0; t < 64; ++t) nu += bf2f(*(LAS const unsigned short*)(kimg + t * 128 + lane * 2));
    vp[64 + lane] = nu; if (lane == 0) { vp[0] = amax; vp[1] = blast; }
    LDS_WAIT(); asm volatile("" ::: "memory");
}
__device__ __forceinline__ void mix_c3_m(const Args& a, LAS unsigned char* wl, LAS unsigned char* halo, int lane, int b, int n, int mh, int l) {
    asm volatile("" : "+v"(lane));
    const size_t row0 = (size_t)b * S + n * 64; const bf16* Zt = (const bf16*)(a.ws + WS_Z) + row0 * 4096 + (12 + mh) * 256;
    LAS unsigned char* bufA = wl; LAS unsigned char* bufB = wl + 8192;
    const float* vp = (const float*)(a.ws + WS_VEC) + ((size_t)(b * 64 + n) * 16 + 12 + mh) * 192;
    const int vrow = lane >> 3, vch = lane & 7; const unsigned char* zb = (const unsigned char*)Zt; const unsigned loff = (unsigned)(vrow * 8192 + vch * 16);
    const bf16* CpT = (const bf16*)(a.ws + WS_XN + (size_t)(b * 64 + n) * SP_BN + u_off(12 + mh) / 2);
    v4u rq[8], rk[8], rv[8], rc[8], rh;
#pragma unroll
    for (int i = 0; i < 8; ++i) { rq[i] = *(const v4u*)(zb + (size_t)i * 65536 + loff); rk[i] = *(const v4u*)(zb + (size_t)i * 65536 + 128 + loff); }
    { const int hl = lane < 48 ? lane : 0, qk = hl / 24, rr = (hl % 24) >> 3; const bool ok = n > 0;
      rh = *(const v4u*)(zb - (ok ? 3 * 8192 : 0) + (unsigned)(rr * 8192 + qk * 128 + vch * 16)); rh.x = ok ? rh.x : 0u; rh.y = ok ? rh.y : 0u; rh.z = ok ? rh.z : 0u; rh.w = ok ? rh.w : 0u; }
#pragma unroll
    for (int i = 0; i < 8; ++i) rv[i] = *(const v4u*)(zb + (size_t)i * 65536 + 256 + loff);
#pragma unroll
    for (int i = 0; i < 8; ++i) rc[i] = *(const v4u*)((const unsigned char*)CpT + i * 1024 + (unsigned)(lane * 16));
    const float* mgp = (const float*)(a.ws + WS_MG) + (row0 + lane) * 8; const float* gb = a.in[I_MGB] + l * 8;
    const float li = mgp[mh] + gb[mh]; const float xf = mgp[4 + mh] + gb[4 + mh]; const float lf = fminf(xf, 0.f) - __logf(1.f + fexp_(-fabsf(xf)));
    const float mprev = vp[2];
#pragma unroll
    for (int i = 0; i < 8; ++i) { *(LAS v4u*)(bufA + imgoff<8>(i * 8 + vrow, vch)) = rq[i]; *(LAS v4u*)(bufB + imgoff<8>(i * 8 + vrow, vch)) = rk[i]; }
    if (lane < 48) *(LAS v4u*)(halo + lane * 16) = rh;
    const float bc = wave_scan_add(lf, lane), av = li - bc, amax = wave_max(av);
    const float Mi = fmaxf(mprev, wave_scan_max(av, lane)); const float pst = fexp_(av - amax) * 0.125f;
    const int h = lane >> 5, r32 = lane & 31, g16 = (lane >> 4) & 1, q = (lane & 15) >> 2, p = lane & 3;
    const float* cwq = a.in[I_MCONV] + (size_t)l * 2048 + mh * 64; const float* cwk = cwq + 256;
    bf16x8 Qf[2][4], Kf[2][4];
    LDS_WAIT(); asm volatile("" ::: "memory");
    { const float sc0 = __shfl(pst, r32), sc1 = __shfl(pst, r32 + 32);
#pragma unroll
      for (int s = 0; s < 4; ++s) { const int d0 = 16 * s + 8 * h; ConvW cw; float y[8];
          load_convw(cw, cwq + d0);
          conv8_lds<true>(y, bufA, halo, r32, 2 * s + h, cw); Qf[0][s] = pk8f(y, 1.f); conv8_lds<false>(y, bufA, halo, r32 + 32, 2 * s + h, cw); Qf[1][s] = pk8f(y, 1.f);
          asm volatile("" ::: "memory");
          load_convw(cw, cwk + d0);
          conv8_lds<true>(y, bufB, halo + 384, r32, 2 * s + h, cw); Kf[0][s] = pk8f(y, sc0); conv8_lds<false>(y, bufB, halo + 384, r32 + 32, 2 * s + h, cw); Kf[1][s] = pk8f(y, sc1);
          asm volatile("" ::: "memory"); } }
    LDS_WAIT(); asm volatile("" ::: "memory");
#pragma unroll
    for (int i = 0; i < 8; ++i) { *(LAS v4u*)(bufA + (i * 8 + vrow) * 128 + vch * 16) = rv[i]; *(LAS v4u*)(bufB + imgoff<8>(i * 8 + vrow, vch)) = rc[i]; }
    f32x16 X00, X01, X11;
#pragma unroll
    for (int r = 0; r < 16; ++r) { X00[r] = 0.f; X01[r] = 0.f; X11[r] = 0.f; }
#pragma unroll
    for (int s = 0; s < 4; ++s) { X00 = MFMA32(Kf[0][s], Qf[0][s], X00); X01 = MFMA32(Kf[0][s], Qf[1][s], X01); X11 = MFMA32(Kf[1][s], Qf[1][s], X11); }
    asm volatile("" ::: "memory");
    v4u rg[8];
#pragma unroll
    for (int i = 0; i < 8; ++i) rg[i] = *(const v4u*)(zb + (size_t)i * 65536 + 384 + loff);
    float Mc[2], bi[2], si[2], den[2];
#pragma unroll
    for (int ib = 0; ib < 2; ++ib) { Mc[ib] = __shfl(Mi, r32 + 32 * ib); bi[ib] = __shfl(bc, r32 + 32 * ib); si[ib] = fexp_(mprev - Mc[ib]); }
    { const float f0 = fexp_(amax - Mc[0]), f1 = fexp_(amax - Mc[1]); float d0 = 0.f, d1 = 0.f;
#pragma unroll
      for (int r = 0; r < 16; ++r) { const int jl = (r & 3) + 8 * (r >> 2) + 4 * h; const bool keep = jl <= r32;
          X00[r] = keep ? X00[r] * f0 : 0.f; X01[r] = X01[r] * f1; X11[r] = keep ? X11[r] * f1 : 0.f; d0 += X00[r]; d1 += X01[r] + X11[r]; }
      den[0] = d0 + __shfl_xor(d0, 32); den[1] = d1 + __shfl_xor(d1, 32); }
    bf16x8 P00[2], P01[2], P11[2];
#pragma unroll
    for (int s2 = 0; s2 < 2; ++s2) { P00[s2] = pack8(X00, s2); P01[s2] = pack8(X01, s2); P11[s2] = pack8(X11, s2); }
    f32x16 O[2][2];
#pragma unroll
    for (int vb = 0; vb < 2; ++vb)
#pragma unroll
        for (int ib = 0; ib < 2; ++ib)
#pragma unroll
            for (int r = 0; r < 16; ++r) O[vb][ib][r] = 0.f;
#pragma unroll
    for (int vb = 0; vb < 2; ++vb)
#pragma unroll
        for (int s = 0; s < 4; ++s) { const bf16x8 Cf = *(LAS const bf16x8*)(bufB + imgoff<8>(32 * vb + r32, 2 * s + h)); O[vb][0] = MFMA32(Cf, Qf[0][s], O[vb][0]); O[vb][1] = MFMA32(Cf, Qf[1][s], O[vb][1]); }
    { float qn0 = 0.f, qn1 = 0.f;
#pragma unroll
      for (int s = 0; s < 4; ++s) { const f32x4 n0 = *(const f32x4*)(vp + 128 + 16 * s + 8 * h), n1 = *(const f32x4*)(vp + 128 + 16 * s + 8 * h + 4);
#pragma unroll
          for (int j = 0; j < 4; ++j) { qn0 += bf2f((unsigned short)Qf[0][s][j]) * n0[j] + bf2f((unsigned short)Qf[0][s][4 + j]) * n1[j]; qn1 += bf2f((unsigned short)Qf[1][s][j]) * n0[j] + bf2f((unsigned short)Qf[1][s][4 + j]) * n1[j]; } }
      qn0 += __shfl_xor(qn0, 32); qn1 += __shfl_xor(qn1, 32); den[0] += si[0] * qn0; den[1] += si[1] * qn1; }
#pragma unroll
    for (int vb = 0; vb < 2; ++vb)
#pragma unroll
        for (int ib = 0; ib < 2; ++ib)
#pragma unroll
            for (int r = 0; r < 16; ++r) O[vb][ib][r] *= si[ib];
    LDS_WAIT(); asm volatile("" ::: "memory");
#pragma unroll
    for (int i = 0; i < 8; ++i) *(LAS v4u*)(bufB + imgoff<8>(i * 8 + vrow, vch)) = rg[i];
#pragma unroll
    for (int vb = 0; vb < 2; ++vb)
#pragma unroll
        for (int jb = 0; jb < 2; ++jb)
#pragma unroll
            for (int s2 = 0; s2 < 2; ++s2) { const int t0 = 32 * jb + 16 * s2 + 4 * h + q; LAS const unsigned char* cp = bufA + (32 * vb + 16 * g16 + 4 * p) * 2;
                const bf16x8 A = cat8(tr16(cp + t0 * 128), tr16(cp + (t0 + 8) * 128));
                if (jb == 0) { O[vb][0] = MFMA32(A, P00[s2], O[vb][0]); O[vb][1] = MFMA32(A, P01[s2], O[vb][1]); } else O[vb][1] = MFMA32(A, P11[s2], O[vb][1]); }
    const float* gain = a.in[I_MNORM] + l * 256 + mh * 64; bf16* mixed = (bf16*)(a.ws + WS_MIX);
    LDS_WAIT(); asm volatile("" ::: "memory");
#pragma unroll
    for (int ib = 0; ib < 2; ++ib) { const float inv = 1.f / fmaxf(fabsf(den[ib]), fexp_(-(bi[ib] + Mc[ib]))); float sm = 0.f;
#pragma unroll
        for (int vb = 0; vb < 2; ++vb)
#pragma unroll
            for (int r = 0; r < 16; ++r) { O[vb][ib][r] *= inv; sm += O[vb][ib][r]; }
        sm += __shfl_xor(sm, 32); const float mu = sm * (1.f / 64.f); float sv = 0.f;
#pragma unroll
        for (int vb = 0; vb < 2; ++vb)
#pragma unroll
            for (int r = 0; r < 16; ++r) { const float dlt = O[vb][ib][r] - mu; sv += dlt * dlt; }
        sv += __shfl_xor(sv, 32); const float rn = rsqrtf(sv * (1.f / 64.f) + EPS); const int trow = 32 * ib + r32;
#pragma unroll
        for (int vb = 0; vb < 2; ++vb)
#pragma unroll
            for (int g = 0; g < 4; ++g) { const int vc0 = 32 * vb + 8 * g + 4 * h; const f32x4 gn = *(const f32x4*)(gain + vc0); const v2u gw = *(LAS const v2u*)(bufB + imgoff<8>(trow, 4 * vb + g) + 8 * h);
                const float o0 = (O[vb][ib][4 * g] - mu) * rn * gn[0] * bf2f((unsigned short)(gw.x & 0xffffu)), o1 = (O[vb][ib][4 * g + 1] - mu) * rn * gn[1] * bf2f((unsigned short)(gw.x >> 16));
                const float o2 = (O[vb][ib][4 * g + 2] - mu) * rn * gn[2] * bf2f((unsigned short)(gw.y & 0xffffu)), o3 = (O[vb][ib][4 * g + 3] - mu) * rn * gn[3] * bf2f((unsigned short)(gw.y >> 16));
                v2u w; w.x = cvtpk(o0, o1); w.y = cvtpk(o2, o3); *(LAS v2u*)(bufA + imgoff<8>(trow, 4 * vb + g) + 8 * h) = w; } }
    LDS_WAIT(); asm volatile("" ::: "memory");
#pragma unroll
    for (int i = 0; i < 8; ++i) { const v4u o = *(LAS const v4u*)(bufA + imgoff<8>(i * 8 + vrow, vch)); *(v4u*)((unsigned char*)(mixed + row0 * D + (12 + mh) * 64) + i * 16384 + (unsigned)(vrow * 2048 + vch * 16)) = o; }
    LDS_WAIT(); asm volatile("" ::: "memory");
}
__device__ __forceinline__ void phase_c1(const Args& a, LAS unsigned char* lds, int lane, int wave, int l) {
    LAS unsigned char* wl = lds + wave * 16384; const int gw = blockIdx.x * NWAVES + wave, NGW = gridDim.x * NWAVES;
    for (int id = gw, k = 0; id < NB * 64 * 16; id += NGW, ++k) { const int bn = id >> 4, head = (id + 8 * k) & 15, b = bn >> 6, n = bn & 63;
        if (head < 6) mix_c1_gh<32>(a, wl, lane, b, n, head); else if (head < 12) mix_c1_gh<64>(a, wl, lane, b, n, head); else mix_c1_m(a, wl, lds + RING_BYTES + 1024 + wave * 1024, lane, b, n, head - 12, l); }
}
__device__ __forceinline__ void phase_c3(const Args& a, LAS unsigned char* lds, int lane, int wave, int l, int vblk, int nblk, int nitems) {
    LAS unsigned char* wl = lds + wave * 16384; const int gw = vblk * NWAVES + wave, NGW = nblk * NWAVES;
    for (int id = gw, k = 0; id < nitems; id += NGW, ++k) { const int bn = id >> 4, head = (id + 8 * k) & 15, b = bn >> 6, n = bn & 63;
        if (head < 6) mix_c3_gh<32>(a, wl, lane, b, n, head, l); else if (head < 12) mix_c3_gh<64>(a, wl, lane, b, n, head, l); else mix_c3_m(a, wl, lds + RING_BYTES + 1024 + wave * 1024, lane, b, n, head - 12, l); }
}
typedef float f32x2s __attribute__((ext_vector_type(2)));
__device__ __forceinline__ void phase_c2(const Args& a, int tid) {
    constexpr int TPB = 6 * 1024 + 6 * 2048 + 4 * 2080;
    const unsigned char* ws = a.ws; float* vecb = (float*)(a.ws + WS_VEC);
    for (int task = blockIdx.x * (NWAVES * 64) + tid; task < NB * TPB; task += gridDim.x * NWAVES * 64) {
        const int b = task / TPB; int r = task % TPB; int head, qi;
        if (r < 6144) { head = r >> 10; qi = r & 1023; } else if (r < 18432) { head = 6 + ((r - 6144) >> 11); qi = (r - 6144) & 2047; } else { head = 12 + (r - 18432) / 2080; qi = (r - 18432) % 2080; }
        const int uo = u_off(head);
        if (head < 12) { const int KCH = head < 6 ? 32 : 64; const int c0 = (qi * 2) % KCH; f32x2s st = (f32x2s){0.f, 0.f};
            for (int n0 = 0; n0 < 64; n0 += 16) { f32x2s er[16], ed[16], uu[16];
#pragma unroll
                for (int i = 0; i < 16; ++i) { const size_t bn = (size_t)(b * 64 + n0 + i); const float* vp = vecb + (bn * 16 + head) * 192;
                    er[i] = *(const f32x2s*)(vp + c0); ed[i] = *(const f32x2s*)(vp + 128 + c0); uu[i] = *(const f32x2s*)(ws + WS_U + bn * U_BN + uo + (size_t)qi * 8); }
#pragma unroll
                for (int i = 0; i < 16; ++i) { const size_t bn = (size_t)(b * 64 + n0 + i); const f32x2s sp = st * er[i];
                    *(unsigned*)(a.ws + WS_XN + bn * SP_BN + uo / 2 + (size_t)qi * 4) = cvtpk(sp[0], sp[1]); st = ed[i] * st + uu[i]; } }
        } else { f32x2s st = (f32x2s){0.f, 0.f}; float m = 0.f; const bool isvec = qi >= 2048; const int dq = qi - 2048;
            for (int n0 = 0; n0 < 64; n0 += 16) { f32x2s uu[16]; float am[16], bl[16];
#pragma unroll
                for (int i = 0; i < 16; ++i) { const size_t bn = (size_t)(b * 64 + n0 + i); const float* vp = vecb + (bn * 16 + head) * 192; am[i] = vp[0]; bl[i] = vp[1];
                    uu[i] = isvec ? *(const f32x2s*)(vp + 64 + 2 * dq) : *(const f32x2s*)(ws + WS_U + bn * U_BN + uo + (size_t)qi * 8); }
#pragma unroll
                for (int i = 0; i < 16; ++i) { const size_t bn = (size_t)(b * 64 + n0 + i); float* vp = vecb + (bn * 16 + head) * 192;
                    const float mnew = fmaxf(bl[i] + m, bl[i] + am[i]), so = fexp_(bl[i] + m - mnew), sl = fexp_(bl[i] + am[i] - mnew);
                    if (!isvec) *(unsigned*)(a.ws + WS_XN + bn * SP_BN + uo / 2 + (size_t)qi * 4) = cvtpk(st[0], st[1]);
                    else { *(f32x2s*)(vp + 128 + 2 * dq) = st; if (dq == 0) vp[2] = m; }
                    st = st * so + uu[i] * sl; m = mnew; } }
        }
    }
}
constexpr int NPL = 7;
constexpr int NPRE = 2;
constexpr int NPH = NPRE + NPL * L + 1;
#ifndef MK_REP_MASK
#define MK_REP_MASK 0
#endif
#ifndef MK_REP_N
#define MK_REP_N 1
#endif
#ifndef MK_STAGGER_US
#define MK_STAGGER_US 0
#endif
#ifndef MK_DRY_NOEPI
#define MK_DRY_NOEPI 0
#endif
#ifndef MK_HALF
#define MK_HALF 0
#endif
#ifndef MK_FF2_AUX_A
#define MK_FF2_AUX_A 0
#endif
#ifndef MK_NULL_BARRIERS
#define MK_NULL_BARRIERS 0
#endif
#ifndef MK_ONE_LAUNCH
#define MK_ONE_LAUNCH 1
#endif
__global__ void __launch_bounds__(NWAVES * 64, 2) mk_fwd(Args kargs) {
    extern __shared__ __attribute__((aligned(16))) unsigned char lds_raw[];
    LAS unsigned char* lds = (LAS unsigned char*)lds_raw;
    volatile LAS unsigned* MISC = (volatile LAS unsigned*)(lds + MISC_OFF);
    const int tid0 = threadIdx.x;
    const int wave0 = __builtin_amdgcn_readfirstlane(tid0 >> 6);
    for (int u = tid0; u < (LDS_BYTES - RING_BYTES) / 4; u += NWAVES * 64) ((LAS unsigned*)(lds + RING_BYTES))[u] = 0u;
    __syncthreads();
    const int ph_lo = kargs.ph_lo, ph_hi = kargs.ph_hi, rep_mask = kargs.pad;
    unsigned* ctl = (unsigned*)(kargs.ws + WS_CTL);
    XcdBarrier bar; bar.bar = ctl + 4096; bar.x = 0; bar.st = nullptr;
    if (ph_hi - ph_lo > 1) bar = xcd_barrier_post(ctl + 4096, MISC + 8);
    for (int p = ph_lo; p < ph_hi; ++p) {
        const int kind = p < NPRE ? 1 + p : (p == NPH - 1 ? 10 : 3 + (p - NPRE) % NPL);
        const int reps = ((rep_mask >> kind) & 1) ? 2 : 1;
      for (int rr = 0; rr < reps; ++rr) {
#if defined(__HIP_DEVICE_COMPILE__)
        const __attribute__((address_space(4))) Args* kap = (const __attribute__((address_space(4))) Args*)__builtin_amdgcn_kernarg_segment_ptr(); asm volatile("" : "+s"(kap));
        const Args args = *(const Args*)kap;
#else
        const Args args = kargs;
#endif
        unsigned char* ws = args.ws;
        const bool dry = rr > 0;
        int wave = wave0; asm volatile("" : "+s"(wave));
        int lane; asm volatile("v_mbcnt_lo_u32_b32 %0, -1, 0\n\tv_mbcnt_hi_u32_b32 %0, -1, %0" : "=v"(lane)); const int tid = wave * 64 + lane;
        if (p == 0) phase_p0(args, lds, tid);
        else if (p == 1) phase_p1(args, lds, tid, lane, wave);
        else if (p == NPH - 1) { if (!dry) phase_final(args, lane, wave); }
        else {
            const int l = (p - NPRE) / NPL, j = (p - NPRE) % NPL;
            unsigned char* wl = ws + WS_W + (size_t)l * W_LAYER;
            const float* mod_l = (const float*)(ws + WS_MOD) + (size_t)l * NB * 6 * D;
            float* ssq = (float*)(ws + WS_SSQ);
            bf16* xdst = dry ? (bf16*)(ws + WS_U) : (bf16*)(ws + WS_XB); bf16* xndst = dry ? (bf16*)(ws + WS_U) : (bf16*)(ws + WS_XN); float* ssqdst = dry ? (float*)(ws + WS_U + 48 * MiB) : ssq;
            if (j == 0) {
                pg8::Gemm g{(const bf16*)(ws + WS_XN), (const bf16*)(wl + W_IN), M, NIN, D}; pg8::StaticOrder S; S.init(M, NIN, gridDim.x, (int)blockIdx.x);
                LAS float* rt = (LAS float*)(lds + RING_BYTES + 1024); LAS float* bt = (LAS float*)(lds + RING_BYTES + 1024 + 12288); pg8::fill_rstd(rt, ssq, S, tid); pg8::fill_bias(bt, (const float*)(ws + WS_BIAS) + (size_t)l * NB * 4096, S, tid);
                pg8::EpiIn E{(dry && MK_DRY_NOEPI) ? nullptr : (bf16*)(ws + WS_Z), (float*)(ws + WS_VEC), (float*)(ws + WS_MG), bt, rt, (const float*)(ws + WS_LB) + l * 384, args.in[I_GBG] + l * 192};
                pg8::gemm_phase<pg8::EpiIn, pg8::StaticOrder, true, true>(lds, g, S, E, wave);
            } else if (j == 1) { phase_c1(args, lds, lane, wave, l);
            } else if (j == 2) { if (l + 1 < L && l + 1 >= MK_CONV_P1_LAYERS && !dry) conv_phase(args, lane, wave, l + 1); phase_c2(args, tid);
            } else if (j == 3) { if (dry && MK_HALF) { if (((blockIdx.x >> 3) & 1) == 0) phase_c3(args, lds, lane, wave, l, ((blockIdx.x >> 4) << 3) | (blockIdx.x & 7), gridDim.x / 2, NB * 64 * 16 / 2); } else phase_c3(args, lds, lane, wave, l, blockIdx.x, gridDim.x, NB * 64 * 16);
            } else if (j == 4) {
                pg8::Gemm g{(const bf16*)(ws + WS_MIX), (const bf16*)(wl + W_OUT), M, D, D}; pg8::StaticOrder S; S.init(M, D, gridDim.x, (int)blockIdx.x);
                pg8::EpiRes E{l == 0 ? args.in[I_X] : nullptr, (const bf16*)(ws + WS_XB), dry ? (bf16*)(ws + WS_Z) : (bf16*)(ws + WS_XB), mod_l + 2 * D, (const float*)(ws + WS_GMUL) + (size_t)(l * 2 + 1) * NB * D, dry ? (bf16*)(ws + WS_Z + 64 * MiB) : (bf16*)(ws + WS_XN), dry ? (float*)(ws + WS_Z + 96 * MiB) : ssq};
                pg8::gemm_phase<pg8::EpiRes, pg8::StaticOrder, true, true>(lds, g, S, E, wave);
            } else if (j == 5) {
                pg8::Gemm g{(const bf16*)(ws + WS_XN), (const bf16*)(wl + W_1), M, DFF, D}; pg8::StaticOrder S; S.init(M, DFF, gridDim.x, (int)blockIdx.x);
                if (dry && MK_HALF) { const int grp = (blockIdx.x >> 3) & 1, vb = ((blockIdx.x >> 4) << 3) | (blockIdx.x & 7); S.init(M / 2, DFF, gridDim.x / 2, grp == 0 ? vb : (1 << 20)); }
                LAS float* rt = (LAS float*)(lds + RING_BYTES + 1024); LAS float* bt = (LAS float*)(lds + RING_BYTES + 1024 + 12288); pg8::fill_rstd(rt, ssq, S, tid); pg8::fill_bias(bt, (const float*)(ws + WS_BIAS) + (size_t)(L + l) * NB * 4096, S, tid);
                pg8::EpiFF1 E{(dry && MK_DRY_NOEPI) ? nullptr : (bf16*)(ws + WS_Z), bt, rt};
                if (MK_STAGGER_US > 0 && (blockIdx.x & 8)) { const unsigned long long t0 = __builtin_amdgcn_s_memrealtime(); while (__builtin_amdgcn_s_memrealtime() - t0 < (unsigned long long)(MK_STAGGER_US * 100)) __builtin_amdgcn_s_sleep(32); }
                pg8::gemm_phase<pg8::EpiFF1, pg8::StaticOrder, true, true>(lds, g, S, E, wave);
            } else {
                pg8::Gemm g{(const bf16*)(ws + WS_Z), (const bf16*)(wl + W_2), M, D, DFF}; pg8::StaticOrder S; S.init(M, D, gridDim.x, (int)blockIdx.x);
                pg8::EpiRes E{nullptr, (const bf16*)(ws + WS_XB), xdst, mod_l + 5 * D, l + 1 < L ? (const float*)(ws + WS_GMUL) + (size_t)((l + 1) * 2) * NB * D : nullptr, xndst, ssqdst};
                pg8::gemm_phase<pg8::EpiRes, pg8::StaticOrder, true, true, MK_FF2_AUX_A>(lds, g, S, E, wave);
            }
        }
        if (p + 1 < ph_hi || rr + 1 < reps) xcd_barrier(bar);
#if MK_NULL_BARRIERS > 0
        if (kind == 8) { for (int nb = 0; nb < MK_NULL_BARRIERS; ++nb) xcd_barrier(bar); }
#endif
      }
    }
}

extern "C" void kernel_launch(void* const* d_in, const int* in_sizes, int n_in, void* d_out, int out_size, void* d_ws, size_t ws_size, hipStream_t stream) {
    static int grid = 0;
    if (grid == 0) {
        if (n_in != 19 || out_size != M * D || ws_size < WS_END) { fprintf(stderr, "kernel_launch: unexpected shapes (n_in %d out %d ws %zu)\n", n_in, out_size, ws_size); grid = -1; return; }
        int dev = 0, cus = 0, per_cu = 0;
        if (hipGetDevice(&dev) != hipSuccess || hipDeviceGetAttribute(&cus, hipDeviceAttributeMultiprocessorCount, dev) != hipSuccess) { grid = -1; return; }
        if (hipFuncSetAttribute((const void*)mk_fwd, hipFuncAttributeMaxDynamicSharedMemorySize, LDS_BYTES) != hipSuccess) { fprintf(stderr, "kernel_launch: hipFuncSetAttribute failed\n"); grid = -1; return; }
        if (hipOccupancyMaxActiveBlocksPerMultiprocessor(&per_cu, (const void*)mk_fwd, NWAVES * 64, LDS_BYTES) != hipSuccess || per_cu < 1) { fprintf(stderr, "kernel_launch: occupancy query says %d blocks/CU\n", per_cu); grid = -1; (void)hipGetLastError(); return; }
        grid = cus;
    }
    if (grid < 0) return;
    (void)hipMemsetAsync((char*)d_ws + WS_CTL, 0, CTL_ZERO_BYTES, stream);
    Args a{};
    for (int i = 0; i < 19; ++i) a.in[i] = (const float*)d_in[i];
    a.out = (float*)d_out; a.ws = (unsigned char*)d_ws; a.pad = MK_REP_MASK;
#if MK_ONE_LAUNCH
    a.ph_lo = 0; a.ph_hi = NPH; a.li = 0;
    hipLaunchKernelGGL(mk_fwd, dim3(grid), dim3(NWAVES * 64), LDS_BYTES, stream, a);
#else
    for (int p = 0; p < NPH; ++p) { a.ph_lo = p; a.ph_hi = p + 1; a.li = 0; hipLaunchKernelGGL(mk_fwd, dim3(grid), dim3(NWAVES * 64), LDS_BYTES, stream, a); }
#endif
}
```

```cpp
#include <hip/hip_runtime.h>
#include <cstdint>
#include <cstdio>

#ifndef MK_KLOOP_ALIGN
#define MK_KLOOP_ALIGN 6
#endif
#ifndef MK_KLOOP_PAD
#define MK_KLOOP_PAD 8
#endif
#ifndef MK_SEG_ALIGN
#define MK_SEG_ALIGN 0
#endif
#ifndef MK_NT_LOADS
#define MK_NT_LOADS 1
#endif
#ifndef MK_WT_STORES
#define MK_WT_STORES 1
#endif
namespace cfg {
constexpr int D = 1024, NB = 4, S = 4096, L = 4, M = NB * S, DIN = 3736, DFF = 4096, NIN = 4096  ;
constexpr int GQ = 0, GK = 192, GV = 384, GLOW = 768, GOUT = 784, HQ = 1168, HF = 1552, HI = 1936, HOUT = 2320,
              MQK = 2704, MV = 3216, MI = 3472, MF = 3476, MOUT = 3480;
constexpr float EPS = 1e-6f;
constexpr size_t MiB = 1u << 20;
constexpr size_t WS_CTL = 0, CTL_ZERO_BYTES = 64 * 1024;
constexpr size_t WS_MOD = 256 * 1024;
constexpr size_t WS_LB = 1 * MiB;
constexpr size_t WS_GMUL = 1 * MiB + 64 * 1024;
constexpr size_t WS_BIAS = 2 * MiB;
constexpr size_t WS_MG = 3 * MiB;
constexpr size_t WS_SSQ = 4 * MiB;
constexpr size_t WS_FOLD = 356 * MiB;
constexpr size_t WS_VEC = 5 * MiB;
constexpr size_t WS_W = 8 * MiB, W_LAYER = 26 * MiB;
constexpr size_t W_IN = 0, W_OUT = 8 * MiB, W_1 = 10 * MiB, W_2 = 18 * MiB;
constexpr size_t WS_XN = 112 * MiB;
constexpr size_t WS_XB = 144 * MiB;
constexpr size_t WS_MIX = 304 * MiB;
constexpr size_t WS_Z = 176 * MiB;
constexpr size_t WS_U = 304 * MiB;
constexpr size_t WS_END = 360 * MiB;
}
using namespace cfg;

#define GAS __attribute__((address_space(1)))
#define LAS __attribute__((address_space(3)))
typedef unsigned short bf16;
typedef unsigned v4u __attribute__((ext_vector_type(4)));
typedef unsigned v2u __attribute__((ext_vector_type(2)));
typedef float f32x4 __attribute__((ext_vector_type(4)));
typedef float f32x16 __attribute__((ext_vector_type(16)));
typedef short bf16x8 __attribute__((ext_vector_type(8)));
typedef GAS unsigned gu32;
#define RLX_AGENT __ATOMIC_RELAXED, __HIP_MEMORY_SCOPE_AGENT

__device__ __forceinline__ void st16_wt(void* p, v4u v) {
#if MK_WT_STORES
    asm volatile("global_store_dwordx4 %0, %1, off sc1\n\ts_nop 1" :: "v"(p), "v"(v) : "memory");
#else
    *(v4u*)p = v;
#endif
}
__device__ __forceinline__ void st16_wtnt(void* p, v4u v) {
#if MK_WT_STORES
    asm volatile("global_store_dwordx4 %0, %1, off sc1 nt\n\ts_nop 1" :: "v"(p), "v"(v) : "memory");
#else
    *(v4u*)p = v;
#endif
}
__device__ __forceinline__ void st8_wt(void* p, v2u v) {
#if MK_WT_STORES
    *(v2u*)p = v;
#else
    *(v2u*)p = v;
#endif
}
#if MK_NT_LOADS
#define NT_LD(p) __builtin_nontemporal_load(p)
#else
#define NT_LD(p) (*(p))
#endif
__device__ __forceinline__ unsigned f2bf(float f) { unsigned u = __builtin_bit_cast(unsigned, f); return (u + 0x7fffu + ((u >> 16) & 1u)) >> 16; }
__device__ __forceinline__ unsigned pk2(float lo, float hi) { return f2bf(lo) | (f2bf(hi) << 16); }
__device__ __forceinline__ float bf2f(unsigned short h) { return __builtin_bit_cast(float, (unsigned)h << 16); }
__device__ __forceinline__ float sigmoidf_(float x) { return 1.f / (1.f + __expf(-x)); }
__device__ __forceinline__ float siluf_(float x) { return x * sigmoidf_(x); }
__device__ __forceinline__ float logsigmoidf_(float x) { return fminf(x, 0.f) - log1pf(__expf(-fabsf(x))); }
__device__ __forceinline__ float wave_sum(float v) {
#pragma unroll
    for (int o = 1; o < 64; o <<= 1) v += __shfl_xor(v, o);
    return v;
}
__host__ __device__ __forceinline__ int in_src(int np) {
    const int pn = np >> 8, tc = np & 255, bj = tc >> 7, wc = (tc >> 5) & 3, n = (tc >> 4) & 1, g = tc & 15;
    if (pn < 6) { const int gh = pn;
        if (wc < 2) { const int c = 16 * wc + g;
            if (bj == 0) return (n == 0 ? GQ : GK) + gh * 32 + c;
            if (n == 0) return -2 - (gh * 32 + c);
            if (gh == 0 && wc == 0 && g < 8) return (g < 4) ? MI + g : MF + (g - 4);
            return -1; }
        const int e = 32 * (wc - 2) + 16 * n + g; return (bj == 0 ? GV : GOUT) + gh * 64 + e; }
    if (pn < 12) { const int hh = pn - 6, c = 16 * wc + g; const int base = bj == 0 ? (n == 0 ? HQ : HF) : (n == 0 ? HI : HOUT); return base + hh * 64 + c; }
    const int mh = pn - 12, grp = tc >> 6, c = tc & 63;
    return (grp == 0 ? MQK : grp == 1 ? MQK + 256 : grp == 2 ? MV : MOUT) + mh * 64 + c;
}
namespace pg8 {
#define PG8_LAS __attribute__((address_space(3)))
typedef unsigned short bf16_t;
typedef short bf16x8 __attribute__((ext_vector_type(8)));
typedef float f32x4 __attribute__((ext_vector_type(4)));
typedef unsigned u32x4 __attribute__((ext_vector_type(4)));
constexpr int BM = 256, BK = 64, HALF = 128, HTB = HALF * BK * 2  , STAGE_BYTES = 8 * HTB, NXCD = 8, WGM = 8;

__host__ __device__ __forceinline__ int lds_byte(int r, int c) { const int st = (r >> 4) * 2 + (c >> 5), rr = r & 15, cc = c & 31, ob = rr * 64 + cc * 2; return st * 1024 + (ob ^ (((ob >> 9) & 1) << 5)); }
__host__ __device__ __forceinline__ void stage_rc(int b, int& R, int& C) { const int st = b / 1024, sb = b % 1024, swz = sb ^ (((sb >> 9) & 1) << 5); R = (st >> 1) * 16 + swz / 64; C = (st & 1) * 32 + (swz % 64) / 2; }
__host__ __device__ __forceinline__ int perm32(int rho) { const int n = rho >> 4, i = rho & 15; return 8 * (i >> 2) + 4 * n + (i & 3); }

struct Unit { int pm, pn, ui; };
struct Gemm { const bf16_t* A; const bf16_t* Bt; int M, N, K; int ld = 0  ; int nt_probe = 0; int a_same_probe = 0; };

struct StaticOrder {
    int nM, nN, nwg, G, c;
    __host__ __device__ void init(int M, int N, int G_, int c_) { nM = M / BM; nN = N / BM; nwg = nM * nN; G = G_; c = c_; }
    __host__ __device__ bool next(int i, Unit& u) const {
        const long L = (long)i * G + c; if (L >= nwg) return false;
        int wgid = (int)L; { const int q = nwg / NXCD, r = nwg % NXCD, xcd = wgid % NXCD, off = wgid / NXCD; wgid = (xcd < r ? xcd * (q + 1) : r * (q + 1) + (xcd - r) * q) + off; }
        const int nig = WGM * nN, gid = wgid / nig, fm = gid * WGM, gsz = (nM - fm) < WGM ? (nM - fm) : WGM;
        u.pm = fm + ((wgid % nig) % gsz); u.pn = (wgid % nig) / gsz; u.ui = i; return true;
    }
    __device__ __forceinline__ void a_ready(const Unit&) const {}
    __device__ __forceinline__ void done(const Unit&) const {}
};

typedef float f32x2 __attribute__((ext_vector_type(2)));
typedef unsigned u32x2 __attribute__((ext_vector_type(2)));
__device__ __forceinline__ unsigned cvt_pk_bf16(float lo, float hi) { typedef __bf16 bf16x2_t __attribute__((ext_vector_type(2))); f32x2 v = {lo, hi}; bf16x2_t b = __builtin_convertvector(v, bf16x2_t); return __builtin_bit_cast(unsigned, b); }
__device__ __forceinline__ float row_rstd(const float* ssq, int row, int fq) {
    const f32x4 p = *(const f32x4*)(ssq + (size_t)row * 16 + 4 * fq); float s = (p[0] + p[1]) + (p[2] + p[3]);
    s += __shfl_xor(s, 16); s += __shfl_xor(s, 32);
    return rsqrtf(s * (1.0f / 1024.0f) + 1e-6f);
}
__device__ __forceinline__ void fill_rstd(PG8_LAS float* rt, const float* ssq, const StaticOrder& S, int tid) {
    for (int ui = tid >> 8; ui < 12; ui += 2) { Unit u;
        if (S.next(ui, u)) { const f32x4* p = (const f32x4*)(ssq + (size_t)(u.pm * BM + (tid & 255)) * 16); const f32x4 a = p[0], b = p[1], c = p[2], d = p[3];
            const float s = (((a[0] + a[1]) + (a[2] + a[3])) + ((b[0] + b[1]) + (b[2] + b[3]))) + (((c[0] + c[1]) + (c[2] + c[3])) + ((d[0] + d[1]) + (d[2] + d[3])));
            rt[ui * 256 + (tid & 255)] = rsqrtf(s * (1.0f / 1024.0f) + 1e-6f); } }
}
__device__ __forceinline__ void fill_bias(PG8_LAS float* bt, const float* bias  , const StaticOrder& S, int tid) {
    for (int ui = tid >> 8; ui < 12; ui += 2) { Unit u; if (S.next(ui, u)) bt[ui * 256 + (tid & 255)] = bias[(u.pm >> 4) * 4096 + u.pn * BM + (tid & 255)]; }
}
struct EpiRes {
    static constexpr bool PERM = true, AFTER_DRAIN = false;
    const float* xin32  ; const bf16_t* xin; bf16_t* xout; const float* gate  ; const float* gmul  ; bf16_t* xn; float* ssq;
    __device__ __forceinline__ void operator()(const f32x4 (&acc)[2][2][4][2], const Unit& u, int wr, int wc, int fr, int fq) const {
        const int b = u.pm >> 4, col0 = u.pn * BM + wc * 32 + 8 * fq; const int row0 = u.pm * BM + wr * 64 + fr;
        const unsigned eb = (unsigned)row0 * 1024u + (unsigned)col0;
        const char* xi32 = (const char*)xin32; const char* xi = (const char*)xin; char* xo_ = (char*)xout; char* xn_ = (char*)xn; const bool has_gm = gmul != nullptr, in32 = xin32 != nullptr;
        float s[2][4];
#pragma unroll
        for (int ai = 0; ai < 2; ++ai)
#pragma unroll
            for (int m = 0; m < 4; ++m) s[ai][m] = 0.f;
#pragma unroll
        for (int bj = 0; bj < 2; ++bj) { const unsigned c = (unsigned)(col0 + bj * HALF);
            const f32x4 gv0 = *(const f32x4*)((const char*)gate + (((unsigned)b * 6144u + c) << 2)), gv1 = *(const f32x4*)((const char*)gate + (((unsigned)b * 6144u + c + 4u) << 2));
            f32x4 gm0 = (f32x4){0.f, 0.f, 0.f, 0.f}, gm1 = gm0; if (has_gm) { gm0 = *(const f32x4*)((const char*)gmul + (((unsigned)b * 1024u + c) << 2)); gm1 = *(const f32x4*)((const char*)gmul + (((unsigned)b * 1024u + c + 4u) << 2)); }
#pragma unroll
            for (int ai = 0; ai < 2; ++ai) {
#pragma unroll
                for (int m = 0; m < 4; ++m) { const unsigned e = eb + (unsigned)((ai * HALF + m * 16) * 1024 + bj * HALF);
                    f32x4 xa, xb;
                    if (in32) { xa = *(const f32x4*)(xi32 + (e << 2)); xb = *(const f32x4*)(xi32 + (e << 2) + 16); }
                    else { const u32x4 r = *(const u32x4*)(xi + (e << 1)); xa = (f32x4){__builtin_bit_cast(float, r.x << 16), __builtin_bit_cast(float, r.x & 0xffff0000u), __builtin_bit_cast(float, r.y << 16), __builtin_bit_cast(float, r.y & 0xffff0000u)};
                        xb = (f32x4){__builtin_bit_cast(float, r.z << 16), __builtin_bit_cast(float, r.z & 0xffff0000u), __builtin_bit_cast(float, r.w << 16), __builtin_bit_cast(float, r.w & 0xffff0000u)}; }
                    const f32x4 wa = xa + gv0 * acc[ai][bj][m][0], wb = xb + gv1 * acc[ai][bj][m][1];
                    u32x4 xw; xw.x = cvt_pk_bf16(wa[0], wa[1]); xw.y = cvt_pk_bf16(wa[2], wa[3]); xw.z = cvt_pk_bf16(wb[0], wb[1]); xw.w = cvt_pk_bf16(wb[2], wb[3]);
                    *(u32x4*)(xo_ + (e << 1)) = xw;
                    const float r0 = __builtin_bit_cast(float, xw.x << 16), r1 = __builtin_bit_cast(float, xw.x & 0xffff0000u), r2 = __builtin_bit_cast(float, xw.y << 16), r3 = __builtin_bit_cast(float, xw.y & 0xffff0000u);
                    const float r4 = __builtin_bit_cast(float, xw.z << 16), r5 = __builtin_bit_cast(float, xw.z & 0xffff0000u), r6 = __builtin_bit_cast(float, xw.w << 16), r7 = __builtin_bit_cast(float, xw.w & 0xffff0000u);
                    s[ai][m] += ((r0 * r0 + r1 * r1) + (r2 * r2 + r3 * r3)) + ((r4 * r4 + r5 * r5) + (r6 * r6 + r7 * r7));
                    if (has_gm) { u32x4 w; w.x = cvt_pk_bf16(r0 * gm0[0], r1 * gm0[1]); w.y = cvt_pk_bf16(r2 * gm0[2], r3 * gm0[3]); w.z = cvt_pk_bf16(r4 * gm1[0], r5 * gm1[1]); w.w = cvt_pk_bf16(r6 * gm1[2], r7 * gm1[3]); *(u32x4*)(xn_ + (e << 1)) = w; } }
                asm volatile("" ::: "memory"); } }
#pragma unroll
        for (int ai = 0; ai < 2; ++ai)
#pragma unroll
            for (int m = 0; m < 4; ++m) { float t = s[ai][m]; t += __shfl_xor(t, 16); t += __shfl_xor(t, 32);
                if (fq == 0) *(float*)((char*)ssq + ((((unsigned)(row0 + ai * HALF + m * 16)) * 16u + (unsigned)(u.pn * 4 + wc)) << 2)) = t; }
    }
};
struct EpiFF1 {
    static constexpr bool PERM = true, AFTER_DRAIN = false;
    bf16_t* O; PG8_LAS const float* bt; PG8_LAS const float* rt;
    __device__ __forceinline__ void operator()(const f32x4 (&acc)[2][2][4][2], const Unit& u, int wr, int wc, int fr, int fq) const {
        if (!O) return;
        const int col0 = u.pn * BM + wc * 32 + 8 * fq;
        f32x4 bv[2][2];
#pragma unroll
        for (int bj = 0; bj < 2; ++bj)
#pragma unroll
            for (int n = 0; n < 2; ++n) bv[bj][n] = *(PG8_LAS const f32x4*)(bt + u.ui * 256 + wc * 32 + 8 * fq + bj * HALF + 4 * n);
#pragma unroll
        for (int ai = 0; ai < 2; ++ai)
#pragma unroll
            for (int m = 0; m < 4; ++m) { const int row = u.pm * BM + ai * HALF + wr * 64 + m * 16 + fr; const float rs = rt[u.ui * 256 + ai * HALF + wr * 64 + m * 16 + fr]; bf16_t* rowp = O + (size_t)row * 4096 + col0;
#pragma unroll
                for (int bj = 0; bj < 2; ++bj) { f32x4 v0 = acc[ai][bj][m][0] * rs + bv[bj][0], v1 = acc[ai][bj][m][1] * rs + bv[bj][1];
#pragma unroll
                    for (int j = 0; j < 4; ++j) { const float a = fmaxf(v0[j], 0.f), c = fmaxf(v1[j], 0.f); v0[j] = a * a; v1[j] = c * c; }
                    u32x4 w; w.x = cvt_pk_bf16(v0[0], v0[1]); w.y = cvt_pk_bf16(v0[2], v0[3]); w.z = cvt_pk_bf16(v1[0], v1[1]); w.w = cvt_pk_bf16(v1[2], v1[3]);
                    st16_wt(rowp + bj * HALF, w); } }
    }
};
template <int CTRL> __device__ __forceinline__ float dpp_shr(float x) { return __builtin_bit_cast(float, __builtin_amdgcn_update_dpp(0, __builtin_bit_cast(int, x), CTRL, 0xf, 0xf, true)); }
__device__ __forceinline__ float row15(float x) { return __shfl(x, 15, 16); }
__device__ __forceinline__ float fexp(float x) { return __builtin_amdgcn_exp2f(x * 1.4426950408889634f); }
__device__ __forceinline__ float fsigmoid(float x) { return __builtin_amdgcn_rcpf(1.f + fexp(-x)); }
__device__ __forceinline__ void chunk_scan(float (&v)[4], float& r, float& last) {
    float tot[4];
#pragma unroll
    for (int m = 0; m < 4; ++m) { float x = v[m]; x += dpp_shr<0x111>(x); x += dpp_shr<0x112>(x); x += dpp_shr<0x114>(x); x += dpp_shr<0x118>(x); v[m] = x; tot[m] = row15(x); }
    r = tot[0] + tot[1]; last = (tot[0] + tot[1]) + (tot[2] + tot[3]);
    v[1] += tot[0]; v[2] += tot[0] + tot[1]; v[3] += (tot[0] + tot[1]) + tot[2];
}
struct EpiIn {
    static constexpr bool PERM = false, AFTER_DRAIN = false;
    bf16_t* Z; float* vec  ; float* mg  ; PG8_LAS const float* bt; PG8_LAS const float* rt; const float* lbt  ; const float* bgate  ;
    __device__ __forceinline__ void operator()(f32x4 (&acc)[2][2][4][2], const Unit& u, int wr, int wc, int fr, int fq) const {
        if (!Z) return;
        const int b = u.pm >> 4, pn = u.pn, col0 = pn * BM + wc * 32 + 4 * fq; const int row0 = u.pm * BM + wr * 64 + fr;
#pragma unroll
        for (int ai = 0; ai < 2; ++ai)
#pragma unroll
            for (int m = 0; m < 4; ++m) { const float rs = rt[u.ui * 256 + ai * HALF + wr * 64 + m * 16 + fr];
#pragma unroll
                for (int bj = 0; bj < 2; ++bj)
#pragma unroll
                    for (int n = 0; n < 2; ++n) acc[ai][bj][m][n] = acc[ai][bj][m][n] * rs + *(PG8_LAS const f32x4*)(bt + u.ui * 256 + wc * 32 + 4 * fq + bj * HALF + n * 16); }
        char* Zc = (char*)Z;
        const unsigned zb = ((unsigned)row0 * 4096u + (unsigned)(pn * BM)) * 2u;
        const bool odd = (fq & 1) != 0;
#define ZST2(ai_, m_, colA, valA, colB, valB) do { const f32x4 a_ = (valA), b_ = (valB); u32x2 wa_, wb_; wa_.x = cvt_pk_bf16(a_[0], a_[1]); wa_.y = cvt_pk_bf16(a_[2], a_[3]); wb_.x = cvt_pk_bf16(b_[0], b_[1]); wb_.y = cvt_pk_bf16(b_[2], b_[3]); \
        const unsigned gx_ = odd ? wa_.x : wb_.x, gy_ = odd ? wa_.y : wb_.y; const unsigned rx_ = (unsigned)__shfl_xor((int)gx_, 16), ry_ = (unsigned)__shfl_xor((int)gy_, 16); \
        v4u o_; o_.x = odd ? rx_ : wa_.x; o_.y = odd ? ry_ : wa_.y; o_.z = odd ? wb_.x : rx_; o_.w = odd ? wb_.y : ry_; \
        *(v4u*)(Zc + (zb + (unsigned)(((ai_) * HALF + (m_) * 16) * 8192) + (unsigned)(odd ? (colB) - 8 : (colA)))) = o_; } while (0)
        if (pn >= 12) {
#pragma unroll
            for (int ai = 0; ai < 2; ++ai)
#pragma unroll
                for (int m = 0; m < 4; ++m)
#pragma unroll
                    for (int bj = 0; bj < 2; ++bj) { f32x4 v0 = acc[ai][bj][m][0], v1 = acc[ai][bj][m][1]; const int tc = bj * HALF + wc * 32 + 4 * fq;
                        if (bj == 1 && wc >= 2) { v0[0] = fsigmoid(v0[0]); v0[1] = fsigmoid(v0[1]); v0[2] = fsigmoid(v0[2]); v0[3] = fsigmoid(v0[3]); v1[0] = fsigmoid(v1[0]); v1[1] = fsigmoid(v1[1]); v1[2] = fsigmoid(v1[2]); v1[3] = fsigmoid(v1[3]); }
                        ZST2(ai, m, tc * 2, v0, (tc + 16) * 2, v1); }
        } else if (pn >= 6) {
            const int c0 = 16 * wc + 4 * fq; const f32x4 lb4 = *(const f32x4*)(lbt + (pn - 6) * 64 + c0);
#pragma unroll
            for (int ai = 0; ai < 2; ++ai) {
                float* vp = vec + ((size_t)((b * 64 + (u.pm & 15) * 4 + 2 * ai + wr) * 16 + pn)) * 192 + c0;
#pragma unroll
                for (int j = 0; j < 4; ++j) { float v[4]; const float lbv = lb4[j];
#pragma unroll
                    for (int m = 0; m < 4; ++m) { const float f = fmaxf(acc[ai][0][m][1][j], -80.f), ee = fexp(-f), sig = __builtin_amdgcn_rcpf(1.f + ee);
                        v[m] = __logf(lbv + (1.f - lbv) * sig);
                        acc[ai][0][m][1][j] = (1.f - lbv) * ee * sig;
                        const float q = acc[ai][0][m][0][j]; acc[ai][0][m][0][j] = q * fsigmoid(q); }
                    float r, last; chunk_scan(v, r, last);
#pragma unroll
                    for (int m = 0; m < 4; ++m) { acc[ai][0][m][0][j] *= fexp(fminf(v[m] - r, 60.f)); acc[ai][0][m][1][j] *= fexp(fminf(r - v[m], 60.f)); }
                    if (fr == 0) { vp[j] = fexp(r); vp[64 + j] = fexp(last - r); vp[128 + j] = fexp(last); } }
#pragma unroll
                for (int m = 0; m < 4; ++m) { ZST2(ai, m, c0 * 2, acc[ai][0][m][0], 128 + c0 * 2, acc[ai][0][m][1]);
                    f32x4 g = acc[ai][1][m][1]; g[0] = fsigmoid(g[0]); g[1] = fsigmoid(g[1]); g[2] = fsigmoid(g[2]); g[3] = fsigmoid(g[3]); ZST2(ai, m, 256 + c0 * 2, acc[ai][1][m][0], 384 + c0 * 2, g); }
                asm volatile("" ::: "memory");
            }
        } else if (wc < 2) {
            const int c0 = 16 * wc + 4 * fq; const f32x4 bg4 = *(const f32x4*)(bgate + pn * 32 + c0);
#pragma unroll
            for (int ai = 0; ai < 2; ++ai) {
                float* vp = vec + ((size_t)((b * 64 + (u.pm & 15) * 4 + 2 * ai + wr) * 16 + pn)) * 192 + c0;
#pragma unroll
                for (int j = 0; j < 4; ++j) { float v[4];
#pragma unroll
                    for (int m = 0; m < 4; ++m) { const float x = acc[ai][1][m][0][j] + bg4[j]; v[m] = (fminf(x, 0.f) - __logf(1.f + fexp(-fabsf(x)))) * 0.0625f; }
                    float r, last; chunk_scan(v, r, last);
#pragma unroll
                    for (int m = 0; m < 4; ++m) { acc[ai][0][m][0][j] *= 0.17677669529663687f * fexp(fminf(v[m] - r, 60.f)); acc[ai][0][m][1][j] *= fexp(fminf(r - v[m], 60.f)); }
                    if (fr == 0) { vp[j] = fexp(r); vp[64 + j] = fexp(last - r); vp[128 + j] = fexp(last); } }
#pragma unroll
                for (int m = 0; m < 4; ++m) ZST2(ai, m, c0 * 2, acc[ai][0][m][0], 64 + c0 * 2, acc[ai][0][m][1]);
                if (pn == 0 && wc == 0 && fq < 2) {
#pragma unroll
                    for (int m = 0; m < 4; ++m) *(f32x4*)(mg + (size_t)(row0 + ai * HALF + m * 16) * 8 + 4 * fq) = acc[ai][1][m][1]; }
                asm volatile("" ::: "memory");
            }
        } else {
            const int e0 = 32 * (wc - 2) + 4 * fq;
#pragma unroll
            for (int ai = 0; ai < 2; ++ai)
#pragma unroll
                for (int m = 0; m < 4; ++m)
#pragma unroll
                    for (int n = 0; n < 2; ++n) { f32x4 g = acc[ai][1][m][n]; g[0] *= fsigmoid(g[0]); g[1] *= fsigmoid(g[1]); g[2] *= fsigmoid(g[2]); g[3] *= fsigmoid(g[3]);
                        ZST2(ai, m, 256 + (e0 + 16 * n) * 2, acc[ai][0][m][n], 384 + (e0 + 16 * n) * 2, g); }
        }
#undef ZST2
    }
};
#if MK_SEG_ALIGN
#define PG8_SEGALIGN asm volatile(".p2align 6\n\t.rept " PG8_STR(MK_KLOOP_PAD) "\n\ts_nop 0\n\t.endr" ::: "memory")
#else
#define PG8_SEGALIGN do {} while (0)
#endif
#define PG8_STR2(x) #x
#define PG8_STR(x) PG8_STR2(x)
template <class Epi, class Sched, bool ALIGN_EPI = false, bool SP2 = false, int AUX_A = 0>
__device__ __forceinline__ void gemm_phase(PG8_LAS unsigned char* lds, const Gemm g, const Sched& S, const Epi& E, int wave_in) {
    int tid_; asm volatile("v_mbcnt_lo_u32_b32 %0, -1, 0\n\tv_mbcnt_hi_u32_b32 %0, -1, %0" : "=v"(tid_)); tid_ += wave_in * 64;
    const int tid = tid_, wid = __builtin_amdgcn_readfirstlane(tid >> 6), lane = tid & 63, wr = wid >> 2, wc = wid & 3, fr = lane & 15, fq = lane >> 4;
    const int K = g.K, LD = g.ld ? g.ld : K, nt = g.nt_probe ? g.nt_probe : K / BK;
    unsigned voffA[2], voffB[2];
#pragma unroll
    for (int i = 0; i < 2; ++i) { int R, C; stage_rc(tid * 16 + i * 8192, R, C); const int Rb = Epi::PERM ? ((R & ~31) + perm32(R & 31)) : R;
        voffA[i] = (unsigned)(R * LD + C) * 2u; voffB[i] = (unsigned)(Rb * LD + C) * 2u; }
    const size_t kstep = (size_t)(BK * 2);
    const size_t hstep = (size_t)HALF * LD * 2;
    const size_t tstep = 2 * hstep;
    const unsigned ldsw = (unsigned)wid * 1024u;
    const int aoff = lds_byte(wr * 64 + fr, fq * 8), boff = lds_byte(wc * 32 + fr, fq * 8);
#define PG8_SA(b, h) (((b) * 2 + (h)) * HTB)
#define PG8_SB(b, h) ((4 + (b) * 2 + (h)) * HTB)
#define PG8_STAGE(bufoff, gbase, voff) do { _Pragma("unroll") for (int _i = 0; _i < 2; ++_i) { \
        if ((voff) == voffA && AUX_A != 0) __builtin_amdgcn_global_load_lds((const unsigned*)((const char*)(gbase) + (voff)[_i]), (PG8_LAS unsigned*)(lds + (bufoff) + ldsw + _i * 8192), 16, 0, AUX_A); \
        else __builtin_amdgcn_global_load_lds((const unsigned*)((const char*)(gbase) + (voff)[_i]), (PG8_LAS unsigned*)(lds + (bufoff) + ldsw + _i * 8192), 16, 0, 0); } } while (0)
#define PG8_LDA(dst, b, h) do { _Pragma("unroll") for (int m = 0; m < 4; ++m) _Pragma("unroll") for (int k = 0; k < 2; ++k) dst[m][k] = *(const PG8_LAS bf16x8*)(lds + PG8_SA(b, h) + aoff + m * 2048 + k * 1024); } while (0)
#define PG8_LDB(dst, b, h) do { _Pragma("unroll") for (int n = 0; n < 2; ++n) _Pragma("unroll") for (int k = 0; k < 2; ++k) dst[n][k] = *(const PG8_LAS bf16x8*)(lds + PG8_SB(b, h) + boff + n * 2048 + k * 1024); } while (0)
#define PG8_MMA(ai, bj, At, Bt) do { __builtin_amdgcn_s_setprio(1); _Pragma("unroll") for (int m = 0; m < 4; ++m) _Pragma("unroll") for (int n = 0; n < 2; ++n) _Pragma("unroll") for (int k = 0; k < 2; ++k) \
        acc[ai][bj][m][n] = __builtin_amdgcn_mfma_f32_16x16x32_bf16(Bt[n][k], At[m][k], acc[ai][bj][m][n], 0, 0, 0); __builtin_amdgcn_s_setprio(0); } while (0)
#define PG8_WAIT_V(n) asm volatile("s_waitcnt vmcnt(" #n ")" ::: "memory")
#define PG8_WAIT_L(n) asm volatile("s_waitcnt lgkmcnt(" #n ")" ::: "memory")
#define PG8_BAR __builtin_amdgcn_s_barrier()
#define PG8_SCHED __builtin_amdgcn_sched_barrier(0)
    Unit cur, nxt; int ui = 0;
    if (!S.next(0, cur)) return;
    f32x4 acc[2][2][4][2];
#pragma unroll
    for (int a = 0; a < 2; ++a)
#pragma unroll
        for (int b = 0; b < 2; ++b)
#pragma unroll
            for (int m = 0; m < 4; ++m)
#pragma unroll
                for (int n = 0; n < 2; ++n) acc[a][b][m][n] = (f32x4){0.f, 0.f, 0.f, 0.f};
    bf16x8 At[4][2], B0[2][2], B1[2][2];
    const char* cA = (const char*)g.A + (size_t)(g.a_same_probe ? 0 : cur.pm) * tstep; const char* cB = (const char*)g.Bt + (size_t)cur.pn * tstep;
    S.a_ready(cur);
    if constexpr (SP2) {
        PG8_STAGE(PG8_SB(0, 0), cB, voffB); PG8_STAGE(PG8_SB(0, 1), cB + hstep, voffB); PG8_STAGE(PG8_SA(0, 0), cA, voffA); PG8_STAGE(PG8_SA(0, 1), cA + hstep, voffA);
        if (wr == 1) PG8_BAR;
        PG8_WAIT_V(2); PG8_BAR;
        PG8_STAGE(PG8_SB(1, 0), cB + kstep, voffB); PG8_STAGE(PG8_SA(1, 0), cA + kstep, voffA); PG8_STAGE(PG8_SB(1, 1), cB + hstep + kstep, voffB);
        PG8_WAIT_V(6); PG8_BAR;
    } else {
        PG8_STAGE(PG8_SB(0, 0), cB, voffB); PG8_STAGE(PG8_SA(0, 0), cA, voffA); PG8_STAGE(PG8_SB(0, 1), cB + hstep, voffB); PG8_STAGE(PG8_SA(0, 1), cA + hstep, voffA);
        if (wr == 1) PG8_BAR;
        PG8_WAIT_V(4); PG8_BAR;
        PG8_STAGE(PG8_SB(1, 0), cB + kstep, voffB); PG8_STAGE(PG8_SA(1, 0), cA + kstep, voffA); PG8_STAGE(PG8_SB(1, 1), cB + hstep + kstep, voffB);
        PG8_WAIT_V(6); PG8_BAR;
    }
    for (;;) {
        const bool has_next = S.next(ui + 1, nxt);
        const char* nA = has_next ? (const char*)g.A + (size_t)(g.a_same_probe ? 0 : nxt.pm) * tstep : cA; const char* nB = has_next ? (const char*)g.Bt + (size_t)nxt.pn * tstep : cB;
        for (int t = 0; t < nt; t += 2) {
            asm volatile(".p2align " PG8_STR(MK_KLOOP_ALIGN) "\n\t.rept " PG8_STR(MK_KLOOP_PAD) "\n\ts_nop 0\n\t.endr" ::: "memory");
            const bool last = (t == nt - 2);
            const char* a1 = cA + (size_t)(t + 1) * kstep;
            const char* a2 = last ? nA : cA + (size_t)(t + 2) * kstep; const char* b2 = last ? nB : cB + (size_t)(t + 2) * kstep;
            const char* a3 = a2 + kstep; const char* b3 = b2 + kstep;
            if (last && has_next) S.a_ready(nxt);
            if constexpr (SP2) {
            PG8_LDB(B0, 0, 0); PG8_LDB(B1, 0, 1); PG8_SCHED; PG8_LDA(At, 0, 0); PG8_STAGE(PG8_SA(1, 1), a1 + hstep, voffA);
            PG8_WAIT_V(8); PG8_WAIT_L(0); PG8_BAR; PG8_MMA(0, 0, At, B0); PG8_MMA(0, 1, At, B1); PG8_BAR; PG8_SCHED; PG8_SEGALIGN;
            PG8_LDA(At, 0, 1); PG8_STAGE(PG8_SB(0, 0), b2, voffB); PG8_STAGE(PG8_SB(0, 1), b2 + hstep, voffB); PG8_STAGE(PG8_SA(0, 0), a2, voffA);
            PG8_WAIT_V(8); PG8_WAIT_L(0); PG8_BAR; PG8_MMA(1, 0, At, B0); PG8_MMA(1, 1, At, B1); PG8_BAR; PG8_SCHED; PG8_SEGALIGN;
            PG8_LDB(B0, 1, 0); PG8_LDB(B1, 1, 1); PG8_SCHED; PG8_LDA(At, 1, 0); PG8_STAGE(PG8_SA(0, 1), a2 + hstep, voffA);
            PG8_WAIT_V(8); PG8_WAIT_L(0); PG8_BAR; PG8_MMA(0, 0, At, B0); PG8_MMA(0, 1, At, B1); PG8_BAR; PG8_SCHED; PG8_SEGALIGN;
            PG8_LDA(At, 1, 1); PG8_STAGE(PG8_SB(1, 0), b3, voffB); PG8_STAGE(PG8_SB(1, 1), b3 + hstep, voffB); PG8_STAGE(PG8_SA(1, 0), a3, voffA);
            PG8_WAIT_V(8); PG8_WAIT_L(0); PG8_BAR; PG8_MMA(1, 0, At, B0); PG8_MMA(1, 1, At, B1); PG8_BAR; PG8_SCHED; PG8_SEGALIGN;
            } else {
            PG8_LDB(B0, 0, 0); PG8_SCHED; PG8_LDA(At, 0, 0); PG8_STAGE(PG8_SA(1, 1), a1 + hstep, voffA);
            PG8_WAIT_L(8); PG8_BAR; PG8_WAIT_L(0); PG8_MMA(0, 0, At, B0); PG8_BAR; PG8_SCHED;
            PG8_LDB(B1, 0, 1); PG8_STAGE(PG8_SB(0, 0), b2, voffB);
            PG8_BAR; PG8_WAIT_L(0); PG8_MMA(0, 1, At, B1); PG8_BAR;
            PG8_LDA(At, 0, 1); PG8_STAGE(PG8_SA(0, 0), a2, voffA);
            PG8_BAR; PG8_WAIT_L(0); PG8_MMA(1, 0, At, B0); PG8_BAR; PG8_SCHED;
            PG8_STAGE(PG8_SB(0, 1), b2 + hstep, voffB);
            PG8_WAIT_V(6); PG8_BAR; PG8_MMA(1, 1, At, B1); PG8_BAR;
            PG8_LDB(B0, 1, 0); PG8_SCHED; PG8_LDA(At, 1, 0); PG8_STAGE(PG8_SA(0, 1), a2 + hstep, voffA);
            PG8_WAIT_L(8); PG8_BAR; PG8_WAIT_L(0); PG8_MMA(0, 0, At, B0); PG8_BAR; PG8_SCHED;
            PG8_LDB(B1, 1, 1); PG8_STAGE(PG8_SB(1, 0), b3, voffB);
            PG8_BAR; PG8_WAIT_L(0); PG8_MMA(0, 1, At, B1); PG8_BAR;
            PG8_LDA(At, 1, 1); PG8_STAGE(PG8_SA(1, 0), a3, voffA);
            PG8_BAR; PG8_WAIT_L(0); PG8_MMA(1, 0, At, B0); PG8_BAR; PG8_SCHED;
            PG8_STAGE(PG8_SB(1, 1), b3 + hstep, voffB);
            PG8_WAIT_V(6); PG8_BAR; PG8_MMA(1, 1, At, B1); PG8_BAR;
            }
        }
        if constexpr (ALIGN_EPI) { if (wr == 0) PG8_BAR; }
        if constexpr (!Epi::AFTER_DRAIN) { E(acc, cur, wr, wc, fr, fq); S.done(cur); }
        if (!has_next) break;
#pragma unroll
        for (int a = 0; a < 2; ++a)
#pragma unroll
            for (int b = 0; b < 2; ++b)
#pragma unroll
                for (int m = 0; m < 4; ++m)
#pragma unroll
                    for (int n = 0; n < 2; ++n) acc[a][b][m][n] = (f32x4){0.f, 0.f, 0.f, 0.f};
        cur = nxt; cA = nA; cB = nB; ++ui;
        if constexpr (ALIGN_EPI) { if (wr == 1) PG8_BAR; }
    }
    PG8_WAIT_V(0);
    if constexpr (!ALIGN_EPI) { if (wr == 0) PG8_BAR; }
    PG8_BAR;
    if constexpr (Epi::AFTER_DRAIN) { E.fused(acc, cur, wr, wc, fr, fq, lds, wid, lane); S.done(cur); }
#undef PG8_SA
#undef PG8_SB
#undef PG8_STAGE
#undef PG8_LDA
#undef PG8_LDB
#undef PG8_MMA
#undef PG8_WAIT_V
#undef PG8_WAIT_L
#undef PG8_BAR
#undef PG8_SCHED
}
}
#define XB_TMO      128
#define XB_XCNT(j)  (256  + 64 * (j))
#define XB_XSUB(j)  (1280 + 64 * (j))
#define XB_XGEN(j)  (2304 + 64 * (j))
#define XB_TOP      3328
#define XB_TOPGEN   3392
#define XCD_BAR_WORDS 3456
#define XB_SPIN_CAP (1u << 18)
#ifndef MK_FLAT_RELEASE
#define MK_FLAT_RELEASE 1
#endif

__device__ __forceinline__ unsigned xb_ld(unsigned* p)              { return __hip_atomic_load(p, __ATOMIC_RELAXED, __HIP_MEMORY_SCOPE_AGENT); }
__device__ __forceinline__ unsigned xb_add(unsigned* p, unsigned v) { return __hip_atomic_fetch_add(p, v, __ATOMIC_RELAXED, __HIP_MEMORY_SCOPE_AGENT); }
__device__ __forceinline__ unsigned xb_xcc_id() { return (unsigned)__builtin_amdgcn_s_getreg((3 << 11) | 20) & 0xFu; }
#define XB_SPIN(cond, bar) do { unsigned _sp = 0; while (cond) { __builtin_amdgcn_s_sleep(1); \
    if ((++_sp & 255u) == 0u) { if (xb_ld(&(bar)[XB_TMO])) break; if (_sp > XB_SPIN_CAP) { atomicAdd(&(bar)[XB_TMO], 1u); break; } } } } while (0)

struct XcdBarrier {
    unsigned* bar; unsigned x;
    volatile LAS unsigned* st;
};

__device__ __forceinline__ XcdBarrier xcd_barrier_post(unsigned* bar, volatile LAS unsigned* st) {
    XcdBarrier b; b.bar = bar; b.x = xb_xcc_id(); b.st = st;
    if (threadIdx.x == 0) (void)xb_add(&bar[XB_XCNT(b.x)], 1u);
    return b;
}
__device__ __forceinline__ void xcd_barrier_complete(unsigned* bar, unsigned x, unsigned& nloc, unsigned& nx) {
    const unsigned G = gridDim.x * gridDim.y * gridDim.z;
    unsigned sum, cnt, mine, sp = 0u;
    for (;;) {
        sum = 0u; cnt = 0u; mine = 0u;
#pragma unroll
        for (unsigned j = 0; j < 16; ++j) { const unsigned c = xb_ld(&bar[XB_XCNT(j)]); sum += c; cnt += (c > 0u) ? 1u : 0u; mine = (j == x) ? c : mine; }
        if (sum == G) break;
        __builtin_amdgcn_s_sleep(1);
        if ((++sp & 255u) == 0u) { if (xb_ld(&bar[XB_TMO])) break; if (sp > XB_SPIN_CAP) { atomicAdd(&bar[XB_TMO], 1u); break; } }
    }
    nloc = mine > 0u ? mine : 1u; nx = cnt > 0u ? cnt : 1u;
}

__device__ __forceinline__ void xcd_barrier(const XcdBarrier& b) {
    asm volatile("s_waitcnt vmcnt(0)" ::: "memory");
    __syncthreads();
    if (threadIdx.x == 0) {
        unsigned* bar = b.bar;
        __builtin_amdgcn_s_waitcnt(0);
        asm volatile("buffer_inv sc1" ::: "memory");
        unsigned nloc = b.st[0], nx = b.st[1];
        if (nloc == 0u) { xcd_barrier_complete(bar, b.x, nloc, nx); b.st[0] = nloc; b.st[1] = nx; }
        const unsigned old = xb_add(&bar[XB_XSUB(b.x)], 1u);
        const unsigned gen = old / nloc;
        if (old + 1u == (gen + 1u) * nloc) {
            asm volatile("buffer_wbl2 sc1\n\ts_waitcnt vmcnt(0)" ::: "memory");
            const unsigned og = xb_add(&bar[XB_TOP], 1u);
            const unsigned tg = og / nx;
            if (og + 1u == (tg + 1u) * nx) {
#pragma unroll
                for (unsigned j = 0; j < 16; ++j) xb_add(&bar[XB_XGEN(j)], 1u);
            }
        }
        XB_SPIN(xb_ld(&bar[XB_XGEN(b.x)]) == gen, bar);
        asm volatile("s_waitcnt vmcnt(0)" ::: "memory");
    }
    __syncthreads();
}
#ifndef MK_CONV_P1_LAYERS
#define MK_CONV_P1_LAYERS 4
#endif
#ifndef MK_CONV_WGS
#define MK_CONV_WGS 144
#endif
constexpr int NWAVES = 8;
constexpr int RING_BYTES = 131072, MISC_OFF = RING_BYTES + 320, LDS_BYTES = 163840;
#define LDS_WAIT() asm volatile("s_waitcnt lgkmcnt(0)" ::: "memory")
#define VM_WAIT() asm volatile("s_waitcnt vmcnt(0)" ::: "memory")

struct Args { const float* in[19]; float* out; unsigned char* ws; int ph_lo, ph_hi, li, pad; };
enum { I_X = 0, I_C, I_WADA, I_BADA, I_NMIX, I_NMLP, I_WIN, I_GWG, I_GBG, I_GNORM, I_LBL, I_HNORM, I_MCONV, I_MGB, I_MNORM, I_WOUT, I_WFF1, I_WFF2, I_FNORM };

__device__ __forceinline__ void phase_p0(const Args& a, LAS unsigned char* lds, int tid) {
    LAS float* cond = (LAS float*)lds;
    LAS f32x4* red = (LAS f32x4*)(lds + 16384);
    const float* c = a.in[I_C];
    for (int i = tid; i < NB * D; i += NWAVES * 64) cond[i] = siluf_(c[i]);
    __syncthreads();
    float* mod = (float*)(a.ws + WS_MOD); const float* w_ada = a.in[I_WADA]; const float* b_ada = a.in[I_BADA];
    const int cg = tid & 31, ks = tid >> 5;
    for (int cb = blockIdx.x; cb < L * 48; cb += gridDim.x) {
        const int l = cb / 48, nb0 = (cb % 48) * 128, n0 = nb0 + 4 * cg;
        { const int k0 = ks * 64; const float* w = w_ada + ((size_t)l * D + k0) * (6 * D) + n0;
            f32x4 acc[4];
#pragma unroll
            for (int b = 0; b < 4; ++b) acc[b] = (f32x4){0.f, 0.f, 0.f, 0.f};
#pragma unroll 16
            for (int k = 0; k < 64; ++k) { const f32x4 wv = NT_LD((const f32x4*)(w + (size_t)k * (6 * D)));
#pragma unroll
                for (int b = 0; b < 4; ++b) acc[b] += cond[b * D + k0 + k] * wv; }
#pragma unroll
            for (int b = 0; b < 4; ++b) red[(ks * 4 + b) * 32 + cg] = acc[b]; }
        __syncthreads();
        if (tid < 128) { const int b = tid >> 5, g = tid & 31; f32x4 s = *(const f32x4*)(b_ada + l * 6 * D + nb0 + 4 * g);
#pragma unroll
            for (int q = 0; q < 16; ++q) s += red[(q * 4 + b) * 32 + g];
            *(f32x4*)(&mod[(size_t)(l * NB + b) * 6 * D + nb0 + 4 * g]) = s; }
        __syncthreads();
    }
    { float* wgf = (float*)(a.ws + WS_FOLD); const float* w_in = a.in[I_WIN]; const float* w_gate = a.in[I_GWG];
      for (int i = blockIdx.x * (NWAVES * 64) + tid; i < L * D * 192; i += gridDim.x * NWAVES * 64) { const int ch = i % 192, k = (i / 192) % D, l = i / (192 * D);
          const float* wr_ = w_in + ((size_t)l * D + k) * DIN + GLOW; const float* g = w_gate + (size_t)l * 16 * 192 + ch; float v = 0.f;
#pragma unroll
          for (int q = 0; q < 16; ++q) v += wr_[q] * g[q * 192];
          wgf[i] = v; } }
    if (blockIdx.x == 0 && tid < 384) {
        const float* logits = a.in[I_LBL]; float* lb = (float*)(a.ws + WS_LB);
        float v0 = logits[tid], v1 = logits[384 + tid], v2 = logits[768 + tid], v3 = logits[1152 + tid];
        const float mx = fmaxf(fmaxf(v0, v1), fmaxf(v2, v3));
        v0 = __expf(v0 - mx); v1 = __expf(v1 - mx); v2 = __expf(v2 - mx); v3 = __expf(v3 - mx);
        const float inv = 1.f / (v0 + v1 + v2 + v3);
        lb[tid] = 0.f; lb[384 + tid] = v1 * inv; lb[768 + tid] = (v1 + v2) * inv; lb[1152 + tid] = (v1 + v2 + v3) * inv;
    }
    __syncthreads();
}

__device__ __forceinline__ void conv_item(const Args& a, int it, int lane) {
    asm volatile("" : "+v"(lane));
    const int l = it / 416, r = it % 416;
    int kind, nb, kpart = 0;
    if (r < 128) { kind = 0; nb = r; } else if (r < 160) { kind = 1; nb = r - 128; } else if (r < 288) { kind = 2; nb = r - 160; } else { kind = 3; nb = (r - 288) >> 2; kpart = (r - 288) & 3; }
    const float* W; int N, K; bf16* WT; unsigned char* wl = a.ws + WS_W + (size_t)l * W_LAYER;
    if (kind == 0) { W = a.in[I_WIN] + (size_t)l * D * DIN; N = DIN; K = D; WT = (bf16*)(wl + W_IN); }
    else if (kind == 1) { W = a.in[I_WOUT] + (size_t)l * D * D; N = D; K = D; WT = (bf16*)(wl + W_OUT); }
    else if (kind == 2) { W = a.in[I_WFF1] + (size_t)l * D * DFF; N = DFF; K = D; WT = (bf16*)(wl + W_1); }
    else { W = a.in[I_WFF2] + (size_t)l * DFF * D; N = D; K = DFF; WT = (bf16*)(wl + W_2); }
    const int kg = lane >> 3, ng = lane & 7, n0 = nb * 32 + 4 * ng;
    const float* sp_ = W + n0; int pitch = N; float mul = 1.f;
    if (kind == 0) { const int code = in_src(n0);
        if (code >= 0) sp_ = W + code; else if (code == -1) { sp_ = W; mul = 0.f; } else { sp_ = (const float*)(a.ws + WS_FOLD) + (size_t)l * D * 192 + (-(code + 2)); pitch = 192; } }
    sp_ += (size_t)(kpart * 1024 + 8 * kg) * pitch;
    const bool want_bias = (kind == 0 || kind == 2);
    const float* shiftp = (const float*)(a.ws + WS_MOD) + (size_t)l * NB * 6 * D + (kind == 0 ? 0 : 3) * D + kpart * 1024 + 8 * kg;
    f32x4 ab[4];
#pragma unroll
    for (int b = 0; b < 4; ++b) ab[b] = (f32x4){0.f, 0.f, 0.f, 0.f};
    bf16* wt = WT + (size_t)n0 * K + kpart * 1024 + 8 * kg;
    f32x4 ring[4][8];
#pragma unroll
    for (int t = 0; t < 3; ++t)
#pragma unroll
        for (int i = 0; i < 8; ++i) ring[t][i] = NT_LD((const f32x4*)(sp_ + (size_t)(64 * t + i) * pitch));
#pragma unroll
    for (int kt = 0; kt < 16; ++kt) {
        if (kt + 3 < 16) {
#pragma unroll
            for (int i = 0; i < 8; ++i) ring[(kt + 3) & 3][i] = NT_LD((const f32x4*)(sp_ + (size_t)(64 * (kt + 3) + i) * pitch)); }
        f32x4 cur[8];
#pragma unroll
        for (int i = 0; i < 8; ++i) cur[i] = ring[kt & 3][i] * mul;
#pragma unroll
        for (int j = 0; j < 4; ++j) { v4u o; o.x = pk2(cur[0][j], cur[1][j]); o.y = pk2(cur[2][j], cur[3][j]); o.z = pk2(cur[4][j], cur[5][j]); o.w = pk2(cur[6][j], cur[7][j]);
            st16_wt(wt + (size_t)j * K + 64 * kt, o); }
        if (want_bias) {
#pragma unroll
            for (int b = 0; b < 4; ++b) { const f32x4 s0 = *(const f32x4*)(shiftp + b * 6 * D + 64 * kt), s1 = *(const f32x4*)(shiftp + b * 6 * D + 64 * kt + 4);
                ab[b] += (cur[0] * s0[0] + cur[1] * s0[1]) + (cur[2] * s0[2] + cur[3] * s0[3]) + (cur[4] * s1[0] + cur[5] * s1[1]) + (cur[6] * s1[2] + cur[7] * s1[3]); } }
    }
    if (want_bias) {
        float* bias = (float*)(a.ws + WS_BIAS) + (kind == 0 ? 0 : (size_t)L * NB * 4096) + (size_t)l * NB * 4096 + n0;
#pragma unroll
        for (int b = 0; b < 4; ++b) { f32x4 v = ab[b];
#pragma unroll
            for (int j = 0; j < 4; ++j) { v[j] += __shfl_xor(v[j], 8); v[j] += __shfl_xor(v[j], 16); v[j] += __shfl_xor(v[j], 32); }
            if (kg == 0) *(f32x4*)(bias + b * 4096) = v; }
    }
}
__device__ __forceinline__ void phase_p1(const Args& a, LAS unsigned char* lds, int tid, int lane, int wave) {
    const int G = gridDim.x, gw = blockIdx.x * NWAVES + wave, NGW = G * NWAVES;
    const float* mod = (const float*)(a.ws + WS_MOD);
    { float* gm = (float*)(a.ws + WS_GMUL);
      for (int i = blockIdx.x * (NWAVES * 64) + tid; i < L * 2 * NB * D; i += G * NWAVES * 64) { const int k = i & 1023, b = (i >> 10) & 3, w = (i >> 12) & 1, l = i >> 13;
          const float gain = (w ? a.in[I_NMLP] : a.in[I_NMIX])[l * D + k]; gm[i] = gain * (1.f + mod[(size_t)(l * NB + b) * 6 * D + (w ? 4 : 1) * D + k]); } }
    { const float* x = a.in[I_X]; bf16* xn = (bf16*)(a.ws + WS_XN); float* ssq = (float*)(a.ws + WS_SSQ); const float* nm = a.in[I_NMIX];
      for (int r0 = gw; r0 < S / 2; r0 += NGW)
        for (int b = 0; b < NB; ++b) { f32x4 gmv[4];
#pragma unroll
          for (int j = 0; j < 4; ++j) { const int k = 4 * lane + 256 * j; gmv[j] = *(const f32x4*)(nm + k) * (*(const f32x4*)(mod + (size_t)b * 6 * D + D + k) + 1.f); }
          const int rowA = b * S + r0, rowB = rowA + S / 2; f32x4 va[4], vb[4];
          const GAS f32x4* xa = (const GAS f32x4*)(x + (size_t)rowA * D) + lane; const GAS f32x4* xb_ = (const GAS f32x4*)(x + (size_t)rowB * D) + lane;
#pragma unroll
          for (int j = 0; j < 4; ++j) { va[j] = NT_LD((const f32x4*)(xa + 64 * j)); vb[j] = NT_LD((const f32x4*)(xb_ + 64 * j)); }
          float sa = 0.f, sb = 0.f; GAS unsigned long long* oa = (GAS unsigned long long*)(xn + (size_t)rowA * D) + lane; GAS unsigned long long* ob = (GAS unsigned long long*)(xn + (size_t)rowB * D) + lane;
#pragma unroll
          for (int j = 0; j < 4; ++j) { sa += (va[j][0] * va[j][0] + va[j][1] * va[j][1]) + (va[j][2] * va[j][2] + va[j][3] * va[j][3]); sb += (vb[j][0] * vb[j][0] + vb[j][1] * vb[j][1]) + (vb[j][2] * vb[j][2] + vb[j][3] * vb[j][3]);
              const f32x4 pa = va[j] * gmv[j], pb = vb[j] * gmv[j];
              oa[64 * j] = (unsigned long long)pk2(pa[0], pa[1]) | ((unsigned long long)pk2(pa[2], pa[3]) << 32); ob[64 * j] = (unsigned long long)pk2(pb[0], pb[1]) | ((unsigned long long)pk2(pb[2], pb[3]) << 32); }
          sa = wave_sum(sa); sb = wave_sum(sb);
          if (lane < 16) { ssq[(size_t)rowA * 16 + lane] = (lane == 0) ? sa : 0.f; ssq[(size_t)rowB * 16 + lane] = (lane == 0) ? sb : 0.f; } } }
    for (int it = gw; it < MK_CONV_P1_LAYERS * 416; it += NGW) conv_item(a, it, lane);
}
__device__ __forceinline__ void conv_phase(const Args& a, int lane, int wave, int layer) {
    const int gwr = (gridDim.x - 1 - blockIdx.x) * NWAVES + wave;
    for (int it = gwr; it < 416; it += MK_CONV_WGS * NWAVES) { if (gwr < MK_CONV_WGS * NWAVES) conv_item(a, layer * 416 + it, lane); }
}
__device__ __forceinline__ void phase_final(const Args& a, int lane, int wave) {
    const int gw = blockIdx.x * NWAVES + wave, NGW = gridDim.x * NWAVES; const float* fn = a.in[I_FNORM]; const bf16* xb = (const bf16*)(a.ws + WS_XB);
    f32x4 g[4];
#pragma unroll
    for (int j = 0; j < 4; ++j) g[j] = *(const f32x4*)(fn + 16 * lane + 4 * j);
    for (int r0 = gw; r0 < M / 4; r0 += NGW) { v4u ra[4], rb[4];
#pragma unroll
        for (int q = 0; q < 4; ++q) { const v4u* xr = (const v4u*)(xb + (size_t)(r0 + q * (M / 4)) * D + 16 * lane); ra[q] = xr[0]; rb[q] = xr[1]; }
#pragma unroll
        for (int q = 0; q < 4; ++q) { float v[16]; const unsigned w[8] = {ra[q].x, ra[q].y, ra[q].z, ra[q].w, rb[q].x, rb[q].y, rb[q].z, rb[q].w}; float s = 0.f;
#pragma unroll
            for (int j = 0; j < 8; ++j) { v[2 * j] = __builtin_bit_cast(float, w[j] << 16); v[2 * j + 1] = __builtin_bit_cast(float, w[j] & 0xffff0000u); s += v[2 * j] * v[2 * j] + v[2 * j + 1] * v[2 * j + 1]; }
            const float rs = rsqrtf(wave_sum(s) * (1.f / D) + EPS); f32x4* o = (f32x4*)(a.out + (size_t)(r0 + q * (M / 4)) * D + 16 * lane);
#pragma unroll
            for (int j = 0; j < 4; ++j) o[j] = (f32x4){v[4 * j] * rs * g[j][0], v[4 * j + 1] * rs * g[j][1], v[4 * j + 2] * rs * g[j][2], v[4 * j + 3] * rs * g[j][3]}; } }
}
typedef short v4i16_t __attribute__((ext_vector_type(4)));
typedef short s16x4 __attribute__((ext_vector_type(4)));
#define MFMA32(a, b, c) __builtin_amdgcn_mfma_f32_32x32x16_bf16((a), (b), (c), 0, 0, 0)
__device__ __forceinline__ s16x4 tr16(LAS const unsigned char* p) { return __builtin_bit_cast(s16x4, __builtin_amdgcn_ds_read_tr16_b64_v4i16((LAS v4i16_t*)p)); }
__device__ __forceinline__ bf16x8 cat8(s16x4 a, s16x4 b) { return __builtin_shufflevector(a, b, 0, 1, 2, 3, 4, 5, 6, 7); }
__device__ __forceinline__ unsigned cvtpk(float lo, float hi) { typedef __bf16 bf16x2_t __attribute__((ext_vector_type(2))); typedef float f32x2_t __attribute__((ext_vector_type(2))); f32x2_t v = {lo, hi}; return __builtin_bit_cast(unsigned, __builtin_convertvector(v, bf16x2_t)); }
__device__ __forceinline__ bf16x8 pack8(const f32x16& x, int s) { v4u p; p.x = cvtpk(x[8 * s], x[8 * s + 1]); p.y = cvtpk(x[8 * s + 2], x[8 * s + 3]); p.z = cvtpk(x[8 * s + 4], x[8 * s + 5]); p.w = cvtpk(x[8 * s + 6], x[8 * s + 7]); return __builtin_bit_cast(bf16x8, p); }
__device__ __forceinline__ float fexp_(float x) { return __builtin_amdgcn_exp2f(x * 1.4426950408889634f); }
__device__ __forceinline__ float fsig_(float x) { return __builtin_amdgcn_rcpf(1.f + fexp_(-x)); }
constexpr size_t U_BN = 208 * 1024, SP_BN = 104 * 1024;
__device__ __forceinline__ int u_off(int head) { return head < 6 ? head * 8192 : head < 12 ? 49152 + (head - 6) * 16384 : 147456 + (head - 12) * 16384; }
template <int NB16> __device__ __forceinline__ void stage_img(LAS unsigned char* img, const bf16* src, int lane) {
    constexpr int RPI = 64 / NB16;
#pragma unroll
    for (int i = 0; i < 64 / RPI; ++i) { const int row = i * RPI + lane / NB16, ch = lane % NB16; const v4u v = *(const v4u*)(src + (size_t)row * 4096 + ch * 8); *(LAS v4u*)(img + row * (NB16 * 16) + ch * 16) = v; }
}
template <int KCH> __device__ __forceinline__ void ktv(f32x16 (&U)[KCH / 32][2], LAS const unsigned char* kimg, LAS const unsigned char* vimg, int lane) {
    const int h = lane >> 5, g16 = (lane >> 4) & 1, q = (lane & 15) >> 2, p = lane & 3;
#pragma unroll
    for (int cb = 0; cb < KCH / 32; ++cb)
#pragma unroll
        for (int vb = 0; vb < 2; ++vb)
#pragma unroll
            for (int r = 0; r < 16; ++r) U[cb][vb][r] = 0.f;
#pragma unroll
    for (int s = 0; s < 4; ++s) { const int t0 = 16 * s + 8 * h + q; bf16x8 A[KCH / 32], B[2];
#pragma unroll
        for (int cb = 0; cb < KCH / 32; ++cb) A[cb] = cat8(tr16(kimg + t0 * (KCH * 2) + (32 * cb + 16 * g16 + 4 * p) * 2), tr16(kimg + (t0 + 4) * (KCH * 2) + (32 * cb + 16 * g16 + 4 * p) * 2));
#pragma unroll
        for (int vb = 0; vb < 2; ++vb) B[vb] = cat8(tr16(vimg + t0 * 128 + (32 * vb + 16 * g16 + 4 * p) * 2), tr16(vimg + (t0 + 4) * 128 + (32 * vb + 16 * g16 + 4 * p) * 2));
#pragma unroll
        for (int cb = 0; cb < KCH / 32; ++cb)
#pragma unroll
            for (int vb = 0; vb < 2; ++vb) U[cb][vb] = MFMA32(A[cb], B[vb], U[cb][vb]); }
}
template <int KCH> __device__ __forceinline__ void store_ut(const f32x16 (&U)[KCH / 32][2], float* UT, const float* el, int lane, LAS unsigned char* buf) {
    const int h = lane >> 5, r32 = lane & 31; constexpr int CPR = KCH / 4;
    LDS_WAIT(); asm volatile("" ::: "memory");
#pragma unroll
    for (int cb = 0; cb < KCH / 32; ++cb)
#pragma unroll
        for (int g = 0; g < 4; ++g) { const int c0 = 32 * cb + 8 * g + 4 * h; f32x4 e4 = {1.f, 1.f, 1.f, 1.f}; if (el) e4 = *(const f32x4*)(el + c0);
#pragma unroll
            for (int vb = 0; vb < 2; ++vb) { const f32x4 o = {U[cb][vb][4 * g] * e4[0], U[cb][vb][4 * g + 1] * e4[1], U[cb][vb][4 * g + 2] * e4[2], U[cb][vb][4 * g + 3] * e4[3]}; const int row = 32 * vb + r32, ch = 8 * cb + 2 * g + h;
                *(LAS f32x4*)(buf + row * (KCH * 4) + ((ch ^ (row & (CPR - 1))) << 4)) = o; } }
    LDS_WAIT(); asm volatile("" ::: "memory");
    unsigned char* dst = (unsigned char*)UT;
#pragma unroll
    for (int i = 0; i < KCH / 4; ++i) { const int row = i * (64 / CPR) + lane / CPR, ch = lane % CPR; const v4u o = *(LAS const v4u*)(buf + row * (KCH * 4) + ((ch ^ (row & (CPR - 1))) << 4)); *(v4u*)(dst + i * 1024 + (unsigned)(lane * 16)) = o; }
}
template <int KCH> __device__ __forceinline__ void mix_c1_gh(const Args& a, LAS unsigned char* wl, int lane, int b, int n, int head) {
    asm volatile("" : "+v"(lane));
    const size_t row0 = (size_t)b * S + n * 64; const bf16* Zt = (const bf16*)(a.ws + WS_Z) + row0 * 4096 + head * 256;
    LAS unsigned char* kimg = wl; LAS unsigned char* vimg = wl + 8192;
    stage_img<KCH / 8>(kimg, Zt + KCH, lane); stage_img<8>(vimg, Zt + 128, lane);
    LDS_WAIT(); asm volatile("" ::: "memory");
    f32x16 U[KCH / 32][2]; ktv<KCH>(U, kimg, vimg, lane);
    const float* vp = (const float*)(a.ws + WS_VEC) + ((size_t)(b * 64 + n) * 16 + head) * 192;
    store_ut<KCH>(U, (float*)(a.ws + WS_U + (size_t)(b * 64 + n) * U_BN + u_off(head)), vp + 64, lane, wl);
    LDS_WAIT(); asm volatile("" ::: "memory");
}
template <int CPR> __device__ __forceinline__ int imgoff(int row, int ch) { return row * (CPR * 16) + ((ch ^ ((row >> (CPR == 8 ? 1 : 2)) & (CPR - 1))) << 4); }
template <int KCH> __device__ __forceinline__ void mix_c3_gh(const Args& a, LAS unsigned char* wl, int lane, int b, int n, int head, int l) {
    asm volatile("" : "+v"(lane));
    const size_t row0 = (size_t)b * S + n * 64; const bf16* Zt = (const bf16*)(a.ws + WS_Z) + row0 * 4096 + head * 256;
    LAS unsigned char* bufA = wl; LAS unsigned char* bufB = wl + 8192;
    const int h = lane >> 5, r32 = lane & 31, g16 = (lane >> 4) & 1, q = (lane & 15) >> 2, p = lane & 3;
    constexpr int NS = KCH / 16, CPR = KCH / 8, RPI = 64 / CPR, NI = 64 / RPI;
    const int srow = lane / CPR, sch = lane % CPR, vrow = lane >> 3, vch = lane & 7; const unsigned char* zb = (const unsigned char*)Zt;
    const unsigned loff = (unsigned)(vrow * 8192 + vch * 16), soff = (unsigned)(srow * 8192 + sch * 16);
    const bf16* SpT = (const bf16*)(a.ws + WS_XN + (size_t)(b * 64 + n) * SP_BN + u_off(head) / 2);
    v4u rq[NI], rk[NI], rs[NI], rv[8], rg[8];
#pragma unroll
    for (int i = 0; i < NI; ++i) { rq[i] = *(const v4u*)(zb + (size_t)i * (RPI * 8192) + soff); rk[i] = *(const v4u*)(zb + (size_t)i * (RPI * 8192) + KCH * 2 + soff); }
#pragma unroll
    for (int i = 0; i < 8; ++i) rv[i] = *(const v4u*)(zb + (size_t)i * 65536 + 256 + loff);
#pragma unroll
    for (int i = 0; i < NI; ++i) rs[i] = *(const v4u*)((const unsigned char*)SpT + i * 1024 + (unsigned)(lane * 16));
#pragma unroll
    for (int i = 0; i < 8; ++i) rg[i] = *(const v4u*)(zb + (size_t)i * 65536 + 384 + loff);
#pragma unroll
    for (int i = 0; i < NI; ++i) { *(LAS v4u*)(bufA + imgoff<CPR>(i * RPI + srow, sch)) = rq[i]; *(LAS v4u*)(bufB + imgoff<CPR>(i * RPI + srow, sch)) = rk[i]; }
    bf16x8 Qf[2][NS], Kf[2][NS], Sf[2][NS];
#pragma unroll
    for (int ib = 0; ib < 2; ++ib)
#pragma unroll
        for (int s = 0; s < NS; ++s) { Qf[ib][s] = *(LAS const bf16x8*)(bufA + imgoff<CPR>(32 * ib + r32, 2 * s + h)); Kf[ib][s] = *(LAS const bf16x8*)(bufB + imgoff<CPR>(32 * ib + r32, 2 * s + h)); }
    LDS_WAIT(); asm volatile("" ::: "memory");
#pragma unroll
    for (int i = 0; i < 8; ++i) *(LAS v4u*)(bufA + (i * 8 + vrow) * 128 + vch * 16) = rv[i];
#pragma unroll
    for (int i = 0; i < NI; ++i) *(LAS v4u*)(bufB + imgoff<CPR>(i * RPI + srow, sch)) = rs[i];
    f32x16 X00, X01, X11;
#pragma unroll
    for (int r = 0; r < 16; ++r) { X00[r] = 0.f; X01[r] = 0.f; X11[r] = 0.f; }
#pragma unroll
    for (int s = 0; s < NS; ++s) { X00 = MFMA32(Kf[0][s], Qf[0][s], X00); X01 = MFMA32(Kf[0][s], Qf[1][s], X01); X11 = MFMA32(Kf[1][s], Qf[1][s], X11); }
#pragma unroll
    for (int r = 0; r < 16; ++r) { const int jl = (r & 3) + 8 * (r >> 2) + 4 * h; if (jl > r32) { X00[r] = 0.f; X11[r] = 0.f; } }
    bf16x8 P00[2], P01[2], P11[2];
#pragma unroll
    for (int s2 = 0; s2 < 2; ++s2) { P00[s2] = pack8(X00, s2); P01[s2] = pack8(X01, s2); P11[s2] = pack8(X11, s2); }
#pragma unroll
    for (int vb = 0; vb < 2; ++vb)
#pragma unroll
        for (int s = 0; s < NS; ++s) Sf[vb][s] = *(LAS const bf16x8*)(bufB + imgoff<CPR>(32 * vb + r32, 2 * s + h));
    LDS_WAIT(); asm volatile("" ::: "memory");
#pragma unroll
    for (int i = 0; i < 8; ++i) *(LAS v4u*)(bufB + imgoff<8>(i * 8 + vrow, vch)) = rg[i];
    f32x16 O[2][2];
#pragma unroll
    for (int vb = 0; vb < 2; ++vb)
#pragma unroll
        for (int ib = 0; ib < 2; ++ib)
#pragma unroll
            for (int r = 0; r < 16; ++r) O[vb][ib][r] = 0.f;
    LDS_WAIT(); asm volatile("" ::: "memory");
#pragma unroll
    for (int vb = 0; vb < 2; ++vb)
#pragma unroll
        for (int jb = 0; jb < 2; ++jb)
#pragma unroll
            for (int s2 = 0; s2 < 2; ++s2) { const int t0 = 32 * jb + 16 * s2 + 4 * h + q; LAS const unsigned char* cp = bufA + (32 * vb + 16 * g16 + 4 * p) * 2;
                const bf16x8 A = cat8(tr16(cp + t0 * 128), tr16(cp + (t0 + 8) * 128));
                if (jb == 0) { O[vb][0] = MFMA32(A, P00[s2], O[vb][0]); O[vb][1] = MFMA32(A, P01[s2], O[vb][1]); } else O[vb][1] = MFMA32(A, P11[s2], O[vb][1]); }
#pragma unroll
    for (int vb = 0; vb < 2; ++vb)
#pragma unroll
        for (int s = 0; s < NS; ++s) { O[vb][0] = MFMA32(Sf[vb][s], Qf[0][s], O[vb][0]); O[vb][1] = MFMA32(Sf[vb][s], Qf[1][s], O[vb][1]); }
    const float* gain = (head < 6 ? a.in[I_GNORM] : a.in[I_HNORM]) + l * 64; bf16* mixed = (bf16*)(a.ws + WS_MIX);
    LDS_WAIT(); asm volatile("" ::: "memory");
#pragma unroll
    for (int ib = 0; ib < 2; ++ib) { float ms = 0.f;
#pragma unroll
        for (int vb = 0; vb < 2; ++vb)
#pragma unroll
            for (int r = 0; r < 16; ++r) ms += O[vb][ib][r] * O[vb][ib][r];
        ms += __shfl_xor(ms, 32); const float rn = rsqrtf(ms * (1.f / 64.f) + EPS); const int trow = 32 * ib + r32;
#pragma unroll
        for (int vb = 0; vb < 2; ++vb)
#pragma unroll
            for (int g = 0; g < 4; ++g) { const int vc0 = 32 * vb + 8 * g + 4 * h; const f32x4 gn = *(const f32x4*)(gain + vc0); const v2u gw = *(LAS const v2u*)(bufB + imgoff<8>(trow, 4 * vb + g) + 8 * h);
                const float o0 = O[vb][ib][4 * g] * rn * gn[0] * bf2f((unsigned short)(gw.x & 0xffffu)), o1 = O[vb][ib][4 * g + 1] * rn * gn[1] * bf2f((unsigned short)(gw.x >> 16));
                const float o2 = O[vb][ib][4 * g + 2] * rn * gn[2] * bf2f((unsigned short)(gw.y & 0xffffu)), o3 = O[vb][ib][4 * g + 3] * rn * gn[3] * bf2f((unsigned short)(gw.y >> 16));
                v2u w; w.x = cvtpk(o0, o1); w.y = cvtpk(o2, o3); *(LAS v2u*)(bufA + imgoff<8>(trow, 4 * vb + g) + 8 * h) = w; } }
    LDS_WAIT(); asm volatile("" ::: "memory");
#pragma unroll
    for (int i = 0; i < 8; ++i) { const v4u o = *(LAS const v4u*)(bufA + imgoff<8>(i * 8 + vrow, vch)); *(v4u*)((unsigned char*)(mixed + row0 * D + head * 64) + i * 16384 + (unsigned)(vrow * 2048 + vch * 16)) = o; }
    LDS_WAIT(); asm volatile("" ::: "memory");
}
__device__ __forceinline__ float wave_scan_add(float x, int lane) {
#pragma unroll
    for (int d = 1; d < 64; d <<= 1) { const float t = __shfl_up(x, d); if (lane >= d) x += t; }
    return x;
}
__device__ __forceinline__ float wave_scan_max(float x, int lane) {
#pragma unroll
    for (int d = 1; d < 64; d <<= 1) { const float t = __shfl_up(x, d); if (lane >= d) x = fmaxf(x, t); }
    return x;
}
__device__ __forceinline__ float wave_max(float v) {
#pragma unroll
    for (int o = 1; o < 64; o <<= 1) v = fmaxf(v, __shfl_xor(v, o));
    return v;
}
struct ConvW { f32x4 w[4][2]; };
__device__ __forceinline__ void load_convw(ConvW& cw, const float* p) {
#pragma unroll
    for (int tap = 0; tap < 4; ++tap) { cw.w[tap][0] = *(const f32x4*)(p + tap * 512); cw.w[tap][1] = *(const f32x4*)(p + tap * 512 + 4); }
}
__device__ __forceinline__ void conv8(float (&y)[8], const bf16* zsrc, int t, int tglob, int d0, const ConvW& cw) {
#pragma unroll
    for (int j = 0; j < 8; ++j) y[j] = 0.f;
#pragma unroll
    for (int tap = 0; tap < 4; ++tap) { const f32x4 w0 = cw.w[tap][0], w1 = cw.w[tap][1];
        const bool ok = tglob - 3 + tap >= 0; const int rr = ok ? t - 3 + tap : 0;
        v4u rv = *(const v4u*)(zsrc + (long)rr * 4096 + d0); rv.x = ok ? rv.x : 0u; rv.y = ok ? rv.y : 0u; rv.z = ok ? rv.z : 0u; rv.w = ok ? rv.w : 0u;
        y[0] += w0[0] * bf2f((unsigned short)(rv.x & 0xffffu)); y[1] += w0[1] * bf2f((unsigned short)(rv.x >> 16)); y[2] += w0[2] * bf2f((unsigned short)(rv.y & 0xffffu)); y[3] += w0[3] * bf2f((unsigned short)(rv.y >> 16));
        y[4] += w1[0] * bf2f((unsigned short)(rv.z & 0xffffu)); y[5] += w1[1] * bf2f((unsigned short)(rv.z >> 16)); y[6] += w1[2] * bf2f((unsigned short)(rv.w & 0xffffu)); y[7] += w1[3] * bf2f((unsigned short)(rv.w >> 16)); }
#pragma unroll
    for (int j = 0; j < 8; ++j) y[j] = y[j] * fsig_(y[j]);
}
__device__ __forceinline__ bf16x8 pk8f(const float (&y)[8], float sc) { v4u p; p.x = cvtpk(y[0] * sc, y[1] * sc); p.y = cvtpk(y[2] * sc, y[3] * sc); p.z = cvtpk(y[4] * sc, y[5] * sc); p.w = cvtpk(y[6] * sc, y[7] * sc); return __builtin_bit_cast(bf16x8, p); }
template <bool LO> __device__ __forceinline__ void conv8_lds(float (&y)[8], LAS const unsigned char* img, LAS const unsigned char* halo, int t, int ch, const ConvW& cw) {
#pragma unroll
    for (int j = 0; j < 8; ++j) y[j] = 0.f;
#pragma unroll
    for (int tap = 0; tap < 4; ++tap) { const f32x4 w0 = cw.w[tap][0], w1 = cw.w[tap][1];
        const int rr = t - 3 + tap; int off = imgoff<8>(rr < 0 ? 0 : rr, ch); LAS const unsigned char* base = img;
        if (LO && tap < 3) { const bool neg = rr < 0; off = neg ? (rr + 3) * 128 + ch * 16 : off; base = neg ? halo : img; }
        const v4u rv = *(LAS const v4u*)(base + off);
        y[0] += w0[0] * bf2f((unsigned short)(rv.x & 0xffffu)); y[1] += w0[1] * bf2f((unsigned short)(rv.x >> 16)); y[2] += w0[2] * bf2f((unsigned short)(rv.y & 0xffffu)); y[3] += w0[3] * bf2f((unsigned short)(rv.y >> 16));
        y[4] += w1[0] * bf2f((unsigned short)(rv.z & 0xffffu)); y[5] += w1[1] * bf2f((unsigned short)(rv.z >> 16)); y[6] += w1[2] * bf2f((unsigned short)(rv.w & 0xffffu)); y[7] += w1[3] * bf2f((unsigned short)(rv.w >> 16)); }
#pragma unroll
    for (int j = 0; j < 8; ++j) y[j] = y[j] * fsig_(y[j]);
}
__device__ __forceinline__ void mix_c1_m(const Args& a, LAS unsigned char* wl, LAS unsigned char* halo, int lane, int b, int n, int mh, int l) {
    asm volatile("" : "+v"(lane));
    const size_t row0 = (size_t)b * S + n * 64; const bf16* Zt = (const bf16*)(a.ws + WS_Z) + row0 * 4096 + (12 + mh) * 256;
    LAS unsigned char* kimg = wl; LAS unsigned char* vimg = wl + 8192;
    const int vrow = lane >> 3, vch = lane & 7; const unsigned char* zb = (const unsigned char*)Zt; const unsigned loff = (unsigned)(vrow * 8192 + vch * 16);
    v4u rk[8], rv[8], rh;
#pragma unroll
    for (int i = 0; i < 8; ++i) rk[i] = *(const v4u*)(zb + (size_t)i * 65536 + 128 + loff);
    { const int hl = lane < 24 ? lane : 0, rr = hl >> 3; const bool ok = n > 0;
      rh = *(const v4u*)(zb - (ok ? 3 * 8192 : 0) + (unsigned)(rr * 8192 + 128 + vch * 16)); rh.x = ok ? rh.x : 0u; rh.y = ok ? rh.y : 0u; rh.z = ok ? rh.z : 0u; rh.w = ok ? rh.w : 0u; }
#pragma unroll
    for (int i = 0; i < 8; ++i) rv[i] = *(const v4u*)(zb + (size_t)i * 65536 + 256 + loff);
    const float* mgp = (const float*)(a.ws + WS_MG) + (row0 + lane) * 8; const float* gb = a.in[I_MGB] + l * 8;
    const float li = mgp[mh] + gb[mh]; const float xf = mgp[4 + mh] + gb[4 + mh]; const float lf = fminf(xf, 0.f) - __logf(1.f + fexp_(-fabsf(xf)));
#pragma unroll
    for (int i = 0; i < 8; ++i) *(LAS v4u*)(vimg + imgoff<8>(i * 8 + vrow, vch)) = rk[i];
    if (lane < 24) *(LAS v4u*)(halo + lane * 16) = rh;
    const float bc = wave_scan_add(lf, lane), av = li - bc, amax = wave_max(av), blast = __shfl(bc, 63);
    const float pst = fexp_(av - amax) * 0.125f;
    const int h = lane >> 5, r32 = lane & 31; const float* cwk = a.in[I_MCONV] + (size_t)l * 2048 + 256 + mh * 64;
    LDS_WAIT(); asm volatile("" ::: "memory");
    { const float sc0 = __shfl(pst, r32), sc1 = __shfl(pst, r32 + 32);
#pragma unroll
      for (int s = 0; s < 4; ++s) { const int d0 = 16 * s + 8 * h; ConvW cw; load_convw(cw, cwk + d0); float y[8];
          conv8_lds<true>(y, vimg, halo, r32, 2 * s + h, cw); *(LAS bf16x8*)(kimg + r32 * 128 + d0 * 2) = pk8f(y, sc0);
          conv8_lds<false>(y, vimg, halo, r32 + 32, 2 * s + h, cw); *(LAS bf16x8*)(kimg + (r32 + 32) * 128 + d0 * 2) = pk8f(y, sc1);
          asm volatile("" ::: "memory"); } }
    LDS_WAIT(); asm volatile("" ::: "memory");
#pragma unroll
    for (int i = 0; i < 8; ++i) *(LAS v4u*)(vimg + (i * 8 + vrow) * 128 + vch * 16) = rv[i];
    LDS_WAIT(); asm volatile("" ::: "memory");
    f32x16 U[2][2]; ktv<64>(U, kimg, vimg, lane);
    float* vp = (float*)(a.ws + WS_VEC) + ((size_t)(b * 64 + n) * 16 + 12 + mh) * 192;
    float nu = 0.f;
#pragma unroll 8
    for (int t = 0; t < 64; ++t) nu += bf2f(*(LAS const unsigned short*)(kimg + t * 128 + lane * 2));
    store_ut<64>(U, (float*)(a.ws + WS_U + (size_t)(b * 64 + n) * U_BN + u_off(12 + mh)), nullptr, lane, wl);
    vp[64 + lane] = nu; if (lane == 0) { vp[0] = amax; vp[1] = blast; }
    LDS_WAIT(); asm volatile("" ::: "memory");
}
__device__ __forceinline__ void mix_c3_m(const Args& a, LAS unsigned char* wl, LAS unsigned char* halo, int lane, int b, int n, int mh, int l) {
    asm volatile("" : "+v"(lane));
    const size_t row0 = (size_t)b * S + n * 64; const bf16* Zt = (const bf16*)(a.ws + WS_Z) + row0 * 4096 + (12 + mh) * 256;
    LAS unsigned char* bufA = wl; LAS unsigned char* bufB = wl + 8192;
    const float* vp = (const float*)(a.ws + WS_VEC) + ((size_t)(b * 64 + n) * 16 + 12 + mh) * 192;
    const int vrow = lane >> 3, vch = lane & 7; const unsigned char* zb = (const unsigned char*)Zt; const unsigned loff = (unsigned)(vrow * 8192 + vch * 16);
    const bf16* CpT = (const bf16*)(a.ws + WS_XN + (size_t)(b * 64 + n) * SP_BN + u_off(12 + mh) / 2);
    v4u rq[8], rk[8], rv[8], rc[8], rh;
#pragma unroll
    for (int i = 0; i < 8; ++i) { rq[i] = *(const v4u*)(zb + (size_t)i * 65536 + loff); rk[i] = *(const v4u*)(zb + (size_t)i * 65536 + 128 + loff); }
    { const int hl = lane < 48 ? lane : 0, qk = hl / 24, rr = (hl % 24) >> 3; const bool ok = n > 0;
      rh = *(const v4u*)(zb - (ok ? 3 * 8192 : 0) + (unsigned)(rr * 8192 + qk * 128 + vch * 16)); rh.x = ok ? rh.x : 0u; rh.y = ok ? rh.y : 0u; rh.z = ok ? rh.z : 0u; rh.w = ok ? rh.w : 0u; }
#pragma unroll
    for (int i = 0; i < 8; ++i) rv[i] = *(const v4u*)(zb + (size_t)i * 65536 + 256 + loff);
#pragma unroll
    for (int i = 0; i < 8; ++i) rc[i] = *(const v4u*)((const unsigned char*)CpT + i * 1024 + (unsigned)(lane * 16));
    const float* mgp = (const float*)(a.ws + WS_MG) + (row0 + lane) * 8; const float* gb = a.in[I_MGB] + l * 8;
    const float li = mgp[mh] + gb[mh]; const float xf = mgp[4 + mh] + gb[4 + mh]; const float lf = fminf(xf, 0.f) - __logf(1.f + fexp_(-fabsf(xf)));
    const float mprev = vp[2];
#pragma unroll
    for (int i = 0; i < 8; ++i) { *(LAS v4u*)(bufA + imgoff<8>(i * 8 + vrow, vch)) = rq[i]; *(LAS v4u*)(bufB + imgoff<8>(i * 8 + vrow, vch)) = rk[i]; }
    if (lane < 48) *(LAS v4u*)(halo + lane * 16) = rh;
    const float bc = wave_scan_add(lf, lane), av = li - bc, amax = wave_max(av);
    const float Mi = fmaxf(mprev, wave_scan_max(av, lane)); const float pst = fexp_(av - amax) * 0.125f;
    const int h = lane >> 5, r32 = lane & 31, g16 = (lane >> 4) & 1, q = (lane & 15) >> 2, p = lane & 3;
    const float* cwq = a.in[I_MCONV] + (size_t)l * 2048 + mh * 64; const float* cwk = cwq + 256;
    bf16x8 Qf[2][4], Kf[2][4];
    LDS_WAIT(); asm volatile("" ::: "memory");
    { const float sc0 = __shfl(pst, r32), sc1 = __shfl(pst, r32 + 32);
#pragma unroll
      for (int s = 0; s < 4; ++s) { const int d0 = 16 * s + 8 * h; ConvW cw; float y[8];
          load_convw(cw, cwq + d0);
          conv8_lds<true>(y, bufA, halo, r32, 2 * s + h, cw); Qf[0][s] = pk8f(y, 1.f); conv8_lds<false>(y, bufA, halo, r32 + 32, 2 * s + h, cw); Qf[1][s] = pk8f(y, 1.f);
          asm volatile("" ::: "memory");
          load_convw(cw, cwk + d0);
          conv8_lds<true>(y, bufB, halo + 384, r32, 2 * s + h, cw); Kf[0][s] = pk8f(y, sc0); conv8_lds<false>(y, bufB, halo + 384, r32 + 32, 2 * s + h, cw); Kf[1][s] = pk8f(y, sc1);
          asm volatile("" ::: "memory"); } }
    LDS_WAIT(); asm volatile("" ::: "memory");
#pragma unroll
    for (int i = 0; i < 8; ++i) { *(LAS v4u*)(bufA + (i * 8 + vrow) * 128 + vch * 16) = rv[i]; *(LAS v4u*)(bufB + imgoff<8>(i * 8 + vrow, vch)) = rc[i]; }
    f32x16 X00, X01, X11;
#pragma unroll
    for (int r = 0; r < 16; ++r) { X00[r] = 0.f; X01[r] = 0.f; X11[r] = 0.f; }
#pragma unroll
    for (int s = 0; s < 4; ++s) { X00 = MFMA32(Kf[0][s], Qf[0][s], X00); X01 = MFMA32(Kf[0][s], Qf[1][s], X01); X11 = MFMA32(Kf[1][s], Qf[1][s], X11); }
    asm volatile("" ::: "memory");
    v4u rg[8];
#pragma unroll
    for (int i = 0; i < 8; ++i) rg[i] = *(const v4u*)(zb + (size_t)i * 65536 + 384 + loff);
    float Mc[2], bi[2], si[2], den[2];
#pragma unroll
    for (int ib = 0; ib < 2; ++ib) { Mc[ib] = __shfl(Mi, r32 + 32 * ib); bi[ib] = __shfl(bc, r32 + 32 * ib); si[ib] = fexp_(mprev - Mc[ib]); }
    { const float f0 = fexp_(amax - Mc[0]), f1 = fexp_(amax - Mc[1]); float d0 = 0.f, d1 = 0.f;
#pragma unroll
      for (int r = 0; r < 16; ++r) { const int jl = (r & 3) + 8 * (r >> 2) + 4 * h; const bool keep = jl <= r32;
          X00[r] = keep ? X00[r] * f0 : 0.f; X01[r] = X01[r] * f1; X11[r] = keep ? X11[r] * f1 : 0.f; d0 += X00[r]; d1 += X01[r] + X11[r]; }
      den[0] = d0 + __shfl_xor(d0, 32); den[1] = d1 + __shfl_xor(d1, 32); }
    bf16x8 P00[2], P01[2], P11[2];
#pragma unroll
    for (int s2 = 0; s2 < 2; ++s2) { P00[s2] = pack8(X00, s2); P01[s2] = pack8(X01, s2); P11[s2] = pack8(X11, s2); }
    f32x16 O[2][2];
#pragma unroll
    for (int vb = 0; vb < 2; ++vb)
#pragma unroll
        for (int ib = 0; ib < 2; ++ib)
#pragma unroll
            for (int r = 0; r < 16; ++r) O[vb][ib][r] = 0.f;
#pragma unroll
    for (int vb = 0; vb < 2; ++vb)
#pragma unroll
        for (int s = 0; s < 4; ++s) { const bf16x8 Cf = *(LAS const bf16x8*)(bufB + imgoff<8>(32 * vb + r32, 2 * s + h)); O[vb][0] = MFMA32(Cf, Qf[0][s], O[vb][0]); O[vb][1] = MFMA32(Cf, Qf[1][s], O[vb][1]); }
    { float qn0 = 0.f, qn1 = 0.f;
#pragma unroll
      for (int s = 0; s < 4; ++s) { const f32x4 n0 = *(const f32x4*)(vp + 128 + 16 * s + 8 * h), n1 = *(const f32x4*)(vp + 128 + 16 * s + 8 * h + 4);
#pragma unroll
          for (int j = 0; j < 4; ++j) { qn0 += bf2f((unsigned short)Qf[0][s][j]) * n0[j] + bf2f((unsigned short)Qf[0][s][4 + j]) * n1[j]; qn1 += bf2f((unsigned short)Qf[1][s][j]) * n0[j] + bf2f((unsigned short)Qf[1][s][4 + j]) * n1[j]; } }
      qn0 += __shfl_xor(qn0, 32); qn1 += __shfl_xor(qn1, 32); den[0] += si[0] * qn0; den[1] += si[1] * qn1; }
#pragma unroll
    for (int vb = 0; vb < 2; ++vb)
#pragma unroll
        for (int ib = 0; ib < 2; ++ib)
#pragma unroll
            for (int r = 0; r < 16; ++r) O[vb][ib][r] *= si[ib];
    LDS_WAIT(); asm volatile("" ::: "memory");
#pragma unroll
    for (int i = 0; i < 8; ++i) *(LAS v4u*)(bufB + imgoff<8>(i * 8 + vrow, vch)) = rg[i];
#pragma unroll
    for (int vb = 0; vb < 2; ++vb)
#pragma unroll
        for (int jb = 0; jb < 2; ++jb)
#pragma unroll
            for (int s2 = 0; s2 < 2; ++s2) { const int t0 = 32 * jb + 16 * s2 + 4 * h + q; LAS const unsigned char* cp = bufA + (32 * vb + 16 * g16 + 4 * p) * 2;
                const bf16x8 A = cat8(tr16(cp + t0 * 128), tr16(cp + (t0 + 8) * 128));
                if (jb == 0) { O[vb][0] = MFMA32(A, P00[s2], O[vb][0]); O[vb][1] = MFMA32(A, P01[s2], O[vb][1]); } else O[vb][1] = MFMA32(A, P11[s2], O[vb][1]); }
    const float* gain = a.in[I_MNORM] + l * 256 + mh * 64; bf16* mixed = (bf16*)(a.ws + WS_MIX);
    LDS_WAIT(); asm volatile("" ::: "memory");
#pragma unroll
    for (int ib = 0; ib < 2; ++ib) { const float inv = 1.f / fmaxf(fabsf(den[ib]), fexp_(-(bi[ib] + Mc[ib]))); float sm = 0.f;
#pragma unroll
        for (int vb = 0; vb < 2; ++vb)
#pragma unroll
            for (int r = 0; r < 16; ++r) { O[vb][ib][r] *= inv; sm += O[vb][ib][r]; }
        sm += __shfl_xor(sm, 32); const float mu = sm * (1.f / 64.f); float sv = 0.f;
#pragma unroll
        for (int vb = 0; vb < 2; ++vb)
#pragma unroll
            for (int r = 0; r < 16; ++r) { const float dlt = O[vb][ib][r] - mu; sv += dlt * dlt; }
        sv += __shfl_xor(sv, 32); const float rn = rsqrtf(sv * (1.f / 64.f) + EPS); const int trow = 32 * ib + r32;
#pragma unroll
        for (int vb = 0; vb < 2; ++vb)
#pragma unroll
            for (int g = 0; g < 4; ++g) { const int vc0 = 32 * vb + 8 * g + 4 * h; const f32x4 gn = *(const f32x4*)(gain + vc0); const v2u gw = *(LAS const v2u*)(bufB + imgoff<8>(trow, 4 * vb + g) + 8 * h);
                const float o0 = (O[vb][ib][4 * g] - mu) * rn * gn[0] * bf2f((unsigned short)(gw.x & 0xffffu)), o1 = (O[vb][ib][4 * g + 1] - mu) * rn * gn[1] * bf2f((unsigned short)(gw.x >> 16));
                const float o2 = (O[vb][ib][4 * g + 2] - mu) * rn * gn[2] * bf2f((unsigned short)(gw.y & 0xffffu)), o3 = (O[vb][ib][4 * g + 3] - mu) * rn * gn[3] * bf2f((unsigned short)(gw.y >> 16));
                v2u w; w.x = cvtpk(o0, o1); w.y = cvtpk(o2, o3); *(LAS v2u*)(bufA + imgoff<8>(trow, 4 * vb + g) + 8 * h) = w; } }
    LDS_WAIT(); asm volatile("" ::: "memory");
#pragma unroll
    for (int i = 0; i < 8; ++i) { const v4u o = *(LAS const v4u*)(bufA + imgoff<8>(i * 8 + vrow, vch)); *(v4u*)((unsigned char*)(mixed + row0 * D + (12 + mh) * 64) + i * 16384 + (unsigned)(vrow * 2048 + vch * 16)) = o; }
    LDS_WAIT(); asm volatile("" ::: "memory");
}
__device__ __forceinline__ void phase_c1(const Args& a, LAS unsigned char* lds, int lane, int wave, int l) {
    LAS unsigned char* wl = lds + wave * 16384; const int gw = blockIdx.x * NWAVES + wave, NGW = gridDim.x * NWAVES;
    for (int id = gw, k = 0; id < NB * 64 * 16; id += NGW, ++k) { const int bn = id >> 4, head = (id + 8 * k) & 15, b = bn >> 6, n = bn & 63;
        if (head < 6) mix_c1_gh<32>(a, wl, lane, b, n, head); else if (head < 12) mix_c1_gh<64>(a, wl, lane, b, n, head); else mix_c1_m(a, wl, lds + RING_BYTES + 1024 + wave * 1024, lane, b, n, head - 12, l); }
}
__device__ __forceinline__ void phase_c3(const Args& a, LAS unsigned char* lds, int lane, int wave, int l, int vblk, int nblk, int nitems) {
    LAS unsigned char* wl = lds + wave * 16384; const int gw = vblk * NWAVES + wave, NGW = nblk * NWAVES;
    for (int id = gw, k = 0; id < nitems; id += NGW, ++k) { const int bn = id >> 4, head = (id + 8 * k) & 15, b = bn >> 6, n = bn & 63;
        if (head < 6) mix_c3_gh<32>(a, wl, lane, b, n, head, l); else if (head < 12) mix_c3_gh<64>(a, wl, lane, b, n, head, l); else mix_c3_m(a, wl, lds + RING_BYTES + 1024 + wave * 1024, lane, b, n, head - 12, l); }
}
typedef float f32x2s __attribute__((ext_vector_type(2)));
__device__ __forceinline__ void phase_c2(const Args& a, int tid) {
    constexpr int TPB = 6 * 1024 + 6 * 2048 + 4 * 2080;
    const unsigned char* ws = a.ws; float* vecb = (float*)(a.ws + WS_VEC);
    for (int task = blockIdx.x * (NWAVES * 64) + tid; task < NB * TPB; task += gridDim.x * NWAVES * 64) {
        const int b = task / TPB; int r = task % TPB; int head, qi;
        if (r < 6144) { head = r >> 10; qi = r & 1023; } else if (r < 18432) { head = 6 + ((r - 6144) >> 11); qi = (r - 6144) & 2047; } else { head = 12 + (r - 18432) / 2080; qi = (r - 18432) % 2080; }
        const int uo = u_off(head);
        if (head < 12) { const int KCH = head < 6 ? 32 : 64; const int c0 = (qi * 2) % KCH; f32x2s st = (f32x2s){0.f, 0.f};
            for (int n0 = 0; n0 < 64; n0 += 16) { f32x2s er[16], ed[16], uu[16];
#pragma unroll
                for (int i = 0; i < 16; ++i) { const size_t bn = (size_t)(b * 64 + n0 + i); const float* vp = vecb + (bn * 16 + head) * 192;
                    er[i] = *(const f32x2s*)(vp + c0); ed[i] = *(const f32x2s*)(vp + 128 + c0); uu[i] = *(const f32x2s*)(ws + WS_U + bn * U_BN + uo + (size_t)qi * 8); }
#pragma unroll
                for (int i = 0; i < 16; ++i) { const size_t bn = (size_t)(b * 64 + n0 + i); const f32x2s sp = st * er[i];
                    *(unsigned*)(a.ws + WS_XN + bn * SP_BN + uo / 2 + (size_t)qi * 4) = cvtpk(sp[0], sp[1]); st = ed[i] * st + uu[i]; } }
        } else { f32x2s st = (f32x2s){0.f, 0.f}; float m = 0.f; const bool isvec = qi >= 2048; const int dq = qi - 2048;
            for (int n0 = 0; n0 < 64; n0 += 16) { f32x2s uu[16]; float am[16], bl[16];
#pragma unroll
                for (int i = 0; i < 16; ++i) { const size_t bn = (size_t)(b * 64 + n0 + i); const float* vp = vecb + (bn * 16 + head) * 192; am[i] = vp[0]; bl[i] = vp[1];
                    uu[i] = isvec ? *(const f32x2s*)(vp + 64 + 2 * dq) : *(const f32x2s*)(ws + WS_U + bn * U_BN + uo + (size_t)qi * 8); }
#pragma unroll
                for (int i = 0; i < 16; ++i) { const size_t bn = (size_t)(b * 64 + n0 + i); float* vp = vecb + (bn * 16 + head) * 192;
                    const float mnew = fmaxf(bl[i] + m, bl[i] + am[i]), so = fexp_(bl[i] + m - mnew), sl = fexp_(bl[i] + am[i] - mnew);
                    if (!isvec) *(unsigned*)(a.ws + WS_XN + bn * SP_BN + uo / 2 + (size_t)qi * 4) = cvtpk(st[0], st[1]);
                    else { *(f32x2s*)(vp + 128 + 2 * dq) = st; if (dq == 0) vp[2] = m; }
                    st = st * so + uu[i] * sl; m = mnew; } }
        }
    }
}
constexpr int NPL = 7;
constexpr int NPRE = 2;
constexpr int NPH = NPRE + NPL * L + 1;
#ifndef MK_REP_MASK
#define MK_REP_MASK 0
#endif
#ifndef MK_REP_N
#define MK_REP_N 1
#endif
#ifndef MK_STAGGER_US
#define MK_STAGGER_US 0
#endif
#ifndef MK_DRY_NOEPI
#define MK_DRY_NOEPI 0
#endif
#ifndef MK_HALF
#define MK_HALF 0
#endif
#ifndef MK_FF2_AUX_A
#define MK_FF2_AUX_A 0
#endif
#ifndef MK_DRY_ASAME
#define MK_DRY_ASAME 0
#endif
#ifndef MK_DRY_NT
#define MK_DRY_NT 0
#endif
#ifndef MK_NULL_BARRIERS
#define MK_NULL_BARRIERS 0
#endif
#ifndef MK_ONE_LAUNCH
#define MK_ONE_LAUNCH 1
#endif
__global__ void __launch_bounds__(NWAVES * 64, 2) mk_fwd(Args kargs) {
    extern __shared__ __attribute__((aligned(16))) unsigned char lds_raw[];
    LAS unsigned char* lds = (LAS unsigned char*)lds_raw;
    volatile LAS unsigned* MISC = (volatile LAS unsigned*)(lds + MISC_OFF);
    const int tid0 = threadIdx.x;
    const int wave0 = __builtin_amdgcn_readfirstlane(tid0 >> 6);
    for (int u = tid0; u < (LDS_BYTES - RING_BYTES) / 4; u += NWAVES * 64) ((LAS unsigned*)(lds + RING_BYTES))[u] = 0u;
    __syncthreads();
    const int ph_lo = kargs.ph_lo, ph_hi = kargs.ph_hi, rep_mask = kargs.pad;
    unsigned* ctl = (unsigned*)(kargs.ws + WS_CTL);
    XcdBarrier bar; bar.bar = ctl + 4096; bar.x = 0; bar.st = nullptr;
    if (ph_hi - ph_lo > 1) bar = xcd_barrier_post(ctl + 4096, MISC + 8);
    for (int p = ph_lo; p < ph_hi; ++p) {
        const int kind = p < NPRE ? 1 + p : (p == NPH - 1 ? 10 : 3 + (p - NPRE) % NPL);
        const int reps = ((rep_mask >> kind) & 1) ? 2 : 1;
      for (int rr = 0; rr < reps; ++rr) {
#if defined(__HIP_DEVICE_COMPILE__)
        const __attribute__((address_space(4))) Args* kap = (const __attribute__((address_space(4))) Args*)__builtin_amdgcn_kernarg_segment_ptr(); asm volatile("" : "+s"(kap));
        const Args args = *(const Args*)kap;
#else
        const Args args = kargs;
#endif
        unsigned char* ws = args.ws;
        const bool dry = rr > 0;
        int wave = wave0; asm volatile("" : "+s"(wave));
        int lane; asm volatile("v_mbcnt_lo_u32_b32 %0, -1, 0\n\tv_mbcnt_hi_u32_b32 %0, -1, %0" : "=v"(lane)); const int tid = wave * 64 + lane;
        if (p == 0) phase_p0(args, lds, tid);
        else if (p == 1) phase_p1(args, lds, tid, lane, wave);
        else if (p == NPH - 1) { if (!dry) phase_final(args, lane, wave); }
        else {
            const int l = (p - NPRE) / NPL, j = (p - NPRE) % NPL;
            unsigned char* wl = ws + WS_W + (size_t)l * W_LAYER;
            const float* mod_l = (const float*)(ws + WS_MOD) + (size_t)l * NB * 6 * D;
            float* ssq = (float*)(ws + WS_SSQ);
            bf16* xdst = dry ? (bf16*)(ws + WS_U) : (bf16*)(ws + WS_XB); bf16* xndst = dry ? (bf16*)(ws + WS_U) : (bf16*)(ws + WS_XN); float* ssqdst = dry ? (float*)(ws + WS_U + 48 * MiB) : ssq;
            if (j == 0) {
                pg8::Gemm g{(const bf16*)(ws + WS_XN), (const bf16*)(wl + W_IN), M, NIN, D}; pg8::StaticOrder S; S.init(M, NIN, gridDim.x, (int)blockIdx.x);
                LAS float* rt = (LAS float*)(lds + RING_BYTES + 1024); LAS float* bt = (LAS float*)(lds + RING_BYTES + 1024 + 12288); pg8::fill_rstd(rt, ssq, S, tid); pg8::fill_bias(bt, (const float*)(ws + WS_BIAS) + (size_t)l * NB * 4096, S, tid);
                pg8::EpiIn E{(dry && MK_DRY_NOEPI) ? nullptr : (bf16*)(ws + WS_Z), (float*)(ws + WS_VEC), (float*)(ws + WS_MG), bt, rt, (const float*)(ws + WS_LB) + l * 384, args.in[I_GBG] + l * 192};
                pg8::gemm_phase<pg8::EpiIn, pg8::StaticOrder, true, true>(lds, g, S, E, wave);
            } else if (j == 1) { phase_c1(args, lds, lane, wave, l);
            } else if (j == 2) { if (l + 1 < L && l + 1 >= MK_CONV_P1_LAYERS && !dry) conv_phase(args, lane, wave, l + 1); phase_c2(args, tid);
            } else if (j == 3) { if (dry && MK_HALF) { if (((blockIdx.x >> 3) & 1) == 0) phase_c3(args, lds, lane, wave, l, ((blockIdx.x >> 4) << 3) | (blockIdx.x & 7), gridDim.x / 2, NB * 64 * 16 / 2); } else phase_c3(args, lds, lane, wave, l, blockIdx.x, gridDim.x, NB * 64 * 16);
            } else if (j == 4) {
                pg8::Gemm g{(const bf16*)(ws + WS_MIX), (const bf16*)(wl + W_OUT), M, D, D}; pg8::StaticOrder S; S.init(M, D, gridDim.x, (int)blockIdx.x);
                pg8::EpiRes E{l == 0 ? args.in[I_X] : nullptr, (const bf16*)(ws + WS_XB), dry ? (bf16*)(ws + WS_Z) : (bf16*)(ws + WS_XB), mod_l + 2 * D, (const float*)(ws + WS_GMUL) + (size_t)(l * 2 + 1) * NB * D, dry ? (bf16*)(ws + WS_Z + 64 * MiB) : (bf16*)(ws + WS_XN), dry ? (float*)(ws + WS_Z + 96 * MiB) : ssq};
                pg8::gemm_phase<pg8::EpiRes, pg8::StaticOrder, true, true>(lds, g, S, E, wave);
            } else if (j == 5) {
                pg8::Gemm g{(const bf16*)(ws + WS_XN), (const bf16*)(wl + W_1), M, DFF, D}; pg8::StaticOrder S; S.init(M, DFF, gridDim.x, (int)blockIdx.x);
                if (dry && MK_DRY_NT > 0) g.nt_probe = MK_DRY_NT;
                if (dry && MK_HALF) { const int grp = (blockIdx.x >> 3) & 1, vb = ((blockIdx.x >> 4) << 3) | (blockIdx.x & 7); S.init(M / 2, DFF, gridDim.x / 2, grp == 0 ? vb : (1 << 20)); }
                LAS float* rt = (LAS float*)(lds + RING_BYTES + 1024); LAS float* bt = (LAS float*)(lds + RING_BYTES + 1024 + 12288); pg8::fill_rstd(rt, ssq, S, tid); pg8::fill_bias(bt, (const float*)(ws + WS_BIAS) + (size_t)(L + l) * NB * 4096, S, tid);
                pg8::EpiFF1 E{(dry && MK_DRY_NOEPI) ? nullptr : (bf16*)(ws + WS_Z), bt, rt};
                if (MK_STAGGER_US > 0 && (blockIdx.x & 8)) { const unsigned long long t0 = __builtin_amdgcn_s_memrealtime(); while (__builtin_amdgcn_s_memrealtime() - t0 < (unsigned long long)(MK_STAGGER_US * 100)) __builtin_amdgcn_s_sleep(32); }
                pg8::gemm_phase<pg8::EpiFF1, pg8::StaticOrder, true, true>(lds, g, S, E, wave);
            } else {
                pg8::Gemm g{(const bf16*)(ws + WS_Z), (const bf16*)(wl + W_2), M, D, DFF}; pg8::StaticOrder S; S.init(M, D, gridDim.x, (int)blockIdx.x);
                if (dry && MK_DRY_NT > 0) g.nt_probe = MK_DRY_NT;
                if (dry && MK_DRY_ASAME) g.a_same_probe = 1;
                pg8::EpiRes E{nullptr, (const bf16*)(ws + WS_XB), xdst, mod_l + 5 * D, l + 1 < L ? (const float*)(ws + WS_GMUL) + (size_t)((l + 1) * 2) * NB * D : nullptr, xndst, ssqdst};
                pg8::gemm_phase<pg8::EpiRes, pg8::StaticOrder, true, true, MK_FF2_AUX_A>(lds, g, S, E, wave);
            }
        }
        if (p + 1 < ph_hi || rr + 1 < reps) xcd_barrier(bar);
#if MK_NULL_BARRIERS > 0
        if (kind == 8) { for (int nb = 0; nb < MK_NULL_BARRIERS; ++nb) xcd_barrier(bar); }
#endif
      }
    }
}

extern "C" void kernel_launch(void* const* d_in, const int* in_sizes, int n_in, void* d_out, int out_size, void* d_ws, size_t ws_size, hipStream_t stream) {
    static int grid = 0;
    if (grid == 0) {
        if (n_in != 19 || out_size != M * D || ws_size < WS_END) { fprintf(stderr, "kernel_launch: unexpected shapes (n_in %d out %d ws %zu)\n", n_in, out_size, ws_size); grid = -1; return; }
        int dev = 0, cus = 0, per_cu = 0;
        if (hipGetDevice(&dev) != hipSuccess || hipDeviceGetAttribute(&cus, hipDeviceAttributeMultiprocessorCount, dev) != hipSuccess) { grid = -1; return; }
        if (hipFuncSetAttribute((const void*)mk_fwd, hipFuncAttributeMaxDynamicSharedMemorySize, LDS_BYTES) != hipSuccess) { fprintf(stderr, "kernel_launch: hipFuncSetAttribute failed\n"); grid = -1; return; }
        if (hipOccupancyMaxActiveBlocksPerMultiprocessor(&per_cu, (const void*)mk_fwd, NWAVES * 64, LDS_BYTES) != hipSuccess || per_cu < 1) { fprintf(stderr, "kernel_launch: occupancy query says %d blocks/CU\n", per_cu); grid = -1; (void)hipGetLastError(); return; }
        grid = cus;
    }
    if (grid < 0) return;
    (void)hipMemsetAsync((char*)d_ws + WS_CTL, 0, CTL_ZERO_BYTES, stream);
    Args a{};
    for (int i = 0; i < 19; ++i) a.in[i] = (const float*)d_in[i];
    a.out = (float*)d_out; a.ws = (unsigned char*)d_ws; a.pad = MK_REP_MASK;
#if MK_ONE_LAUNCH
    a.ph_lo = 0; a.ph_hi = NPH; a.li = 0;
    hipLaunchKernelGGL(mk_fwd, dim3(grid), dim3(NWAVES * 64), LDS_BYTES, stream, a);
#else
    for (int p = 0; p < NPH; ++p) { a.ph_lo = p; a.ph_hi = p + 1; a.li = 0; hipLaunchKernelGGL(mk_fwd, dim3(grid), dim3(NWAVES * 64), LDS_BYTES, stream, a); }
#endif
}
```
